# Optimizing an MI355X kernel written in HIP

```python
import math
import jax, jax.numpy as jnp
from jax import lax
import numpy as np

D_MODEL = 1024
BATCH = 32
SEQ = 256
DEPTH = 2
DEC_BATCH = 2
DEC_SEQ = 2048
PAST_LEN = 512

GRID_W = 64
N_MIXERS = 4
D_BRANCH = D_MODEL // N_MIXERS
D_MIX = N_MIXERS * D_BRANCH
EPS = 1e-6

MLA_HEADS = 4
MLA_Q_RANK = 3 * D_MODEL // 16
MLA_KV_RANK = D_MODEL // 8
MLA_NOPE = 64
MLA_ROPE = 32
MLA_QK = MLA_NOPE + MLA_ROPE
MLA_V = D_BRANCH // MLA_HEADS
ROPE_BASE = 10000.0
Q_BLOCK = 128

HY_ORDER = 2
HY_SHORT = 3
HY_BANDS = 16
HY_FEAT = 1 + 2 * HY_BANDS
HY_HIDDEN = 64
HY_SHIFT = 0.05
HY_FAST_DECAY = 0.3
HY_SLOW_DECAY = 1.5
HY_TARGET = 1e-2

S5_GROUP = 16
S5_GROUPS = D_BRANCH // S5_GROUP
S5_STATE = 64
S5_DT_MIN = 1e-3
S5_DT_MAX = 1e-1

GLA_HEADS = 4
GLA_DK = D_BRANCH // 2 // GLA_HEADS
GLA_DV = D_BRANCH // GLA_HEADS
GLA_GATE_RANK = 16
GLA_TAU = 16.0
GLA_CHUNK = 64

IN_SPLITS = (MLA_Q_RANK, MLA_KV_RANK, MLA_ROPE, D_BRANCH,
             3 * D_BRANCH, D_BRANCH,
             D_BRANCH, D_BRANCH,
             GLA_HEADS * GLA_DK, GLA_HEADS * GLA_DK, GLA_HEADS * GLA_DV,
             2 * GLA_GATE_RANK, D_BRANCH)
N_IN = sum(IN_SPLITS)

kernel_name = 'hybrid_prefix_diffusion_step'


def split_points():
    return np.cumsum(IN_SPLITS)[:-1].tolist()


def rmsnorm(x, w):
    xf = x.astype(jnp.float32)
    y = xf * lax.rsqrt(jnp.mean(xf * xf, axis=-1, keepdims=True) + EPS)
    return (y * w.astype(jnp.float32)).astype(x.dtype)


def rope_1d(x, pos):
    d = x.shape[-1]
    inv = ROPE_BASE ** (-jnp.arange(0, d, 2, dtype=jnp.float32) / d)
    ang = pos.astype(jnp.float32)[:, None] * inv[None, :]
    ang = jnp.concatenate([ang, ang], axis=-1)[None, :, None, :]
    x1, x2 = jnp.split(x, 2, axis=-1)
    rot = jnp.concatenate([-x2, x1], axis=-1)
    return (x * jnp.cos(ang) + rot * jnp.sin(ang)).astype(x.dtype)


def rope_tail(x, row, col):
    r = x[..., MLA_NOPE:]
    half = MLA_ROPE // 2
    r = jnp.concatenate([rope_1d(r[..., :half], row), rope_1d(r[..., half:], col)], axis=-1)
    return jnp.concatenate([x[..., :MLA_NOPE], r], axis=-1)


def block_attention(q, k, v):
    b, lq, h, dq = q.shape
    nb = lq // Q_BLOCK
    qb = jnp.moveaxis(q.reshape(b, nb, Q_BLOCK, h, dq), 1, 0)

    def one(qi):
        s = jnp.einsum('bqhd,bkhd->bhqk', qi, k).astype(jnp.float32) * (MLA_QK ** -0.5)
        pr = jax.nn.softmax(s, axis=-1).astype(v.dtype)
        return jnp.einsum('bhqk,bkhd->bqhd', pr, v)

    o = lax.map(one, qb)
    return jnp.moveaxis(o, 0, 1).reshape(b, lq, h, v.shape[-1])


def mla_keys_values(c_kv, k_rope, p):
    b, L, _ = c_kv.shape
    kv = (c_kv @ p['mla_w_ukv']).reshape(b, L, MLA_HEADS, MLA_NOPE + MLA_V)
    kr = jnp.broadcast_to(k_rope[:, :, None, :], (b, L, MLA_HEADS, MLA_ROPE)).astype(kv.dtype)
    k = rmsnorm(jnp.concatenate([kv[..., :MLA_NOPE], kr], axis=-1), p['mla_k_norm'])
    return k, kv[..., MLA_NOPE:]


def hyena_filters(L, p):
    pos = jnp.arange(L, dtype=jnp.float32)
    t = pos / L
    w = 2.0 * math.pi * pos / L
    bands = jnp.linspace(1e-4, HY_BANDS - 1, HY_BANDS, dtype=jnp.float32)
    feat = jnp.concatenate([t[:, None], jnp.cos(w[:, None] * bands), jnp.sin(w[:, None] * bands)], axis=-1)
    hid = jnp.sin(p['hy_freq1'] * (feat @ p['hy_w1'] + p['hy_b1']))
    hid = jnp.sin(p['hy_freq2'] * (hid @ p['hy_w2'] + p['hy_b2']))
    filt = (hid @ p['hy_w3']).astype(jnp.float32).reshape(L, 2, HY_ORDER, D_BRANCH)
    deltas = jnp.linspace(math.log(1.0 / HY_TARGET) / HY_FAST_DECAY,
                          math.log(1.0 / HY_TARGET) / HY_SLOW_DECAY, D_BRANCH, dtype=jnp.float32)
    window = jnp.exp(-t[:, None] * deltas[None, :]) + HY_SHIFT
    filt = filt * window[:, None, None, :]
    kern = jnp.concatenate([filt[:, 0], jnp.zeros((1, HY_ORDER, D_BRANCH), jnp.float32),
                            filt[1:, 1][::-1]], axis=0)
    kern = kern / jnp.sum(jnp.abs(kern), axis=0, keepdims=True)
    return jnp.fft.rfft(kern, axis=0)


def fft_conv(u, kf):
    L = u.shape[1]
    uf = jnp.fft.rfft(u, n=2 * L, axis=1)
    return jnp.fft.irfft(uf * kf[None], n=2 * L, axis=1)[:, :L]


def hyena_mixer(z, p):
    L = z.shape[1]
    z = lax.conv_general_dilated(z, p['hy_conv_w'][:, None, :].astype(z.dtype), (1,),
                                 ((HY_SHORT // 2, HY_SHORT // 2),),
                                 dimension_numbers=('NWC', 'WIO', 'NWC'),
                                 feature_group_count=z.shape[-1]) + p['hy_conv_b']
    v, x1, x2 = jnp.split(z.astype(jnp.float32), 3, axis=-1)
    kf = hyena_filters(L, p)
    bias = p['hy_bias'].astype(jnp.float32)
    y = x1 * (fft_conv(v, kf[:, 0]) + bias[0] * v)
    y = x2 * (fft_conv(y, kf[:, 1]) + bias[1] * y)
    return y


def s5_discretise(p, d):
    f32 = jnp.float32
    a = lax.complex(jnp.minimum(p['s5_a_re'][d].astype(f32), -1e-4), p['s5_a_im'][d].astype(f32))
    dt = jnp.exp(p['s5_log_dt'][d].astype(f32))[:, None]
    a_bar = jnp.exp(a * dt)
    bmat = lax.complex(p['s5_b_re'][d].astype(f32), p['s5_b_im'][d].astype(f32))
    b_bar = ((a_bar - 1.0) / a)[..., None] * bmat
    cmat = lax.complex(p['s5_c_re'][d].astype(f32), p['s5_c_im'][d].astype(f32))
    return a_bar, b_bar, cmat


def s5_scan(ug, a_bar, b_bar, h0, reverse):
    bu = jnp.einsum('blgi,gpi->blgp', ug.astype(jnp.complex64), b_bar)
    a = jnp.broadcast_to(a_bar, bu.shape)

    def combine(e1, e2):
        a1, b1 = e1
        a2, b2 = e2
        return a1 * a2, a2 * b1 + b2

    a_cum, h = lax.associative_scan(combine, (a, bu), reverse=reverse, axis=1)
    return h + a_cum * h0[:, None]


def s5_mixer(u, p, h0):
    b, L, _ = u.shape
    uf = u.astype(jnp.float32)
    ug = uf.reshape(b, L, S5_GROUPS, S5_GROUP)
    y = p['s5_d'].astype(jnp.float32) * uf
    finals = []
    for d in range(2):
        a_bar, b_bar, cmat = s5_discretise(p, d)
        h = s5_scan(ug, a_bar, b_bar, h0[:, d], reverse=(d == 1))
        y = y + jnp.real(jnp.einsum('blgp,gip->blgi', h, cmat)).reshape(b, L, D_BRANCH)
        finals.append(h[:, -1] if d == 0 else h[:, 0])
    g = jax.nn.gelu(y)
    out = g * jax.nn.sigmoid(g @ p['s5_glu_w'] + p['s5_glu_b'])
    return out, jnp.stack(finals, axis=1)


def gla_chunked(q, k, v, log_a, s0):
    b, L, h, _ = q.shape
    n = L // GLA_CHUNK

    def to_chunks(x):
        return jnp.moveaxis(x.reshape(b, n, GLA_CHUNK, h, x.shape[-1]), 1, 0)

    mask = jnp.tril(jnp.ones((GLA_CHUNK, GLA_CHUNK), dtype=bool))[None, :, :, None, None]

    def step(s, inp):
        qc, kc, vc, gc = inp
        bc = jnp.cumsum(gc, axis=1)
        diff = bc[:, :, None] - bc[:, None, :]
        decay = jnp.exp(jnp.where(mask, diff, -jnp.inf))
        att = jnp.einsum('btshd,bthd,bshd->bhts', decay, qc, kc)
        o = (jnp.einsum('bhts,bshe->bthe', att, vc)
             + jnp.einsum('bthd,bhde->bthe', qc * jnp.exp(bc), s))
        blast = bc[:, -1]
        s_new = (jnp.exp(blast)[..., None] * s
                 + jnp.einsum('bshd,bshe->bhde', kc * jnp.exp(blast[:, None] - bc), vc))
        return s_new, o

    s_fin, o = lax.scan(step, s0, (to_chunks(q), to_chunks(k), to_chunks(v), to_chunks(log_a)))
    return jnp.moveaxis(o, 0, 1).reshape(b, L, h, v.shape[-1]), s_fin


def gla_mixer(q, k, v, g_lr, p, s0):
    b, L, _ = q.shape
    f32 = jnp.float32
    qh = q.astype(f32).reshape(b, L, GLA_HEADS, GLA_DK) * (GLA_DK ** -0.5)
    kh = k.astype(f32).reshape(b, L, GLA_HEADS, GLA_DK)
    vh = v.astype(f32).reshape(b, L, GLA_HEADS, GLA_DV)
    g_lr = g_lr.astype(f32).reshape(b, L, 2, GLA_GATE_RANK)
    flip = lambda t: t[:, ::-1]
    outs, finals = [], []
    for d in range(2):
        log_a = jax.nn.log_sigmoid(g_lr[:, :, d] @ p['gla_gw'][d] + p['gla_gb'][d]) / GLA_TAU
        log_a = log_a.astype(f32).reshape(b, L, GLA_HEADS, GLA_DK)
        if d == 0:
            od, sf = gla_chunked(qh, kh, vh, log_a, s0[:, d])
        else:
            od, sf = gla_chunked(flip(qh), flip(kh), flip(vh), flip(log_a), s0[:, d])
            od = flip(od)
        outs.append(od)
        finals.append(sf)
    o = rmsnorm(outs[0] + outs[1], p['gla_norm']).reshape(b, L, D_BRANCH)
    return o, jnp.stack(finals, axis=1)


def trunk_layer(x, cond, p, pos=None, ctx=None):
    b, L, _ = x.shape
    f32 = jnp.float32
    mod = jax.nn.silu(cond) @ p['ada_w'] + p['ada_b']
    shift, scale, gate = jnp.split(mod[:, None, :], 3, axis=-1)
    h = rmsnorm(x, p['norm_w']) * (1.0 + scale) + shift
    (c_q, c_kv, k_rope, g_mla, hy_in, g_hy, s5_in, g_s5,
     gla_q, gla_k, gla_v, gla_g, g_gla) = jnp.split(h @ p['w_in'], split_points(), axis=-1)

    c_q = rmsnorm(c_q, p['mla_qa_norm'])
    c_kv = rmsnorm(c_kv, p['mla_kva_norm'])
    q = rmsnorm((c_q @ p['mla_w_uq']).reshape(b, L, MLA_HEADS, MLA_QK), p['mla_q_norm'])
    k, v = mla_keys_values(c_kv, k_rope, p)
    if ctx is None:
        o_mla = block_attention(q, k, v)
        s5_h0 = jnp.zeros((b, 2, S5_GROUPS, S5_STATE), jnp.complex64)
        gla_s0 = jnp.zeros((b, 2, GLA_HEADS, GLA_DK, GLA_DV), f32)
    else:
        ctx_ckv, ctx_krope, ctx_s5, ctx_gla = ctx
        row, col = pos
        k_ctx, v_ctx = mla_keys_values(ctx_ckv, ctx_krope, p)
        q = rope_tail(q, row, col)
        k = rope_tail(k, row, col)
        o_mla = block_attention(q, jnp.concatenate([k_ctx.astype(k.dtype), k], axis=1),
                                jnp.concatenate([v_ctx.astype(v.dtype), v], axis=1))
        s5_h0 = lax.complex(ctx_s5[..., 0].astype(f32), ctx_s5[..., 1].astype(f32))
        gla_s0 = ctx_gla.astype(f32)

    o_hy = hyena_mixer(hy_in, p)
    o_s5, s5_fin = s5_mixer(s5_in, p, s5_h0)
    o_gla, gla_fin = gla_mixer(gla_q, gla_k, gla_v, gla_g, p, gla_s0)

    branches = jnp.concatenate([
        o_mla.reshape(b, L, D_BRANCH) * jax.nn.silu(g_mla),
        o_hy * jax.nn.silu(g_hy),
        o_s5 * jax.nn.silu(g_s5),
        o_gla * jax.nn.silu(g_gla)], axis=-1).astype(x.dtype)
    x = (x + gate * (branches @ p['w_out'])).astype(x.dtype)
    if ctx is None:
        s5_state = jnp.stack([jnp.real(s5_fin), jnp.imag(s5_fin)], axis=-1)
        return x, (c_kv, k_rope, s5_state, gla_fin)
    return x, None


def setup_inputs(seed: int = 0) -> dict:
    key = jax.random.key(seed)
    ks = iter(jax.random.split(key, 48))
    f32 = jnp.float32

    def nrm(shape, scale):
        return jax.random.normal(next(ks), shape, f32) * scale

    def gain(shape):
        return 1.0 + nrm(shape, 0.02)

    a_im = jnp.broadcast_to(math.pi * jnp.arange(S5_STATE, dtype=f32), (DEPTH, 2, S5_GROUPS, S5_STATE))
    return {
        'x_prompt': nrm((BATCH, SEQ, D_MODEL), 1.0),
        'x_sample': nrm((DEC_BATCH, DEC_SEQ, D_MODEL), 1.0),
        'c': nrm((DEC_BATCH, D_MODEL), 1.0),
        'cache_mla_ckv': nrm((DEC_BATCH, DEPTH, PAST_LEN, MLA_KV_RANK), 1.0),
        'cache_mla_krope': nrm((DEC_BATCH, DEPTH, PAST_LEN, MLA_ROPE), 1.0),
        'state_s5': nrm((DEC_BATCH, DEPTH, 2, S5_GROUPS, S5_STATE, 2), 1.0),
        'state_gla': nrm((DEC_BATCH, DEPTH, 2, GLA_HEADS, GLA_DK, GLA_DV), 1.0),
        'c_ctx': nrm((D_MODEL,), 1.0),
        'norm_w': gain((DEPTH, D_MODEL)),
        'ada_w': nrm((DEPTH, D_MODEL, 3 * D_MODEL), 0.5 * D_MODEL ** -0.5),
        'ada_b': nrm((DEPTH, 3 * D_MODEL), 0.02),
        'w_in': nrm((DEPTH, D_MODEL, N_IN), D_MODEL ** -0.5),
        'w_out': nrm((DEPTH, D_MIX, D_MODEL), D_MIX ** -0.5),
        'mla_qa_norm': gain((DEPTH, MLA_Q_RANK)),
        'mla_kva_norm': gain((DEPTH, MLA_KV_RANK)),
        'mla_w_uq': nrm((DEPTH, MLA_Q_RANK, MLA_HEADS * MLA_QK), MLA_Q_RANK ** -0.5),
        'mla_w_ukv': nrm((DEPTH, MLA_KV_RANK, MLA_HEADS * (MLA_NOPE + MLA_V)), MLA_KV_RANK ** -0.5),
        'mla_q_norm': gain((DEPTH, MLA_QK)),
        'mla_k_norm': gain((DEPTH, MLA_QK)),
        'hy_conv_w': nrm((DEPTH, HY_SHORT, 3 * D_BRANCH), HY_SHORT ** -0.5),
        'hy_conv_b': nrm((DEPTH, 3 * D_BRANCH), 0.02),
        'hy_w1': nrm((DEPTH, HY_FEAT, HY_HIDDEN), HY_FEAT ** -0.5),
        'hy_b1': nrm((DEPTH, HY_HIDDEN), 0.02),
        'hy_freq1': gain((DEPTH, HY_HIDDEN)),
        'hy_w2': nrm((DEPTH, HY_HIDDEN, HY_HIDDEN), HY_HIDDEN ** -0.5),
        'hy_b2': nrm((DEPTH, HY_HIDDEN), 0.02),
        'hy_freq2': gain((DEPTH, HY_HIDDEN)),
        'hy_w3': nrm((DEPTH, HY_HIDDEN, 2 * HY_ORDER * D_BRANCH), HY_HIDDEN ** -0.5),
        'hy_bias': nrm((DEPTH, HY_ORDER, D_BRANCH), 1.0),
        's5_a_re': -0.5 + nrm((DEPTH, 2, S5_GROUPS, S5_STATE), 0.01),
        's5_a_im': a_im + nrm((DEPTH, 2, S5_GROUPS, S5_STATE), 0.01),
        's5_log_dt': jax.random.uniform(next(ks), (DEPTH, 2, S5_GROUPS), f32,
                                        math.log(S5_DT_MIN), math.log(S5_DT_MAX)),
        's5_b_re': nrm((DEPTH, 2, S5_GROUPS, S5_STATE, S5_GROUP), (2 * S5_GROUP) ** -0.5),
        's5_b_im': nrm((DEPTH, 2, S5_GROUPS, S5_STATE, S5_GROUP), (2 * S5_GROUP) ** -0.5),
        's5_c_re': nrm((DEPTH, 2, S5_GROUPS, S5_GROUP, S5_STATE), (2 * S5_STATE) ** -0.5),
        's5_c_im': nrm((DEPTH, 2, S5_GROUPS, S5_GROUP, S5_STATE), (2 * S5_STATE) ** -0.5),
        's5_d': nrm((DEPTH, D_BRANCH), 1.0),
        's5_glu_w': nrm((DEPTH, D_BRANCH, D_BRANCH), D_BRANCH ** -0.5),
        's5_glu_b': nrm((DEPTH, D_BRANCH), 0.02),
        'gla_gw': nrm((DEPTH, 2, GLA_GATE_RANK, GLA_HEADS * GLA_DK), GLA_GATE_RANK ** -0.5),
        'gla_gb': nrm((DEPTH, 2, GLA_HEADS * GLA_DK), 0.02),
        'gla_norm': gain((DEPTH, GLA_DV)),
    }


def reference(x_prompt, x_sample, c, cache_mla_ckv, cache_mla_krope, state_s5, state_gla, c_ctx,
              norm_w, ada_w, ada_b, w_in, w_out,
              mla_qa_norm, mla_kva_norm, mla_w_uq, mla_w_ukv, mla_q_norm, mla_k_norm,
              hy_conv_w, hy_conv_b, hy_w1, hy_b1, hy_freq1, hy_w2, hy_b2, hy_freq2, hy_w3, hy_bias,
              s5_a_re, s5_a_im, s5_log_dt, s5_b_re, s5_b_im, s5_c_re, s5_c_im, s5_d, s5_glu_w, s5_glu_b,
              gla_gw, gla_gb, gla_norm):
    weights = {
        'norm_w': norm_w, 'ada_w': ada_w, 'ada_b': ada_b, 'w_in': w_in, 'w_out': w_out,
        'mla_qa_norm': mla_qa_norm, 'mla_kva_norm': mla_kva_norm, 'mla_w_uq': mla_w_uq,
        'mla_w_ukv': mla_w_ukv, 'mla_q_norm': mla_q_norm, 'mla_k_norm': mla_k_norm,
        'hy_conv_w': hy_conv_w, 'hy_conv_b': hy_conv_b, 'hy_w1': hy_w1, 'hy_b1': hy_b1,
        'hy_freq1': hy_freq1, 'hy_w2': hy_w2, 'hy_b2': hy_b2, 'hy_freq2': hy_freq2,
        'hy_w3': hy_w3, 'hy_bias': hy_bias,
        's5_a_re': s5_a_re, 's5_a_im': s5_a_im, 's5_log_dt': s5_log_dt, 's5_b_re': s5_b_re,
        's5_b_im': s5_b_im, 's5_c_re': s5_c_re, 's5_c_im': s5_c_im, 's5_d': s5_d,
        's5_glu_w': s5_glu_w, 's5_glu_b': s5_glu_b,
        'gla_gw': gla_gw, 'gla_gb': gla_gb, 'gla_norm': gla_norm,
    }
    n_rows = x_sample.shape[1] // GRID_W
    row = jnp.repeat(jnp.arange(n_rows), GRID_W)
    col = jnp.tile(jnp.arange(GRID_W), n_rows)

    y_prompt, y_sample = x_prompt, x_sample
    ckv_l, krope_l, s5_l, gla_l = [], [], [], []
    for l in range(DEPTH):
        p = {name: w[l] for name, w in weights.items()}
        y_prompt, (ckv, krope, s5s, glas) = trunk_layer(y_prompt, c_ctx[None, :], p)
        ckv_l.append(ckv)
        krope_l.append(krope)
        s5_l.append(s5s)
        gla_l.append(glas)
        y_sample, _ = trunk_layer(y_sample, c, p, pos=(row, col),
                                  ctx=(cache_mla_ckv[:, l], cache_mla_krope[:, l],
                                       state_s5[:, l], state_gla[:, l]))
    new_mla_ckv = jnp.stack(ckv_l, axis=1)
    new_mla_krope = jnp.stack(krope_l, axis=1)
    new_s5 = jnp.stack(s5_l, axis=1)
    new_gla = jnp.stack(gla_l, axis=1)
    return (y_prompt, y_sample, new_mla_ckv, new_mla_krope, new_s5, new_gla)
```

```cpp
#include <hip/hip_runtime.h>
#include <hip/hip_bf16.h>
#include <hip/hip_cooperative_groups.h>
#include <cstdio>
namespace cg = cooperative_groups;

typedef unsigned short bf16_t;
using bf16x8 = __attribute__((ext_vector_type(8))) short;
using bf16x4 = __attribute__((ext_vector_type(4))) short;
using f32x4 = __attribute__((ext_vector_type(4))) float;
using u32x4 = __attribute__((ext_vector_type(4))) unsigned;
using f32x2 = __attribute__((ext_vector_type(2))) float;
#define DI __device__ __forceinline__

constexpr int NTOK = 12288, NCTX = 8192, DM = 1024, NIN = 2944, NKT = 13312;
constexpr int C_CQ = 0, C_CKV = 192, C_KR = 320, C_GMLA = 352, C_HY = 608, C_GHY = 1376, C_S5 = 1632, C_GS5 = 1888,
              C_GQ = 2144, C_GK = 2272, C_GV = 2400, C_GG = 2656, C_GGLA = 2688;
constexpr size_t OFF_CKV = 12582912, OFF_KR = 14680064, OFF_S5 = 15204352, OFF_GLA = 15466496;

constexpr size_t al256(size_t x) { return (x + 255) & ~(size_t)255; }
constexpr size_t WS_MOD = 0;
constexpr size_t WS_WTIN = al256(WS_MOD + 2 * 3 * 3072 * 4);
constexpr size_t WS_WTOUT = al256(WS_WTIN + (size_t)2 * 2944 * 1024 * 2);
constexpr size_t WS_WTUQ = al256(WS_WTOUT + (size_t)2 * 1024 * 1024 * 2);
constexpr size_t WS_WTUKV = al256(WS_WTUQ + (size_t)2 * 384 * 192 * 2);
constexpr size_t WS_WTGLU = al256(WS_WTUKV + (size_t)2 * 512 * 128 * 2);
constexpr size_t WS_HF = al256(WS_WTGLU + (size_t)2 * 256 * 256 * 2);
constexpr size_t HF_LAYER = (size_t)(256 + 2048) * 1024;
constexpr size_t WS_HNORM = al256(WS_HF + 2 * HF_LAYER * 4);
constexpr size_t WS_HB = al256(WS_HNORM + 2 * 2 * 512 * 4);
constexpr size_t WS_PROJ = al256(WS_HB + (size_t)NTOK * 1024 * 2);
constexpr size_t WS_QB = al256(WS_PROJ + (size_t)NTOK * NIN * 2);
constexpr size_t WS_KB = al256(WS_QB + (size_t)4 * NTOK * 96 * 2);
constexpr size_t WS_VT = al256(WS_KB + (size_t)4 * NKT * 96 * 2);
constexpr size_t WS_ZT = al256(WS_VT + (size_t)4 * NKT * 64 * 2);
constexpr size_t WS_Y1T = al256(WS_ZT + (size_t)768 * NTOK * 2);
constexpr size_t WS_OUTT = al256(WS_Y1T + (size_t)256 * NTOK * 2);
constexpr size_t WS_RTL = al256(WS_OUTT + (size_t)256 * NTOK * 2);
constexpr size_t WS_RTC = al256(WS_RTL + (size_t)2 * 2 * 256 * 4096 * 2);
constexpr size_t WS_CTR = al256(WS_RTC + (size_t)2 * 2 * 256 * 512 * 2);
constexpr size_t WS_HPART = al256(WS_CTR + 16384);
constexpr size_t WS_YS5 = al256(WS_HPART + (size_t)2 * 288 * 1024 * 4);
constexpr size_t WS_GS5 = al256(WS_YS5 + (size_t)NTOK * 256 * 4);
constexpr size_t WS_OGLA = al256(WS_GS5 + (size_t)NTOK * 256 * 2);
constexpr size_t WS_S5LOC = al256(WS_OGLA + (size_t)2 * NTOK * 256 * 4);
constexpr size_t WS_GLALOC = al256(WS_S5LOC + (size_t)2 * 8 * 16 * 2 * 128 * 4);
constexpr size_t WS_S5T = al256(WS_GLALOC + (size_t)2 * 8 * 4 * 2 * 2080 * 4);
constexpr size_t S5T_STRIDE = 9216;
constexpr size_t WS_END = al256(WS_S5T + 64 * S5T_STRIDE);
static_assert(WS_END <= ((size_t)256 << 20), "workspace");

struct P { const float* in[42]; float* out; unsigned char* ws; };

enum { I_XP = 0, I_XS, I_C, I_CCKV, I_CKR, I_SS5, I_SGLA, I_CCTX, I_NORMW, I_ADAW, I_ADAB, I_WIN, I_WOUT, I_QAN, I_KVAN, I_WUQ, I_WUKV,
       I_QN, I_KN, I_HCW, I_HCB, I_HW1, I_HB1, I_HF1, I_HW2, I_HB2, I_HF2, I_HW3, I_HBIAS, I_AR, I_AI, I_LDT, I_BR, I_BI, I_CR, I_CI,
       I_S5D, I_GLUW, I_GLUB, I_GGW, I_GGB, I_GLAN };

DI bf16_t f2bf(float x) { __bf16 b = (__bf16)x; return __builtin_bit_cast(bf16_t, b); }
DI float bf2f(bf16_t h) { return __uint_as_float(((unsigned)h) << 16); }
DI float sigmoidf_(float x) { return 1.f / (1.f + __expf(-x)); }
DI float siluf_(float x) { return x / (1.f + __expf(-x)); }
DI float gelu_tanh(float x) { float u = 0.7978845608028654f * (x + 0.044715f * x * x * x); return 0.5f * x * (1.f + tanhf(u)); }
DI int cond_of(int tok) { return tok < NCTX ? 0 : 1 + ((tok - NCTX) >> 11); }
DI const float* xrow(const P& p, int l, int tok) {
    if (l == 0) return tok < NCTX ? p.in[I_XP] + (size_t)tok * DM : p.in[I_XS] + (size_t)(tok - NCTX) * DM;
    return p.out + (size_t)tok * DM;
}
DI int get_tid() { int t = threadIdx.x; asm volatile("" : "+v"(t)); return t; }
DI bf16x8 pack8_hw(float a0, float a1, float a2, float a3, float a4, float a5, float a6, float a7) {
    typedef __bf16 bfv8 __attribute__((ext_vector_type(8)));
    typedef float fv8 __attribute__((ext_vector_type(8)));
    fv8 v = {a0, a1, a2, a3, a4, a5, a6, a7};
    return __builtin_bit_cast(bf16x8, __builtin_convertvector(v, bfv8));
}
#define MFMA16(a, b, c) __builtin_amdgcn_mfma_f32_16x16x32_bf16((a), (b), (c), 0, 0, 0)

DI void tr_item(const float* __restrict__ src, int K, int N, bf16_t* __restrict__ dst, int kt, int nt, unsigned char* smem) {
    float* tile = (float*)smem;
    const int tid = get_tid(), k0 = kt * 64, n0 = nt * 64;
#pragma unroll
    for (int i = 0; i < 16; ++i) { int e = tid + 256 * i; int kk = e >> 6, nn = e & 63; tile[kk * 65 + nn] = src[(size_t)(k0 + kk) * N + n0 + nn]; }
    __syncthreads();
#pragma unroll
    for (int i = 0; i < 16; ++i) { int e = tid + 256 * i; int nn = e >> 6, kk = e & 63; dst[(size_t)(n0 + nn) * K + k0 + kk] = f2bf(tile[kk * 65 + nn]); }
    __syncthreads();
}

DI void ada_item(const P& p, int l, int cc, unsigned char* smem) {
    float* sc = (float*)smem;
    float* red = sc + 3 * 1024;
    const int tid = get_tid();
    for (int e = tid; e < 3 * 1024; e += 256) { int cnd = e >> 10, k = e & 1023; float v = cnd == 0 ? p.in[I_CCTX][k] : p.in[I_C][(cnd - 1) * 1024 + k]; sc[e] = siluf_(v); }
    __syncthreads();
    const int cq = tid & 15, kg = tid >> 4, n0 = cc * 64;
    const float* W = p.in[I_ADAW] + (size_t)l * 1024 * 3072 + n0 + 4 * cq;
    float acc[3][4];
#pragma unroll
    for (int a = 0; a < 3; ++a)
#pragma unroll
        for (int j = 0; j < 4; ++j) acc[a][j] = 0.f;
#pragma unroll 8
    for (int kk = 0; kk < 64; ++kk) {
        int k = kg * 64 + kk;
        float4 w = *(const float4*)(W + (size_t)k * 3072);
#pragma unroll
        for (int a = 0; a < 3; ++a) { float s = sc[a * 1024 + k]; acc[a][0] += s * w.x; acc[a][1] += s * w.y; acc[a][2] += s * w.z; acc[a][3] += s * w.w; }
    }
#pragma unroll
    for (int a = 0; a < 3; ++a)
#pragma unroll
        for (int j = 0; j < 4; ++j) red[(kg * 3 + a) * 64 + 4 * cq + j] = acc[a][j];
    __syncthreads();
    if (tid < 192) {
        int a = tid >> 6, n = tid & 63; float s = 0.f;
#pragma unroll
        for (int g = 0; g < 16; ++g) s += red[(g * 3 + a) * 64 + n];
        float* MOD = (float*)(p.ws + WS_MOD);
        MOD[(l * 3 + a) * 3072 + n0 + n] = s + p.in[I_ADAB][l * 3072 + n0 + n];
    }
    __syncthreads();
}

DI void hyfilt_item(const P& p, int l, int lsel, int tile, unsigned char* smem) {
    float* feat = (float*)smem;
    float* h1 = feat + 8 * 33;
    float* h2 = h1 + 8 * 64;
    const int tid = get_tid();
    const int L = lsel ? 2048 : 256;
    const int lag0 = tile * 8;
    const float Lf = (float)L;
    for (int e = tid; e < 8 * 33; e += 256) {
        int lg = e / 33, f = e % 33; float pos = (float)(lag0 + lg);
        float v;
        if (f == 0) v = pos / Lf;
        else {
            float w = 6.283185307179586f * pos / Lf;
            int bi = (f - 1) & 15; float band = 1e-4f + (float)bi * ((15.0f - 1e-4f) / 15.0f);
            v = (f <= 16) ? cosf(w * band) : sinf(w * band);
        }
        feat[e] = v;
    }
    __syncthreads();
    for (int e = tid; e < 8 * 64; e += 256) {
        int lg = e >> 6, j = e & 63; float s = p.in[I_HB1][l * 64 + j];
        for (int f = 0; f < 33; ++f) s += feat[lg * 33 + f] * p.in[I_HW1][(l * 33 + f) * 64 + j];
        h1[e] = sinf(p.in[I_HF1][l * 64 + j] * s);
    }
    __syncthreads();
    for (int e = tid; e < 8 * 64; e += 256) {
        int lg = e >> 6, j = e & 63; float s = p.in[I_HB2][l * 64 + j];
        for (int k = 0; k < 64; ++k) s += h1[lg * 64 + k] * p.in[I_HW2][(l * 64 + k) * 64 + j];
        h2[e] = sinf(p.in[I_HF2][l * 64 + j] * s);
    }
    __syncthreads();
    float acc[8][4];
#pragma unroll
    for (int a = 0; a < 8; ++a)
#pragma unroll
        for (int j = 0; j < 4; ++j) acc[a][j] = 0.f;
    const float* W3 = p.in[I_HW3] + (size_t)l * 64 * 1024 + 4 * tid;
#pragma unroll 4
    for (int k = 0; k < 64; ++k) {
        float4 w = *(const float4*)(W3 + k * 1024);
#pragma unroll
        for (int a = 0; a < 8; ++a) { float hv = h2[a * 64 + k]; acc[a][0] += hv * w.x; acc[a][1] += hv * w.y; acc[a][2] += hv * w.z; acc[a][3] += hv * w.w; }
    }
    float* HF = (float*)(p.ws + WS_HF) + (size_t)l * HF_LAYER + (lsel ? (size_t)256 * 1024 : 0);
    const float d0 = 15.350567286626973f, d1 = 3.0701134573253946f;
    float4 ps = make_float4(0.f, 0.f, 0.f, 0.f);
#pragma unroll
    for (int a = 0; a < 8; ++a) {
        float t = (float)(lag0 + a) / Lf;
        float4 o;
        float* op = (float*)&o;
#pragma unroll
        for (int j = 0; j < 4; ++j) {
            int ch = (4 * tid + j) & 255;
            float delta = d0 + (float)ch * ((d1 - d0) / 255.0f);
            op[j] = acc[a][j] * (expf(-t * delta) + 0.05f);
        }
        *(float4*)(HF + (size_t)(lag0 + a) * 1024 + 4 * tid) = o;
        const bool cnt = !(lag0 + a == 0 && 4 * tid >= 512);
        if (cnt) { ps.x += fabsf(o.x); ps.y += fabsf(o.y); ps.z += fabsf(o.z); ps.w += fabsf(o.w); }
    }
    *(float4*)((float*)(p.ws + WS_HPART) + ((size_t)l * 288 + (lsel ? 32 : 0) + tile) * 1024 + 4 * tid) = ps;
    __syncthreads();
}

DI void hynorm_item(const P& p, int l, int lsel, int cc, unsigned char* smem) {
    float* red = (float*)smem;
    const int tid = get_tid(), c = tid & 63, lg = tid >> 6;
    const int ntile = lsel ? 256 : 32;
    const float* PT = (const float*)(p.ws + WS_HPART) + ((size_t)l * 288 + (lsel ? 32 : 0)) * 1024;
    const int col = cc * 64 + c;
    float s = 0.f;
#pragma unroll 8
    for (int t = lg; t < ntile; t += 4) s += PT[(size_t)t * 1024 + col] + PT[(size_t)t * 1024 + 512 + col];
    red[lg * 64 + c] = s;
    __syncthreads();
    if (tid < 64) {
        float t = red[tid] + red[64 + tid] + red[128 + tid] + red[192 + tid];
        ((float*)(p.ws + WS_HNORM))[(l * 2 + lsel) * 512 + col] = 1.f / t;
    }
    __syncthreads();
}

DI void normmod_item(const P& p, int l, int item) {
    const int tid_ = get_tid(); const int lane = tid_ & 63, w = tid_ >> 6;
    float4 v[6][4]; float ss[6];
#pragma unroll
    for (int j = 0; j < 6; ++j) {
        const float* x = xrow(p, l, (item * 6 + j) * 4 + w);
        ss[j] = 0.f;
#pragma unroll
        for (int i = 0; i < 4; ++i) v[j][i] = *(const float4*)(x + lane * 4 + 256 * i);
    }
#pragma unroll
    for (int j = 0; j < 6; ++j) {
#pragma unroll
        for (int i = 0; i < 4; ++i) ss[j] += v[j][i].x * v[j][i].x + v[j][i].y * v[j][i].y + v[j][i].z * v[j][i].z + v[j][i].w * v[j][i].w;
#pragma unroll
        for (int o = 1; o < 64; o <<= 1) ss[j] += __shfl_xor(ss[j], o);
    }
#pragma unroll
    for (int j = 0; j < 6; ++j) {
        const int tok = (item * 6 + j) * 4 + w;
        const float r = rsqrtf(ss[j] * (1.f / 1024.f) + 1e-6f);
        const float* MOD = (const float*)(p.ws + WS_MOD) + (l * 3 + cond_of(tok)) * 3072;
        bf16_t* HB = (bf16_t*)(p.ws + WS_HB) + (size_t)tok * 1024;
#pragma unroll
        for (int i = 0; i < 4; ++i) {
            int c = lane * 4 + 256 * i;
            float4 nw = *(const float4*)(p.in[I_NORMW] + l * 1024 + c);
            float4 sh = *(const float4*)(MOD + c), sc = *(const float4*)(MOD + 1024 + c);
            bf16x4 o;
            o[0] = (short)f2bf(v[j][i].x * r * nw.x * (1.f + sc.x) + sh.x);
            o[1] = (short)f2bf(v[j][i].y * r * nw.y * (1.f + sc.y) + sh.y);
            o[2] = (short)f2bf(v[j][i].z * r * nw.z * (1.f + sc.z) + sh.z);
            o[3] = (short)f2bf(v[j][i].w * r * nw.w * (1.f + sc.w) + sh.w);
            *(bf16x4*)(HB + c) = o;
        }
    }
}

template <class Epi>
DI void gemm_tile(const bf16_t* __restrict__ A, int lda, const bf16_t* __restrict__ Bt, int ldb, int K, int m0, int n0,
                          unsigned char* smem, Epi epi) {
    bf16_t* As = (bf16_t*)smem;
    bf16_t* Bs = As + 128 * 72;
    const int tid = get_tid(), lane = tid & 63, w = tid >> 6;
    const int wm = w & 1, wn = w >> 1, lr = lane & 15, quad = lane >> 4;
    f32x4 acc[4][4];
#pragma unroll
    for (int a = 0; a < 4; ++a)
#pragma unroll
        for (int b = 0; b < 4; ++b) acc[a][b] = (f32x4){0.f, 0.f, 0.f, 0.f};
    u32x4 ra[4], rb[4], ra2[4], rb2[4];
    const bf16_t* Ag = A + (size_t)(m0 + (tid >> 3)) * lda + (tid & 7) * 8;
    const bf16_t* Bg = Bt + (size_t)(n0 + (tid >> 3)) * ldb + (tid & 7) * 8;
#pragma unroll
    for (int i = 0; i < 4; ++i) { ra[i] = *(const u32x4*)(Ag + (size_t)(32 * i) * lda); rb[i] = *(const u32x4*)(Bg + (size_t)(32 * i) * ldb); }
#pragma unroll
    for (int i = 0; i < 4; ++i) { ra2[i] = *(const u32x4*)(Ag + (size_t)(32 * i) * lda + 64); rb2[i] = *(const u32x4*)(Bg + (size_t)(32 * i) * ldb + 64); }
#define GEMM_STEP(RA, RB, KNEXT)                                                                                   \
    {                                                                                                                \
        _Pragma("unroll") for (int i = 0; i < 4; ++i) {                                                              \
            *(u32x4*)(As + ((tid >> 3) + 32 * i) * 72 + (tid & 7) * 8) = RA[i];                                      \
            *(u32x4*)(Bs + ((tid >> 3) + 32 * i) * 72 + (tid & 7) * 8) = RB[i];                                      \
        }                                                                                                            \
        __syncthreads();                                                                                             \
        if ((KNEXT) < K) {                                                                                           \
            _Pragma("unroll") for (int i = 0; i < 4; ++i) {                                                          \
                RA[i] = *(const u32x4*)(Ag + (size_t)(32 * i) * lda + (KNEXT));                                      \
                RB[i] = *(const u32x4*)(Bg + (size_t)(32 * i) * ldb + (KNEXT));                                      \
            }                                                                                                        \
        }                                                                                                            \
        _Pragma("unroll") for (int ks = 0; ks < 2; ++ks) {                                                           \
            bf16x8 af[4], bfr[4];                                                                                    \
            _Pragma("unroll") for (int t = 0; t < 4; ++t) {                                                          \
                af[t] = *(const bf16x8*)(As + (wm * 64 + t * 16 + lr) * 72 + ks * 32 + quad * 8);                    \
                bfr[t] = *(const bf16x8*)(Bs + (wn * 64 + t * 16 + lr) * 72 + ks * 32 + quad * 8);                   \
            }                                                                                                        \
            _Pragma("unroll") for (int nt = 0; nt < 4; ++nt)                                                         \
                _Pragma("unroll") for (int mt = 0; mt < 4; ++mt) acc[nt][mt] = MFMA16(bfr[nt], af[mt], acc[nt][mt]); \
        }                                                                                                            \
        __syncthreads();                                                                                             \
    }
    for (int k0 = 0; k0 < K; k0 += 128) {
        GEMM_STEP(ra, rb, k0 + 128)
        GEMM_STEP(ra2, rb2, k0 + 192)
    }
#undef GEMM_STEP
#pragma unroll
    for (int nt = 0; nt < 4; ++nt)
#pragma unroll
        for (int mt = 0; mt < 4; ++mt) epi(m0 + wm * 64 + mt * 16 + lr, n0 + wn * 64 + nt * 16 + quad * 4, acc[nt][mt]);
}

struct EpiProj {
    bf16_t* out; bf16_t* zt;
    DI void operator()(int row, int col, f32x4 v) const {
        bf16x4 o; o[0] = (short)f2bf(v[0]); o[1] = (short)f2bf(v[1]); o[2] = (short)f2bf(v[2]); o[3] = (short)f2bf(v[3]);
        if (col >= C_HY && col < C_HY + 768) {
#pragma unroll
            for (int j = 0; j < 4; ++j) zt[(size_t)(col - C_HY + j) * NTOK + row] = (bf16_t)o[j];
        } else *(bf16x4*)(out + (size_t)row * NIN + col) = o;
    }
};
struct EpiOut {
    const P* p; int l;
    DI void operator()(int row, int col, f32x4 v) const {
        const float* xr = xrow(*p, l, row);
        float4 x = *(const float4*)(xr + col);
        const float* gate = (const float*)(p->ws + WS_MOD) + (l * 3 + cond_of(row)) * 3072 + 2048 + col;
        float4 g = *(const float4*)gate;
        float4 o; o.x = x.x + g.x * v[0]; o.y = x.y + g.y * v[1]; o.z = x.z + g.z * v[2]; o.w = x.w + g.w * v[3];
        *(float4*)(p->out + (size_t)row * DM + col) = o;
    }
};
struct EpiGlu {
    const P* p; int l;
    DI void operator()(int row, int col, f32x4 v) const {
        const bf16_t* GS5 = (const bf16_t*)(p->ws + WS_GS5) + (size_t)row * 256 + col;
        const bf16_t* PR = (const bf16_t*)(p->ws + WS_PROJ) + (size_t)row * NIN + C_GS5 + col;
        bf16x4 gg = *(const bf16x4*)GS5, gs = *(const bf16x4*)PR;
        float4 b = *(const float4*)(p->in[I_GLUB] + l * 256 + col);
        const float bb[4] = {b.x, b.y, b.z, b.w};
        bf16x4 o;
#pragma unroll
        for (int j = 0; j < 4; ++j) { float g = bf2f((bf16_t)gg[j]); o[j] = (short)f2bf(g * sigmoidf_(v[j] + bb[j]) * siluf_(bf2f((bf16_t)gs[j]))); }
        *(bf16x4*)((bf16_t*)(p->ws + WS_HB) + (size_t)row * 1024 + 512 + col) = o;
    }
};

DI void mlaprep_item(const P& p, int l, int item, unsigned char* smem) {
    bf16_t* Aq = (bf16_t*)smem;
    bf16_t* Akv = Aq + 32 * 200;
    float* R = (float*)(Akv + 32 * 136);
    float* kr = R + 32 * 132;
    float* kn = kr + 32 * 32;
    float* cst = kn + 32 * 32;
    float* snt = cst + 32 * 16;
    const int tid = get_tid(), lane = tid & 63, w = tid >> 6, lr = lane & 15, quad = lane >> 4;
    const bool is_cache = item >= 384;
    int tok0 = 0, cb = 0, r0 = 0;
    if (!is_cache) tok0 = item * 32; else { cb = (item - 384) >> 4; r0 = ((item - 384) & 15) * 32; }
    const bool is_lat = !is_cache && tok0 >= NCTX;
    const bool do_rope = is_lat;
    int kbase, nkeys, kin0;
    if (is_cache) { kbase = 8192 + 2560 * cb; nkeys = 2560; kin0 = r0; }
    else if (is_lat) { int b = (tok0 - NCTX) >> 11; kbase = 8192 + 2560 * b; nkeys = 2560; kin0 = 512 + ((tok0 - NCTX) & 2047); }
    else { kbase = tok0 & ~255; nkeys = 256; kin0 = tok0 & 255; }
    const bf16_t* PR = (const bf16_t*)(p.ws + WS_PROJ);
    {
        const int t = tid >> 3, part = tid & 7;
        if (!is_cache) {
            const bf16_t* row = PR + (size_t)(tok0 + t) * NIN;
            const int tok = tok0 + t;
            {
                bf16x8 q[3];
#pragma unroll
                for (int c = 0; c < 3; ++c) q[c] = *(const bf16x8*)(row + C_CQ + part * 24 + 8 * c);
                float ss = 0.f;
#pragma unroll
                for (int c = 0; c < 3; ++c)
#pragma unroll
                    for (int j = 0; j < 8; ++j) { float x = bf2f((bf16_t)q[c][j]); ss += x * x; }
                ss += __shfl_xor(ss, 1); ss += __shfl_xor(ss, 2); ss += __shfl_xor(ss, 4);
                const float rq = rsqrtf(ss * (1.f / 192.f) + 1e-6f);
                const float4* wq4 = (const float4*)(p.in[I_QAN] + l * 192 + part * 24);
#pragma unroll
                for (int c = 0; c < 3; ++c) {
                    float4 w0 = wq4[2 * c], w1 = wq4[2 * c + 1];
                    bf16x8 o;
                    o[0] = (short)f2bf(bf2f((bf16_t)q[c][0]) * rq * w0.x); o[1] = (short)f2bf(bf2f((bf16_t)q[c][1]) * rq * w0.y);
                    o[2] = (short)f2bf(bf2f((bf16_t)q[c][2]) * rq * w0.z); o[3] = (short)f2bf(bf2f((bf16_t)q[c][3]) * rq * w0.w);
                    o[4] = (short)f2bf(bf2f((bf16_t)q[c][4]) * rq * w1.x); o[5] = (short)f2bf(bf2f((bf16_t)q[c][5]) * rq * w1.y);
                    o[6] = (short)f2bf(bf2f((bf16_t)q[c][6]) * rq * w1.z); o[7] = (short)f2bf(bf2f((bf16_t)q[c][7]) * rq * w1.w);
                    *(bf16x8*)(Aq + t * 200 + part * 24 + 8 * c) = o;
                }
            }
            {
                bf16x8 k[2];
#pragma unroll
                for (int c = 0; c < 2; ++c) k[c] = *(const bf16x8*)(row + C_CKV + part * 16 + 8 * c);
                float ss = 0.f;
#pragma unroll
                for (int c = 0; c < 2; ++c)
#pragma unroll
                    for (int j = 0; j < 8; ++j) { float x = bf2f((bf16_t)k[c][j]); ss += x * x; }
                ss += __shfl_xor(ss, 1); ss += __shfl_xor(ss, 2); ss += __shfl_xor(ss, 4);
                const float rk = rsqrtf(ss * (1.f / 128.f) + 1e-6f);
                const float4* wk4 = (const float4*)(p.in[I_KVAN] + l * 128 + part * 16);
                float* oc = p.out + OFF_CKV + ((size_t)((tok >> 8) * 2 + l) * 256 + (tok & 255)) * 128 + part * 16;
#pragma unroll
                for (int c = 0; c < 2; ++c) {
                    float4 w0 = wk4[2 * c], w1 = wk4[2 * c + 1];
                    float4 v0, v1;
                    v0.x = bf2f((bf16_t)k[c][0]) * rk * w0.x; v0.y = bf2f((bf16_t)k[c][1]) * rk * w0.y;
                    v0.z = bf2f((bf16_t)k[c][2]) * rk * w0.z; v0.w = bf2f((bf16_t)k[c][3]) * rk * w0.w;
                    v1.x = bf2f((bf16_t)k[c][4]) * rk * w1.x; v1.y = bf2f((bf16_t)k[c][5]) * rk * w1.y;
                    v1.z = bf2f((bf16_t)k[c][6]) * rk * w1.z; v1.w = bf2f((bf16_t)k[c][7]) * rk * w1.w;
                    bf16x8 o;
                    o[0] = (short)f2bf(v0.x); o[1] = (short)f2bf(v0.y); o[2] = (short)f2bf(v0.z); o[3] = (short)f2bf(v0.w);
                    o[4] = (short)f2bf(v1.x); o[5] = (short)f2bf(v1.y); o[6] = (short)f2bf(v1.z); o[7] = (short)f2bf(v1.w);
                    *(bf16x8*)(Akv + t * 136 + part * 16 + 8 * c) = o;
                    if (!is_lat) { *(float4*)(oc + 8 * c) = v0; *(float4*)(oc + 8 * c + 4) = v1; }
                }
            }
            {
                bf16x4 r4 = *(const bf16x4*)(row + C_KR + part * 4);
                float4 v = make_float4(bf2f((bf16_t)r4[0]), bf2f((bf16_t)r4[1]), bf2f((bf16_t)r4[2]), bf2f((bf16_t)r4[3]));
                *(float4*)(kr + t * 32 + part * 4) = v;
                if (!is_lat) *(float4*)(p.out + OFF_KR + ((size_t)((tok >> 8) * 2 + l) * 256 + (tok & 255)) * 32 + part * 4) = v;
            }
        } else {
            const float4* ck = (const float4*)(p.in[I_CCKV] + ((size_t)(cb * 2 + l) * 512 + r0 + t) * 128 + part * 16);
            const float4* ckr = (const float4*)(p.in[I_CKR] + ((size_t)(cb * 2 + l) * 512 + r0 + t) * 32 + part * 4);
#pragma unroll
            for (int c = 0; c < 2; ++c) {
                float4 v0 = ck[2 * c], v1 = ck[2 * c + 1];
                bf16x8 o;
                o[0] = (short)f2bf(v0.x); o[1] = (short)f2bf(v0.y); o[2] = (short)f2bf(v0.z); o[3] = (short)f2bf(v0.w);
                o[4] = (short)f2bf(v1.x); o[5] = (short)f2bf(v1.y); o[6] = (short)f2bf(v1.z); o[7] = (short)f2bf(v1.w);
                *(bf16x8*)(Akv + t * 136 + part * 16 + 8 * c) = o;
            }
            *(float4*)(kr + t * 32 + part * 4) = ckr[0];
        }
        if (do_rope) {
            for (int e = tid; e < 32 * 16; e += 256) {
                int tt = e >> 4, a = e & 15; int pos = (tok0 - NCTX + tt) & 2047;
                float pp = (a < 8) ? (float)(pos >> 6) : (float)(pos & 63);
                float inv = powf(10000.f, -(float)(a & 7) * 0.125f);
                float ang = pp * inv;
                cst[e] = cosf(ang); snt[e] = sinf(ang);
            }
        }
    }
    __syncthreads();
    const int mt = w & 1, nh = w >> 1;
    const float qscale = 0.10206207261596577f * 1.4426950408889634f;
    for (int h = 0; h < 4; ++h) {
        if (!is_cache) {
            f32x4 acc[3];
#pragma unroll
            for (int i = 0; i < 3; ++i) acc[i] = (f32x4){0.f, 0.f, 0.f, 0.f};
            const bf16_t* W = (const bf16_t*)(p.ws + WS_WTUQ) + (size_t)l * 384 * 192 + (size_t)(96 * h + 48 * nh + lr) * 192 + quad * 8;
#pragma unroll
            for (int ks = 0; ks < 6; ++ks) {
                bf16x8 xf = *(const bf16x8*)(Aq + (16 * mt + lr) * 200 + 32 * ks + quad * 8);
#pragma unroll
                for (int i = 0; i < 3; ++i) { bf16x8 wf = *(const bf16x8*)(W + (size_t)(16 * i) * 192 + 32 * ks); acc[i] = MFMA16(wf, xf, acc[i]); }
            }
#pragma unroll
            for (int i = 0; i < 3; ++i) *(f32x4*)(R + (16 * mt + lr) * 132 + 48 * nh + 16 * i + quad * 4) = acc[i];
            __syncthreads();
            {
                const int t = tid >> 3, part = tid & 7;
                float4* rp = (float4*)(R + t * 132 + part * 12);
                float4 x0 = rp[0], x1 = rp[1], x2 = rp[2];
                float ss = x0.x * x0.x + x0.y * x0.y + x0.z * x0.z + x0.w * x0.w + x1.x * x1.x + x1.y * x1.y + x1.z * x1.z + x1.w * x1.w
                         + x2.x * x2.x + x2.y * x2.y + x2.z * x2.z + x2.w * x2.w;
                ss += __shfl_xor(ss, 1); ss += __shfl_xor(ss, 2); ss += __shfl_xor(ss, 4);
                float r = rsqrtf(ss * (1.f / 96.f) + 1e-6f);
                const float4* wn = (const float4*)(p.in[I_QN] + l * 96 + part * 12);
                float4 w0 = wn[0], w1 = wn[1], w2 = wn[2];
                rp[0] = make_float4(x0.x * r * w0.x, x0.y * r * w0.y, x0.z * r * w0.z, x0.w * r * w0.w);
                rp[1] = make_float4(x1.x * r * w1.x, x1.y * r * w1.y, x1.z * r * w1.z, x1.w * r * w1.w);
                rp[2] = make_float4(x2.x * r * w2.x, x2.y * r * w2.y, x2.z * r * w2.z, x2.w * r * w2.w);
            }
            __syncthreads();
            {
                const int t = tid >> 3, part = tid & 7;
                bf16_t* Qo = (bf16_t*)(p.ws + WS_QB) + ((size_t)h * NTOK + tok0 + t) * 96;
                bf16_t qv[12];
#pragma unroll
                for (int j = 0; j < 12; ++j) {
                    int n = part * 12 + j; float v;
                    if (n < 64 || !do_rope) v = R[t * 132 + n];
                    else {
                        int i = (n - 64) & 7, half = ((n - 64) >> 3) & 1, ax = (n - 64) >> 4;
                        float x1 = R[t * 132 + 64 + 16 * ax + i], x2 = R[t * 132 + 64 + 16 * ax + 8 + i];
                        float c = cst[t * 16 + ax * 8 + i], s = snt[t * 16 + ax * 8 + i];
                        v = half == 0 ? x1 * c - x2 * s : x2 * c + x1 * s;
                    }
                    qv[j] = f2bf(v * qscale);
                }
#pragma unroll
                for (int c = 0; c < 3; ++c) { bf16x4 o; o[0] = (short)qv[4 * c]; o[1] = (short)qv[4 * c + 1]; o[2] = (short)qv[4 * c + 2]; o[3] = (short)qv[4 * c + 3]; *(bf16x4*)(Qo + part * 12 + 4 * c) = o; }
            }
            __syncthreads();
        }
        {
            f32x4 acc[4];
#pragma unroll
            for (int i = 0; i < 4; ++i) acc[i] = (f32x4){0.f, 0.f, 0.f, 0.f};
            const bf16_t* W = (const bf16_t*)(p.ws + WS_WTUKV) + (size_t)l * 512 * 128 + (size_t)(128 * h + 64 * nh + lr) * 128 + quad * 8;
#pragma unroll
            for (int ks = 0; ks < 4; ++ks) {
                bf16x8 xf = *(const bf16x8*)(Akv + (16 * mt + lr) * 136 + 32 * ks + quad * 8);
#pragma unroll
                for (int i = 0; i < 4; ++i) { bf16x8 wf = *(const bf16x8*)(W + (size_t)(16 * i) * 128 + 32 * ks); acc[i] = MFMA16(wf, xf, acc[i]); }
            }
#pragma unroll
            for (int i = 0; i < 4; ++i) *(f32x4*)(R + (16 * mt + lr) * 132 + 64 * nh + 16 * i + quad * 4) = acc[i];
        }
        __syncthreads();
        {
            const int t = tid >> 3, part = tid & 7;
            float4* rp = (float4*)(R + t * 132 + part * 8);
            float4 x0 = rp[0], x1 = rp[1], x2 = *(const float4*)(kr + t * 32 + part * 4);
            float ss = x0.x * x0.x + x0.y * x0.y + x0.z * x0.z + x0.w * x0.w + x1.x * x1.x + x1.y * x1.y + x1.z * x1.z + x1.w * x1.w
                     + x2.x * x2.x + x2.y * x2.y + x2.z * x2.z + x2.w * x2.w;
            ss += __shfl_xor(ss, 1); ss += __shfl_xor(ss, 2); ss += __shfl_xor(ss, 4);
            float r = rsqrtf(ss * (1.f / 96.f) + 1e-6f);
            const float4* wn = (const float4*)(p.in[I_KN] + l * 96 + part * 8);
            float4 w0 = wn[0], w1 = wn[1], w2 = *(const float4*)(p.in[I_KN] + l * 96 + 64 + part * 4);
            rp[0] = make_float4(x0.x * r * w0.x, x0.y * r * w0.y, x0.z * r * w0.z, x0.w * r * w0.w);
            rp[1] = make_float4(x1.x * r * w1.x, x1.y * r * w1.y, x1.z * r * w1.z, x1.w * r * w1.w);
            *(float4*)(kn + t * 32 + part * 4) = make_float4(x2.x * r * w2.x, x2.y * r * w2.y, x2.z * r * w2.z, x2.w * r * w2.w);
        }
        __syncthreads();
        {
            const int t = tid >> 3, part = tid & 7;
            bf16_t* Ko = (bf16_t*)(p.ws + WS_KB) + ((size_t)h * NKT + kbase + kin0 + t) * 96;
            bf16_t kv[12];
#pragma unroll
            for (int j = 0; j < 12; ++j) {
                int n = part * 12 + j; float v;
                if (n < 64) v = R[t * 132 + n];
                else if (!do_rope) v = kn[t * 32 + n - 64];
                else {
                    int i = (n - 64) & 7, half = ((n - 64) >> 3) & 1, ax = (n - 64) >> 4;
                    float x1 = kn[t * 32 + 16 * ax + i], x2 = kn[t * 32 + 16 * ax + 8 + i];
                    float c = cst[t * 16 + ax * 8 + i], s = snt[t * 16 + ax * 8 + i];
                    v = half == 0 ? x1 * c - x2 * s : x2 * c + x1 * s;
                }
                kv[j] = f2bf(v);
            }
#pragma unroll
            for (int c = 0; c < 3; ++c) { bf16x4 o; o[0] = (short)kv[4 * c]; o[1] = (short)kv[4 * c + 1]; o[2] = (short)kv[4 * c + 2]; o[3] = (short)kv[4 * c + 3]; *(bf16x4*)(Ko + part * 12 + 4 * c) = o; }
            const int dv = tid & 63, tg = tid >> 6;
            bf16x8 o;
#pragma unroll
            for (int j = 0; j < 8; ++j) o[j] = (short)f2bf(R[(tg * 8 + j) * 132 + 64 + dv]);
            bf16_t* Vo = (bf16_t*)(p.ws + WS_VT) + ((size_t)h * NKT + kbase) * 64 + (size_t)dv * nkeys + kin0 + tg * 8;
            *(bf16x8*)Vo = o;
        }
        __syncthreads();
    }
}

DI void attn_item(const P& p, int l, int item, unsigned char* smem) {
    bf16_t* Ks = (bf16_t*)smem;
    bf16_t* Vs = Ks + 64 * 104;
    const int tid = get_tid(), lane = tid & 63, w = tid >> 6, lr = lane & 15, quad = lane >> 4;
    int seq, h, qb;
    if (item < 128) { seq = 32 + (item >> 6); h = (item >> 4) & 3; qb = item & 15; }
    else { int j = item - 128; seq = j >> 3; h = (j >> 1) & 3; qb = j & 1; }
    int tokbase, nkeys, kbase;
    if (seq < 32) { tokbase = 256 * seq; nkeys = 256; kbase = 256 * seq; }
    else { tokbase = NCTX + 2048 * (seq - 32); nkeys = 2560; kbase = 8192 + 2560 * (seq - 32); }
    const bf16_t* Qp = (const bf16_t*)(p.ws + WS_QB) + ((size_t)h * NTOK + tokbase + qb * 128 + 32 * w) * 96;
    const bf16_t* Kp = (const bf16_t*)(p.ws + WS_KB) + ((size_t)h * NKT + kbase) * 96;
    const bf16_t* Vp = (const bf16_t*)(p.ws + WS_VT) + ((size_t)h * NKT + kbase) * 64;
    bf16x8 qf[2][3];
#pragma unroll
    for (int nt = 0; nt < 2; ++nt)
#pragma unroll
        for (int ks = 0; ks < 3; ++ks) qf[nt][ks] = *(const bf16x8*)(Qp + (16 * nt + lr) * 96 + 32 * ks + 8 * quad);
    f32x4 o[4][2];
#pragma unroll
    for (int a = 0; a < 4; ++a)
#pragma unroll
        for (int b = 0; b < 2; ++b) o[a][b] = (f32x4){0.f, 0.f, 0.f, 0.f};
    float mrow[2] = {-1e30f, -1e30f}, lsum[2] = {0.f, 0.f};
    u32x4 rk[3], rv[2];
    const int ntile = nkeys >> 6;
#pragma unroll
    for (int i = 0; i < 3; ++i) { int c = tid + 256 * i; rk[i] = *(const u32x4*)(Kp + (size_t)(c / 12) * 96 + (c % 12) * 8); }
#pragma unroll
    for (int i = 0; i < 2; ++i) { int c = tid + 256 * i; rv[i] = *(const u32x4*)(Vp + (size_t)(c >> 3) * nkeys + (c & 7) * 8); }
    for (int kt = 0; kt < ntile; ++kt) {
#pragma unroll
        for (int i = 0; i < 3; ++i) { int c = tid + 256 * i; *(u32x4*)(Ks + (c / 12) * 104 + (c % 12) * 8) = rk[i]; }
#pragma unroll
        for (int i = 0; i < 2; ++i) { int c = tid + 256 * i; *(u32x4*)(Vs + (c >> 3) * 72 + (c & 7) * 8) = rv[i]; }
        __syncthreads();
        if (kt + 1 < ntile) {
#pragma unroll
            for (int i = 0; i < 3; ++i) { int c = tid + 256 * i; rk[i] = *(const u32x4*)(Kp + (size_t)((kt + 1) * 64 + c / 12) * 96 + (c % 12) * 8); }
#pragma unroll
            for (int i = 0; i < 2; ++i) { int c = tid + 256 * i; rv[i] = *(const u32x4*)(Vp + (size_t)(c >> 3) * nkeys + (kt + 1) * 64 + (c & 7) * 8); }
        }
        f32x4 s[4][2];
#pragma unroll
        for (int a = 0; a < 4; ++a)
#pragma unroll
            for (int b = 0; b < 2; ++b) s[a][b] = (f32x4){0.f, 0.f, 0.f, 0.f};
#pragma unroll
        for (int ks = 0; ks < 3; ++ks)
#pragma unroll
            for (int mt = 0; mt < 4; ++mt) {
                bf16x8 kf = *(const bf16x8*)(Ks + (16 * mt + lr) * 104 + 32 * ks + 8 * quad);
#pragma unroll
                for (int nt = 0; nt < 2; ++nt) s[mt][nt] = MFMA16(kf, qf[nt][ks], s[mt][nt]);
            }
        bf16x8 pf[2][2];
#pragma unroll
        for (int nt = 0; nt < 2; ++nt) {
            float mx = -1e30f;
#pragma unroll
            for (int mt = 0; mt < 4; ++mt)
#pragma unroll
                for (int j = 0; j < 4; ++j) mx = fmaxf(mx, s[mt][nt][j]);
            mx = fmaxf(mx, __shfl_xor(mx, 16)); mx = fmaxf(mx, __shfl_xor(mx, 32));
            float mnew = fmaxf(mrow[nt], mx);
            float alpha = __builtin_amdgcn_exp2f(mrow[nt] - mnew);
            mrow[nt] = mnew;
            float rs = 0.f;
#pragma unroll
            for (int mt = 0; mt < 4; ++mt)
#pragma unroll
                for (int j = 0; j < 4; ++j) { float pv = __builtin_amdgcn_exp2f(s[mt][nt][j] - mnew); s[mt][nt][j] = pv; rs += pv; }
            lsum[nt] = lsum[nt] * alpha + rs;
#pragma unroll
            for (int dt = 0; dt < 4; ++dt) { o[dt][nt][0] *= alpha; o[dt][nt][1] *= alpha; o[dt][nt][2] *= alpha; o[dt][nt][3] *= alpha; }
#pragma unroll
            for (int kk = 0; kk < 2; ++kk)
                pf[kk][nt] = pack8_hw(s[2 * kk][nt][0], s[2 * kk][nt][1], s[2 * kk][nt][2], s[2 * kk][nt][3],
                                      s[2 * kk + 1][nt][0], s[2 * kk + 1][nt][1], s[2 * kk + 1][nt][2], s[2 * kk + 1][nt][3]);
        }
#pragma unroll
        for (int kk = 0; kk < 2; ++kk)
#pragma unroll
            for (int dt = 0; dt < 4; ++dt) {
                bf16x4 lo = *(const bf16x4*)(Vs + (16 * dt + lr) * 72 + 32 * kk + 4 * quad);
                bf16x4 hi = *(const bf16x4*)(Vs + (16 * dt + lr) * 72 + 32 * kk + 16 + 4 * quad);
                bf16x8 vf = __builtin_shufflevector(lo, hi, 0, 1, 2, 3, 4, 5, 6, 7);
#pragma unroll
                for (int nt = 0; nt < 2; ++nt) o[dt][nt] = MFMA16(vf, pf[kk][nt], o[dt][nt]);
            }
        __syncthreads();
    }
    const bf16_t* PR = (const bf16_t*)(p.ws + WS_PROJ);
    bf16_t* HB = (bf16_t*)(p.ws + WS_HB);
#pragma unroll
    for (int nt = 0; nt < 2; ++nt) {
        float lt = lsum[nt]; lt += __shfl_xor(lt, 16); lt += __shfl_xor(lt, 32);
        float inv = 1.f / lt;
        int tok = tokbase + qb * 128 + 32 * w + 16 * nt + lr;
#pragma unroll
        for (int dt = 0; dt < 4; ++dt) {
            int col = h * 64 + 16 * dt + 4 * quad;
            bf16x4 g = *(const bf16x4*)(PR + (size_t)tok * NIN + C_GMLA + col);
            bf16x4 ov;
#pragma unroll
            for (int j = 0; j < 4; ++j) ov[j] = (short)f2bf(o[dt][nt][j] * inv * siluf_(bf2f((bf16_t)g[j])));
            *(bf16x4*)(HB + (size_t)tok * 1024 + col) = ov;
        }
    }
}

DI void rt_item(const P& p, int item, unsigned char* smem) {
    float* tile = (float*)smem;
    const int tid = get_tid();
    int l = item / 576, r = item % 576;
    int order = r / 288; r %= 288;
    int cht = r / 72, xt = r % 72;
    const int lsel = xt >= 8 ? 1 : 0; if (lsel) xt -= 8;
    const int L = lsel ? 2048 : 256, x0 = xt * 64, ch0 = cht * 64;
    const float* HF = (const float*)(p.ws + WS_HF) + (size_t)l * HF_LAYER + (lsel ? (size_t)256 * 1024 : 0) + order * 256 + ch0;
    const float* HN = (const float*)(p.ws + WS_HNORM) + (l * 2 + lsel) * 512 + order * 256 + ch0;
#pragma unroll
    for (int i = 0; i < 16; ++i) {
        int e = tid + 256 * i; int xx = e >> 6, cc = e & 63;
        int d = L - 1 - (x0 + xx);
        float v = 0.f;
        if (d >= 0) v = HF[(size_t)d * 1024 + cc]; else if (d > -L) v = HF[(size_t)(-d) * 1024 + 512 + cc];
        tile[xx * 65 + cc] = v * HN[cc];
    }
    __syncthreads();
    bf16_t* RT = lsel ? (bf16_t*)(p.ws + WS_RTL) + ((size_t)(l * 2 + order) * 256 + ch0) * 4096 : (bf16_t*)(p.ws + WS_RTC) + ((size_t)(l * 2 + order) * 256 + ch0) * 512;
    const int XL = 2 * L;
#pragma unroll
    for (int i = 0; i < 16; ++i) { int e = tid + 256 * i; int cc = e >> 6, xx = e & 63; RT[(size_t)cc * XL + x0 + xx] = f2bf(tile[xx * 65 + cc]); }
    __syncthreads();
}

DI void hy_short4(const P& p, int l, int ch768, int tokseq0, int L, int t, float* o) {
    const bf16_t* Z = (const bf16_t*)(p.ws + WS_ZT) + (size_t)ch768 * NTOK + tokseq0 + t;
    const float* cw = p.in[I_HCW] + l * 3 * 768 + ch768;
    const float w0 = cw[0], w1 = cw[768], w2 = cw[1536], bb = p.in[I_HCB][l * 768 + ch768];
    bf16x4 m = *(const bf16x4*)Z;
    const float zm = t > 0 ? bf2f(Z[-1]) : 0.f;
    const float z0 = bf2f((bf16_t)m[0]), z1 = bf2f((bf16_t)m[1]), z2 = bf2f((bf16_t)m[2]), z3 = bf2f((bf16_t)m[3]);
    const float zp = t + 4 < L ? bf2f(Z[4]) : 0.f;
    o[0] = bb + w0 * zm + w1 * z0 + w2 * z1;
    o[1] = bb + w0 * z0 + w1 * z1 + w2 * z2;
    o[2] = bb + w0 * z1 + w1 * z2 + w2 * z3;
    o[3] = bb + w0 * z2 + w1 * z3 + w2 * zp;
}
DI bf16x8 hy_short8(const P& p, int l, int ch768, int tokseq0, int L, int t) {
    const bf16_t* Z = (const bf16_t*)(p.ws + WS_ZT) + (size_t)ch768 * NTOK + tokseq0 + t;
    const float* cw = p.in[I_HCW] + l * 3 * 768 + ch768;
    const float w0 = cw[0], w1 = cw[768], w2 = cw[1536], bb = p.in[I_HCB][l * 768 + ch768];
    bf16x8 m = *(const bf16x8*)Z;
    const float zm = t > 0 ? bf2f(Z[-1]) : 0.f;
    const float z0 = bf2f((bf16_t)m[0]), z1 = bf2f((bf16_t)m[1]), z2 = bf2f((bf16_t)m[2]), z3 = bf2f((bf16_t)m[3]);
    const float z4 = bf2f((bf16_t)m[4]), z5 = bf2f((bf16_t)m[5]), z6 = bf2f((bf16_t)m[6]), z7 = bf2f((bf16_t)m[7]);
    const float zp = t + 8 < L ? bf2f(Z[8]) : 0.f;
    bf16x8 o;
    o[0] = (short)f2bf(bb + w0 * zm + w1 * z0 + w2 * z1);
    o[1] = (short)f2bf(bb + w0 * z0 + w1 * z1 + w2 * z2);
    o[2] = (short)f2bf(bb + w0 * z1 + w1 * z2 + w2 * z3);
    o[3] = (short)f2bf(bb + w0 * z2 + w1 * z3 + w2 * z4);
    o[4] = (short)f2bf(bb + w0 * z3 + w1 * z4 + w2 * z5);
    o[5] = (short)f2bf(bb + w0 * z4 + w1 * z5 + w2 * z6);
    o[6] = (short)f2bf(bb + w0 * z5 + w1 * z6 + w2 * z7);
    o[7] = (short)f2bf(bb + w0 * z6 + w1 * z7 + w2 * zp);
    return o;
}

DI void hy2_item(const P& p, int l, int which, int item, unsigned char* smem) {
    const int tid = get_tid(), lane = tid & 63, w = tid >> 6, lr = lane & 15, quad = lane >> 4;
    const bool lat = item < 256;
    const int c = lat ? item : item - 256;
    const int XL = lat ? 4096 : 512;
    unsigned* c0 = (unsigned*)smem;
    unsigned* c1 = c0 + 2048 + 16;
    bf16_t* U = (bf16_t*)(c1 + 2048 + 16);
    const bf16_t* RT = lat ? (const bf16_t*)(p.ws + WS_RTL) + ((size_t)(l * 2 + which) * 256 + c) * 4096
                           : (const bf16_t*)(p.ws + WS_RTC) + ((size_t)(l * 2 + which) * 256 + c) * 512;
    const bf16_t* Y1T = (const bf16_t*)(p.ws + WS_Y1T) + (size_t)c * NTOK;
    for (int i = tid; i < XL / 8; i += 256) *(u32x4*)(c0 + 4 * i) = *(const u32x4*)(RT + 8 * i);
    if (lat) {
        for (int i = tid; i < 2 * 64 * 72 / 8; i += 256) *(u32x4*)(U + 8 * i) = (u32x4){0u, 0u, 0u, 0u};
    }
    __syncthreads();
    for (int i = tid; i < XL / 2; i += 256) { unsigned lo = c0[i], hi = (i + 1 < XL / 2) ? c0[i + 1] : 0u; c1[i] = (lo >> 16) | (hi << 16); }
    if (lat) {
        for (int i = tid; i < 512; i += 256) {
            int b = i >> 8, t = (i & 255) * 8;
            bf16x8 v = which == 0 ? hy_short8(p, l, c, NCTX + 2048 * b, 2048, t) : *(const bf16x8*)(Y1T + NCTX + 2048 * b + t);
            *(bf16x8*)(U + (size_t)(b * 64 + 16 + (t >> 6)) * 72 + (t & 63)) = v;
        }
    } else {
        for (int i = tid; i < 1024; i += 256) {
            int b = i >> 5, t = (i & 31) * 8;
            bf16x8 v = which == 0 ? hy_short8(p, l, c, 256 * b, 256, t) : *(const bf16x8*)(Y1T + 256 * b + t);
            *(bf16x8*)(U + b * 264 + t) = v;
        }
    }
    __syncthreads();
    const float bias = p.in[I_HBIAS][(l * 2 + which) * 256 + c];
    bf16_t* OT = (which == 0 ? (bf16_t*)(p.ws + WS_Y1T) : (bf16_t*)(p.ws + WS_OUTT)) + (size_t)c * NTOK;
    const int xch = (which == 0 ? 256 : 512) + c;
    const int par = (lr + 1) & 1;
    const unsigned* cp = par ? c1 : c0;
    if (lat) {
        const int b = w >> 1, ih = w & 1;
        const int lane_dw = (2047 - lr - par) / 2 + 4 * quad;
        f32x4 acc[4];
#pragma unroll
        for (int i = 0; i < 4; ++i) acc[i] = (f32x4){0.f, 0.f, 0.f, 0.f};
        const int dlo = ih ? -15 : -31, dhi = ih ? 31 : 15;
        for (int dl = dlo; dl <= dhi; ++dl) {
#pragma unroll
            for (int ks = 0; ks < 2; ++ks) {
                bf16x8 bfr = *(const bf16x8*)(U + (size_t)(b * 64 + 16 + 16 * ih + lr - dl) * 72 + 32 * ks + 8 * quad);
#pragma unroll
                for (int mt = 0; mt < 4; ++mt) {
                    const unsigned* ap = cp + lane_dw - 32 * dl - 8 * mt + 16 * ks;
                    u32x4 av; av[0] = ap[0]; av[1] = ap[1]; av[2] = ap[2]; av[3] = ap[3];
                    acc[mt] = MFMA16(__builtin_bit_cast(bf16x8, av), bfr, acc[mt]);
                }
            }
        }
        const int tokseq0 = NCTX + 2048 * b;
#pragma unroll
        for (int mt = 0; mt < 4; ++mt) {
            const int t = 64 * (16 * ih + lr) + 16 * mt + 4 * quad;
            float x[4]; hy_short4(p, l, xch, tokseq0, 2048, t, x);
            bf16x4 uu = *(const bf16x4*)(U + (size_t)(b * 64 + 16 + (t >> 6)) * 72 + (t & 63));
            bf16x4 o;
#pragma unroll
            for (int j = 0; j < 4; ++j) o[j] = (short)f2bf(x[j] * (acc[mt][j] + bias * bf2f((bf16_t)uu[j])));
            *(bf16x4*)(OT + tokseq0 + t) = o;
        }
    } else {
        const int lane_dw = (255 - lr - par) / 2 + 4 * quad;
        f32x4 acc[4][2];
#pragma unroll
        for (int i = 0; i < 4; ++i) { acc[i][0] = (f32x4){0.f, 0.f, 0.f, 0.f}; acc[i][1] = (f32x4){0.f, 0.f, 0.f, 0.f}; }
#pragma unroll 2
        for (int ks = 0; ks < 8; ++ks) {
            bf16x8 b0 = *(const bf16x8*)(U + lr * 264 + 32 * ks + 8 * quad);
            bf16x8 b1 = *(const bf16x8*)(U + (16 + lr) * 264 + 32 * ks + 8 * quad);
#pragma unroll
            for (int mi = 0; mi < 4; ++mi) {
                const unsigned* ap = cp + lane_dw - 8 * (4 * w + mi) + 16 * ks;
                u32x4 av; av[0] = ap[0]; av[1] = ap[1]; av[2] = ap[2]; av[3] = ap[3];
                bf16x8 af = __builtin_bit_cast(bf16x8, av);
                acc[mi][0] = MFMA16(af, b0, acc[mi][0]);
                acc[mi][1] = MFMA16(af, b1, acc[mi][1]);
            }
        }
#pragma unroll
        for (int mi = 0; mi < 4; ++mi)
#pragma unroll
            for (int nt = 0; nt < 2; ++nt) {
                const int b = 16 * nt + lr, t = 16 * (4 * w + mi) + 4 * quad;
                float x[4]; hy_short4(p, l, xch, 256 * b, 256, t, x);
                bf16x4 uu = *(const bf16x4*)(U + b * 264 + t);
                bf16x4 o;
#pragma unroll
                for (int j = 0; j < 4; ++j) o[j] = (short)f2bf(x[j] * (acc[mi][nt][j] + bias * bf2f((bf16_t)uu[j])));
                *(bf16x4*)(OT + 256 * b + t) = o;
            }
    }
    __syncthreads();
}

DI void hyfin_item(const P& p, int item, unsigned char* smem) {
    bf16_t* tile = (bf16_t*)smem;
    const int tid = get_tid();
    const int tok0 = (item >> 2) * 64, ch0 = (item & 3) * 64;
    {
        const int cc = tid >> 2, part = tid & 3;
        const bf16_t* src = (const bf16_t*)(p.ws + WS_OUTT) + (size_t)(ch0 + cc) * NTOK + tok0 + part * 16;
        *(u32x4*)(tile + cc * 72 + part * 16) = *(const u32x4*)src;
        *(u32x4*)(tile + cc * 72 + part * 16 + 8) = *(const u32x4*)(src + 8);
    }
    __syncthreads();
    {
        const int tt = tid >> 2, part = tid & 3;
        const bf16_t* g = (const bf16_t*)(p.ws + WS_PROJ) + (size_t)(tok0 + tt) * NIN + C_GHY + ch0 + part * 16;
        bf16x8 g0 = *(const bf16x8*)g, g1 = *(const bf16x8*)(g + 8);
        bf16x8 o0, o1;
#pragma unroll
        for (int j = 0; j < 8; ++j) {
            o0[j] = (short)f2bf(bf2f(tile[(part * 16 + j) * 72 + tt]) * siluf_(bf2f((bf16_t)g0[j])));
            o1[j] = (short)f2bf(bf2f(tile[(part * 16 + 8 + j) * 72 + tt]) * siluf_(bf2f((bf16_t)g1[j])));
        }
        bf16_t* dst = (bf16_t*)(p.ws + WS_HB) + (size_t)(tok0 + tt) * 1024 + 256 + ch0 + part * 16;
        *(bf16x8*)dst = o0; *(bf16x8*)(dst + 8) = o1;
    }
    __syncthreads();
}

DI bf16x8 pack8(float a0, float a1, float a2, float a3, float a4, float a5, float a6, float a7) {
    typedef __bf16 bfv8 __attribute__((ext_vector_type(8)));
    typedef float fv8 __attribute__((ext_vector_type(8)));
    fv8 v = {a0, a1, a2, a3, a4, a5, a6, a7};
    return __builtin_bit_cast(bf16x8, __builtin_convertvector(v, bfv8));
}
DI void s5prep_item(const P& p, int item) {
    const int tid = get_tid();
    if (tid < 64) {
        const int pst = tid;
        unsigned char* T = p.ws + WS_S5T + (size_t)item * S5T_STRIDE;
        const int pidx = item * 64 + pst;
        const float are = fminf(p.in[I_AR][pidx], -1e-4f), aim = p.in[I_AI][pidx];
        const float dt = expf(p.in[I_LDT][item]);
        float abr, abi, Ar, Ai;
        { float m = expf(are * dt); float sn, cn; sincosf(aim * dt, &sn, &cn); abr = m * cn; abi = m * sn; }
        { float m = expf(are * dt * 256.f); float sn, cn; sincosf(aim * dt * 256.f, &sn, &cn); Ar = m * cn; Ai = m * sn; }
        ((float2*)T)[pst] = make_float2(abr, abi);
        ((float2*)T)[64 + pst] = make_float2(Ar, Ai);
        float nr = abr - 1.f, ni = abi; float den = 1.f / (are * are + aim * aim);
        float cfr = (nr * are + ni * aim) * den, cfi = (ni * are - nr * aim) * den;
        bf16_t* Bt = (bf16_t*)(T + 1024);
        bf16_t* Ct = (bf16_t*)(T + 1024 + 4096);
        for (int i = 0; i < 16; ++i) {
            float br = p.in[I_BR][(size_t)pidx * 16 + i], bi = p.in[I_BI][(size_t)pidx * 16 + i];
            Bt[(2 * pst) * 16 + i] = f2bf(cfr * br - cfi * bi);
            Bt[(2 * pst + 1) * 16 + i] = f2bf(cfr * bi + cfi * br);
            size_t ci = (size_t)(item * 16 + i) * 64 + pst;
            Ct[i * 128 + 2 * pst] = f2bf(p.in[I_CR][ci]);
            Ct[i * 128 + 2 * pst + 1] = f2bf(-p.in[I_CI][ci]);
        }
    }
}
DI void s5_item(const P& p, int l, int sc, int g, int dir, int mode, unsigned char* smem) {
    bf16_t* Ub = (bf16_t*)smem;
    float* H = (float*)(Ub + 256 * 16);
    const int tid = get_tid(), lane = tid & 63, w = tid >> 6, lr = lane & 15, quad = lane >> 4;
    const int pst = lane;
    const bool lat = sc >= 32;
    const int tokc = lat ? NCTX + 256 * (sc - 32) : 256 * sc;
    const int lb = lat ? (sc - 32) >> 3 : 0, lj = lat ? (sc - 32) & 7 : 0;
    const bf16_t* PR = (const bf16_t*)(p.ws + WS_PROJ);
    for (int e = tid; e < 512; e += 256) *(u32x4*)(Ub + 8 * e) = *(const u32x4*)(PR + (size_t)(tokc + (e >> 1)) * NIN + C_S5 + 16 * g + 8 * (e & 1));
    const unsigned char* T = p.ws + WS_S5T + (size_t)((l * 2 + dir) * 16 + g) * S5T_STRIDE;
    const float2 ab = ((const float2*)T)[pst];
    const float abr = ab.x, abi = ab.y;
    bf16x8 afB[8];
#pragma unroll
    for (int mt = 0; mt < 8; ++mt) {
        afB[mt] = (bf16x8){0, 0, 0, 0, 0, 0, 0, 0};
        if (quad < 2) afB[mt] = *(const bf16x8*)((const bf16_t*)(T + 1024) + (16 * mt + lr) * 16 + 8 * quad);
    }
    bf16x8 afC[4];
    if (mode == 1) {
#pragma unroll
        for (int ks = 0; ks < 4; ++ks) afC[ks] = *(const bf16x8*)((const bf16_t*)(T + 1024 + 4096) + lr * 128 + 32 * ks + 8 * quad);
    }
    float hr = 0.f, hi = 0.f;
    if (mode == 1 && lat && w == 0) {
        const float* h0 = p.in[I_SS5] + ((size_t)(((lb * 2 + l) * 2 + dir) * 16 + g) * 64 + pst) * 2;
        hr = h0[0]; hi = h0[1];
        const float2 A2 = ((const float2*)T)[64 + pst];
        const float Ar = A2.x, Ai = A2.y;
        const float* LOC = (const float*)(p.ws + WS_S5LOC);
        if (dir == 0) {
            for (int j = 0; j < lj; ++j) {
                const float* lc = LOC + ((size_t)(((lb * 8 + j) * 16 + g) * 2 + dir) * 64 + pst) * 2;
                float nr = Ar * hr - Ai * hi + lc[0], ni = Ar * hi + Ai * hr + lc[1]; hr = nr; hi = ni;
            }
        } else {
            for (int j = 7; j > lj; --j) {
                const float* lc = LOC + ((size_t)(((lb * 8 + j) * 16 + g) * 2 + dir) * 64 + pst) * 2;
                float nr = Ar * hr - Ai * hi + lc[0], ni = Ar * hi + Ai * hr + lc[1]; hr = nr; hi = ni;
            }
        }
    }
    __syncthreads();
    for (int sbi = 0; sbi < 4; ++sbi) {
        const int sub = dir == 0 ? sbi : 3 - sbi;
        const int tl = sub * 64 + 16 * w + lr, tok = tokc + tl, ch = 16 * g + 4 * quad;
        float* YS = (float*)(p.ws + WS_YS5) + (size_t)tok * 256 + ch;
        float4 pv = make_float4(0.f, 0.f, 0.f, 0.f);
        if (mode == 1 && dir == 1) pv = *(const float4*)YS;
        {
            bf16x8 bfr = (bf16x8){0, 0, 0, 0, 0, 0, 0, 0};
            if (quad < 2) bfr = *(const bf16x8*)(Ub + tl * 16 + 8 * quad);
#pragma unroll
            for (int mt = 0; mt < 8; ++mt) {
                f32x4 acc = MFMA16(afB[mt], bfr, ((f32x4){0.f, 0.f, 0.f, 0.f}));
                *(f32x4*)(H + (16 * w + lr) * 132 + 16 * mt + 4 * quad) = acc;
            }
        }
        __syncthreads();
        if (w == 0) {
#pragma unroll 8
            for (int k = 0; k < 64; ++k) {
                int tt = dir == 0 ? k : 63 - k;
                float2 b = *(const float2*)(H + tt * 132 + 2 * pst);
                float nr = abr * hr - abi * hi + b.x, ni = abr * hi + abi * hr + b.y; hr = nr; hi = ni;
                *(float2*)(H + tt * 132 + 2 * pst) = make_float2(hr, hi);
            }
        }
        __syncthreads();
        if (mode == 1) {
            f32x4 acc = (f32x4){0.f, 0.f, 0.f, 0.f};
#pragma unroll
            for (int ks = 0; ks < 4; ++ks) {
                const float* hp = H + (16 * w + lr) * 132 + 32 * ks + 8 * quad;
                float4 x0 = *(const float4*)hp, x1 = *(const float4*)(hp + 4);
                bf16x8 bfr = pack8(x0.x, x0.y, x0.z, x0.w, x1.x, x1.y, x1.z, x1.w);
                acc = MFMA16(afC[ks], bfr, acc);
            }
            if (dir == 0) {
                bf16x4 uu = *(const bf16x4*)(Ub + tl * 16 + 4 * quad);
                float4 dd = *(const float4*)(p.in[I_S5D] + l * 256 + ch);
                float4 o;
                o.x = dd.x * bf2f((bf16_t)uu[0]) + acc[0]; o.y = dd.y * bf2f((bf16_t)uu[1]) + acc[1];
                o.z = dd.z * bf2f((bf16_t)uu[2]) + acc[2]; o.w = dd.w * bf2f((bf16_t)uu[3]) + acc[3];
                *(float4*)YS = o;
            } else {
                bf16x4 o;
                o[0] = (short)f2bf(gelu_tanh(pv.x + acc[0])); o[1] = (short)f2bf(gelu_tanh(pv.y + acc[1]));
                o[2] = (short)f2bf(gelu_tanh(pv.z + acc[2])); o[3] = (short)f2bf(gelu_tanh(pv.w + acc[3]));
                *(bf16x4*)((bf16_t*)(p.ws + WS_GS5) + (size_t)tok * 256 + ch) = o;
            }
            __syncthreads();
        }
    }
    if (w == 0) {
        if (mode == 0) {
            float* lc = (float*)(p.ws + WS_S5LOC) + ((size_t)(((lb * 8 + lj) * 16 + g) * 2 + dir) * 64 + pst) * 2;
            lc[0] = hr; lc[1] = hi;
        } else if (!lat) {
            float* o = p.out + OFF_S5 + ((size_t)(((sc * 2 + l) * 2 + dir) * 16 + g) * 64 + pst) * 2;
            o[0] = hr; o[1] = hi;
        }
    }
    __syncthreads();
}

DI void gla_item(const P& p, int l, int sc, int head, int dir, int mode, unsigned char* smem) {
    float* qs = (float*)smem;
    float* ks = qs + 1024;
    float* ds = ks + 1024;
    float* vs = ds + 1024;
    float* gl = vs + 2048;
    float* gwl = gl + 512;
    float* ob = gwl + 544;
    const int tid = get_tid(), lane = tid & 63, w = tid >> 6;
    const int e = 16 * w + (lane & 15), dq = lane >> 4;
    const bool lat = sc >= 32;
    const int tokc = lat ? NCTX + 256 * (sc - 32) : 256 * sc;
    const int lb = lat ? (sc - 32) >> 3 : 0, lj = lat ? (sc - 32) & 7 : 0;
    const bf16_t* PR = (const bf16_t*)(p.ws + WS_PROJ);
    float S[8];
#pragma unroll
    for (int i = 0; i < 8; ++i) S[i] = 0.f;
    float acum[8];
#pragma unroll
    for (int i = 0; i < 8; ++i) acum[i] = 1.f;
    for (int i = tid; i < 544; i += 256)
        gwl[i] = i < 512 ? p.in[I_GGW][(size_t)((l * 2 + dir) * 16 + (i >> 5)) * 128 + 32 * head + (i & 31)] : p.in[I_GGB][(l * 2 + dir) * 128 + 32 * head + (i - 512)];
    if (mode == 1 && lat) {
        const float* s0 = p.in[I_SGLA] + (size_t)(((lb * 2 + l) * 2 + dir) * 4 + head) * 2048;
#pragma unroll
        for (int i = 0; i < 8; ++i) S[i] = s0[(8 * dq + i) * 64 + e];
        const float* LOC = (const float*)(p.ws + WS_GLALOC);
        if (dir == 0) {
            for (int j = 0; j < lj; ++j) {
                const float* lc = LOC + (size_t)(((lb * 8 + j) * 4 + head) * 2 + dir) * 2080;
#pragma unroll
                for (int i = 0; i < 8; ++i) S[i] = lc[2048 + 8 * dq + i] * S[i] + lc[(8 * dq + i) * 64 + e];
            }
        } else {
            for (int j = 7; j > lj; --j) {
                const float* lc = LOC + (size_t)(((lb * 8 + j) * 4 + head) * 2 + dir) * 2080;
#pragma unroll
                for (int i = 0; i < 8; ++i) S[i] = lc[2048 + 8 * dq + i] * S[i] + lc[(8 * dq + i) * 64 + e];
            }
        }
    }
    float* OG = (float*)(p.ws + WS_OGLA) + (size_t)dir * NTOK * 256;
    bf16x8 rqk, rv8, rg8 = (bf16x8){0, 0, 0, 0, 0, 0, 0, 0};
    const int qk_t = (tid & 127) >> 2, qk_c = (tid & 3) * 8, qk_col = (tid < 128 ? C_GQ : C_GK) + 32 * head + qk_c;
    {
        const int sub = dir == 0 ? 0 : 7; const int tk0 = tokc + sub * 32;
        rqk = *(const bf16x8*)(PR + (size_t)(tk0 + qk_t) * NIN + qk_col);
        rv8 = *(const bf16x8*)(PR + (size_t)(tk0 + (tid >> 3)) * NIN + C_GV + 64 * head + (tid & 7) * 8);
        if (tid < 64) rg8 = *(const bf16x8*)(PR + (size_t)(tk0 + (tid >> 1)) * NIN + C_GG + 16 * dir + (tid & 1) * 8);
    }
    for (int sbi = 0; sbi < 8; ++sbi) {
        const int sub = dir == 0 ? sbi : 7 - sbi;
        const int tk0 = tokc + sub * 32;
        __syncthreads();
        {
            float* dq_ = (tid < 128 ? qs : ks) + qk_t * 32 + qk_c;
            const float sc_ = tid < 128 ? 0.17677669529663687f : 1.f;
            *(float4*)dq_ = make_float4(bf2f((bf16_t)rqk[0]) * sc_, bf2f((bf16_t)rqk[1]) * sc_, bf2f((bf16_t)rqk[2]) * sc_, bf2f((bf16_t)rqk[3]) * sc_);
            *(float4*)(dq_ + 4) = make_float4(bf2f((bf16_t)rqk[4]) * sc_, bf2f((bf16_t)rqk[5]) * sc_, bf2f((bf16_t)rqk[6]) * sc_, bf2f((bf16_t)rqk[7]) * sc_);
            float* dv_ = vs + (tid >> 3) * 64 + (tid & 7) * 8;
            *(float4*)dv_ = make_float4(bf2f((bf16_t)rv8[0]), bf2f((bf16_t)rv8[1]), bf2f((bf16_t)rv8[2]), bf2f((bf16_t)rv8[3]));
            *(float4*)(dv_ + 4) = make_float4(bf2f((bf16_t)rv8[4]), bf2f((bf16_t)rv8[5]), bf2f((bf16_t)rv8[6]), bf2f((bf16_t)rv8[7]));
            if (tid < 64) {
                float* dg_ = gl + (tid >> 1) * 16 + (tid & 1) * 8;
                *(float4*)dg_ = make_float4(bf2f((bf16_t)rg8[0]), bf2f((bf16_t)rg8[1]), bf2f((bf16_t)rg8[2]), bf2f((bf16_t)rg8[3]));
                *(float4*)(dg_ + 4) = make_float4(bf2f((bf16_t)rg8[4]), bf2f((bf16_t)rg8[5]), bf2f((bf16_t)rg8[6]), bf2f((bf16_t)rg8[7]));
            }
        }
        __syncthreads();
        if (sbi < 7) {
            const int nsub = dir == 0 ? sbi + 1 : 6 - sbi; const int nk0 = tokc + nsub * 32;
            rqk = *(const bf16x8*)(PR + (size_t)(nk0 + qk_t) * NIN + qk_col);
            rv8 = *(const bf16x8*)(PR + (size_t)(nk0 + (tid >> 3)) * NIN + C_GV + 64 * head + (tid & 7) * 8);
            if (tid < 64) rg8 = *(const bf16x8*)(PR + (size_t)(nk0 + (tid >> 1)) * NIN + C_GG + 16 * dir + (tid & 1) * 8);
        }
#pragma unroll
        for (int j = 0; j < 4; ++j) {
            int i = tid + 256 * j; int t = i >> 5, d = i & 31;
            float z = gwl[512 + d];
#pragma unroll
            for (int r = 0; r < 16; ++r) z += gl[t * 16 + r] * gwl[r * 32 + d];
            float ls = fminf(z, 0.f) - __logf(1.f + __expf(-fabsf(z)));
            ds[i] = __expf(ls * (1.f / 16.f));
        }
        __syncthreads();
        {
            f32x2 S2[4], A2[4];
#pragma unroll
            for (int i = 0; i < 4; ++i) { S2[i] = (f32x2){S[2 * i], S[2 * i + 1]}; A2[i] = (f32x2){acum[2 * i], acum[2 * i + 1]}; }
#pragma unroll 4
            for (int k = 0; k < 32; ++k) {
                const int t = dir == 0 ? k : 31 - k;
                const float4* ap = (const float4*)(ds + t * 32 + 8 * dq);
                const float4* kp = (const float4*)(ks + t * 32 + 8 * dq);
                const float4 a0 = ap[0], a1 = ap[1], k0 = kp[0], k1 = kp[1];
                const float v = vs[t * 64 + e];
                const f32x2 vv = (f32x2){v, v};
                const f32x2 a01 = (f32x2){a0.x, a0.y}, a23 = (f32x2){a0.z, a0.w}, a45 = (f32x2){a1.x, a1.y}, a67 = (f32x2){a1.z, a1.w};
                S2[0] = a01 * S2[0] + (f32x2){k0.x, k0.y} * vv;
                S2[1] = a23 * S2[1] + (f32x2){k0.z, k0.w} * vv;
                S2[2] = a45 * S2[2] + (f32x2){k1.x, k1.y} * vv;
                S2[3] = a67 * S2[3] + (f32x2){k1.z, k1.w} * vv;
                if (mode == 1) {
                    const float4* qp = (const float4*)(qs + t * 32 + 8 * dq);
                    const float4 q0 = qp[0], q1 = qp[1];
                    f32x2 oo = (f32x2){q0.x, q0.y} * S2[0];
                    oo = (f32x2){q0.z, q0.w} * S2[1] + oo;
                    oo = (f32x2){q1.x, q1.y} * S2[2] + oo;
                    oo = (f32x2){q1.z, q1.w} * S2[3] + oo;
                    ob[(t * 64 + e) * 4 + dq] = oo[0] + oo[1];
                } else {
                    A2[0] *= a01; A2[1] *= a23; A2[2] *= a45; A2[3] *= a67;
                }
            }
#pragma unroll
            for (int i = 0; i < 4; ++i) { S[2 * i] = S2[i][0]; S[2 * i + 1] = S2[i][1]; acum[2 * i] = A2[i][0]; acum[2 * i + 1] = A2[i][1]; }
        }
        if (mode == 1) {
            __syncthreads();
            const int t = tid >> 3, e0 = (tid & 7) * 8;
            float r[8];
#pragma unroll
            for (int j = 0; j < 8; ++j) { float4 x = *(const float4*)(ob + (t * 64 + e0 + j) * 4); r[j] = (x.x + x.y) + (x.z + x.w); }
            float* dst = OG + (size_t)(tk0 + t) * 256 + 64 * head + e0;
            *(float4*)dst = make_float4(r[0], r[1], r[2], r[3]);
            *(float4*)(dst + 4) = make_float4(r[4], r[5], r[6], r[7]);
        }
    }
    if (mode == 0) {
        float* lc = (float*)(p.ws + WS_GLALOC) + (size_t)(((lb * 8 + lj) * 4 + head) * 2 + dir) * 2080;
#pragma unroll
        for (int i = 0; i < 8; ++i) lc[(8 * dq + i) * 64 + e] = S[i];
        if (w == 0 && (lane & 15) == 0) {
#pragma unroll
            for (int i = 0; i < 8; ++i) lc[2048 + 8 * dq + i] = acum[i];
        }
    } else if (!lat) {
        float* o = p.out + OFF_GLA + (size_t)(((sc * 2 + l) * 2 + dir) * 4 + head) * 2048;
#pragma unroll
        for (int i = 0; i < 8; ++i) o[(8 * dq + i) * 64 + e] = S[i];
    }
    __syncthreads();
}

DI void glafin_item(const P& p, int l, int item) {
    const int tid_ = get_tid(); const int lane = tid_ & 63, w = tid_ >> 6;
    float4 a[6], b[6]; bf16x4 g[6];
#pragma unroll
    for (int j = 0; j < 6; ++j) {
        const int tok = (item * 6 + j) * 4 + w;
        const float* O0 = (const float*)(p.ws + WS_OGLA) + (size_t)tok * 256 + lane * 4;
        a[j] = *(const float4*)O0; b[j] = *(const float4*)(O0 + (size_t)NTOK * 256);
        g[j] = *(const bf16x4*)((const bf16_t*)(p.ws + WS_PROJ) + (size_t)tok * NIN + C_GGLA + lane * 4);
    }
    const float4 nw = *(const float4*)(p.in[I_GLAN] + l * 64 + (lane & 15) * 4);
#pragma unroll
    for (int j = 0; j < 6; ++j) {
        const int tok = (item * 6 + j) * 4 + w;
        float v[4] = {a[j].x + b[j].x, a[j].y + b[j].y, a[j].z + b[j].z, a[j].w + b[j].w};
        float ss = v[0] * v[0] + v[1] * v[1] + v[2] * v[2] + v[3] * v[3];
        ss += __shfl_xor(ss, 1); ss += __shfl_xor(ss, 2); ss += __shfl_xor(ss, 4); ss += __shfl_xor(ss, 8);
        float r = rsqrtf(ss * (1.f / 64.f) + 1e-6f);
        bf16x4 o;
        o[0] = (short)f2bf(v[0] * r * nw.x * siluf_(bf2f((bf16_t)g[j][0])));
        o[1] = (short)f2bf(v[1] * r * nw.y * siluf_(bf2f((bf16_t)g[j][1])));
        o[2] = (short)f2bf(v[2] * r * nw.z * siluf_(bf2f((bf16_t)g[j][2])));
        o[3] = (short)f2bf(v[3] * r * nw.w * siluf_(bf2f((bf16_t)g[j][3])));
        *(bf16x4*)((bf16_t*)(p.ws + WS_HB) + (size_t)tok * 1024 + 768 + lane * 4) = o;
    }
}

#define XB_TMO      128
#define XB_XCNT(j)  (256  + 64 * (j))
#define XB_XSUB(j)  (1280 + 64 * (j))
#define XB_XGEN(j)  (2304 + 64 * (j))
#define XB_TOP      3328
#define XB_TOPGEN   3392
#define XCD_BAR_WORDS 3456
#define XB_SPIN_CAP (1u << 18)
#define LAS __attribute__((address_space(3)))
DI unsigned xb_ld(unsigned* p)              { return __hip_atomic_load(p, __ATOMIC_RELAXED, __HIP_MEMORY_SCOPE_AGENT); }
DI unsigned xb_add(unsigned* p, unsigned v) { return __hip_atomic_fetch_add(p, v, __ATOMIC_RELAXED, __HIP_MEMORY_SCOPE_AGENT); }
DI unsigned xb_xcc_id() { return (unsigned)__builtin_amdgcn_s_getreg((3 << 11) | 20) & 0xFu; }
#define XB_SPIN(cond, bar) do { unsigned _sp = 0; while (cond) { __builtin_amdgcn_s_sleep(1); \
    if ((++_sp & 255u) == 0u) { if (xb_ld(&(bar)[XB_TMO])) break; if (_sp > XB_SPIN_CAP) { atomicAdd(&(bar)[XB_TMO], 1u); break; } } } } while (0)
struct XcdBarrier { unsigned* bar; unsigned x; volatile LAS unsigned* st; };
DI XcdBarrier xcd_barrier_post(unsigned* bar, volatile LAS unsigned* st) {
    XcdBarrier b; b.bar = bar; b.x = xb_xcc_id(); b.st = st;
    if (threadIdx.x == 0) (void)xb_add(&bar[XB_XCNT(b.x)], 1u);
    return b;
}
DI void xcd_barrier_complete(unsigned* bar, unsigned x, unsigned& nloc, unsigned& nx) {
    const unsigned G = gridDim.x * gridDim.y * gridDim.z;
    unsigned sum, cnt, mine, sp = 0u;
    for (;;) {
        sum = 0u; cnt = 0u; mine = 0u;
#pragma unroll
        for (unsigned j = 0; j < 16; ++j) { const unsigned c = xb_ld(&bar[XB_XCNT(j)]); sum += c; cnt += (c > 0u) ? 1u : 0u; mine = (j == x) ? c : mine; }
        if (sum == G) break;
        __builtin_amdgcn_s_sleep(1);
        if ((++sp & 255u) == 0u) { if (xb_ld(&bar[XB_TMO])) break; if (sp > XB_SPIN_CAP) { atomicAdd(&bar[XB_TMO], 1u); break; } }
    }
    nloc = mine > 0u ? mine : 1u; nx = cnt > 0u ? cnt : 1u;
}
DI void xcd_barrier(const XcdBarrier& b) {
    asm volatile("s_waitcnt vmcnt(0)" ::: "memory");
    __syncthreads();
    if (threadIdx.x == 0) {
        unsigned* bar = b.bar;
        __builtin_amdgcn_s_waitcnt(0);
        unsigned nloc = b.st[0], nx = b.st[1];
        if (nloc == 0u) { xcd_barrier_complete(bar, b.x, nloc, nx); b.st[0] = nloc; b.st[1] = nx; }
        const unsigned old = xb_add(&bar[XB_XSUB(b.x)], 1u);
        const unsigned gen = old / nloc;
        if (old + 1u == (gen + 1u) * nloc) {
            __builtin_amdgcn_fence(__ATOMIC_RELEASE, "agent");
            asm volatile("s_waitcnt vmcnt(0)" ::: "memory");
            const unsigned og = xb_add(&bar[XB_TOP], 1u);
            const unsigned tg = og / nx;
            if (og + 1u == (tg + 1u) * nx) xb_add(&bar[XB_TOPGEN], 1u);
            else XB_SPIN(xb_ld(&bar[XB_TOPGEN]) == tg, bar);
            __builtin_amdgcn_fence(__ATOMIC_ACQUIRE, "agent");
            xb_add(&bar[XB_XGEN(b.x)], 1u);
            asm volatile("s_waitcnt vmcnt(0)" ::: "memory");
        } else {
            XB_SPIN(xb_ld(&bar[XB_XGEN(b.x)]) == gen, bar);
            __builtin_amdgcn_fence(__ATOMIC_ACQUIRE, "agent");
            asm volatile("s_waitcnt vmcnt(0)" ::: "memory");
        }
    }
    __syncthreads();
}

constexpr int SMEM_BYTES = 59392;
#ifndef NPHASE_LAUNCH
#define NPHASE_LAUNCH 0
#endif

DI int next_item(unsigned* ctr, int* slot) {
    __syncthreads();
    if (threadIdx.x == 0) *slot = (int)atomicAdd(ctr, 1u);
    __syncthreads();
    return __builtin_amdgcn_readfirstlane(*slot);
}

__global__ void __launch_bounds__(256, 2) mega(P pk, int ph_lo, int ph_hi) {
    __shared__ __attribute__((aligned(16))) unsigned char smem[SMEM_BYTES];
    __shared__ P p;
    __shared__ int s_next;
    if (threadIdx.x < 42) p.in[threadIdx.x] = pk.in[threadIdx.x];
    if (threadIdx.x == 42) p.out = pk.out;
    if (threadIdx.x == 43) p.ws = pk.ws;
    __syncthreads();
    cg::grid_group grid = cg::this_grid();
    __shared__ uint4 xb_words;
    if (threadIdx.x == 0) xb_words = make_uint4(0u, 0u, 0u, 0u);
    __syncthreads();
    XcdBarrier xbar = xcd_barrier_post((unsigned*)(pk.ws + WS_CTR), (volatile LAS unsigned*)&xb_words);
    if (ph_lo < 0) grid.sync();
    int ph = 0;
#define PHASE_BEGIN if (ph >= ph_lo && ph < ph_hi) {
#define PHASE_END   if (ph + 1 < ph_hi) xcd_barrier(xbar); } ++ph;
#define FOR_ITEMS(N) for (int it = blockIdx.x; it < (N); it += gridDim.x)

    PHASE_BEGIN
    FOR_ITEMS(2756 + 64) {
        if (it >= 2756) s5prep_item(p, it - 2756);
        else if (it < 96) ada_item(p, it / 48, it % 48, smem);
        else if (it < 96 + 576) { int j = it - 96; int l = j / 288, r = j % 288; int ls = r < 256 ? 1 : 0; hyfilt_item(p, l, ls, ls ? r : r - 256, smem); }
        else {
            int j = it - 672; int l = j / 1042, r = j % 1042;
            if (r < 736) tr_item(p.in[I_WIN] + (size_t)l * 1024 * 2944, 1024, 2944, (bf16_t*)(p.ws + WS_WTIN) + (size_t)l * 2944 * 1024, r / 46, r % 46, smem);
            else if (r < 992) { r -= 736; tr_item(p.in[I_WOUT] + (size_t)l * 1024 * 1024, 1024, 1024, (bf16_t*)(p.ws + WS_WTOUT) + (size_t)l * 1024 * 1024, r / 16, r % 16, smem); }
            else if (r < 1010) { r -= 992; tr_item(p.in[I_WUQ] + (size_t)l * 192 * 384, 192, 384, (bf16_t*)(p.ws + WS_WTUQ) + (size_t)l * 384 * 192, r / 6, r % 6, smem); }
            else if (r < 1026) { r -= 1010; tr_item(p.in[I_WUKV] + (size_t)l * 128 * 512, 128, 512, (bf16_t*)(p.ws + WS_WTUKV) + (size_t)l * 512 * 128, r / 8, r % 8, smem); }
            else { r -= 1026; tr_item(p.in[I_GLUW] + (size_t)l * 256 * 256, 256, 256, (bf16_t*)(p.ws + WS_WTGLU) + (size_t)l * 256 * 256, r / 4, r % 4, smem); }
        }
    }
    PHASE_END

    for (int l = 0; l < 2; ++l) {
        PHASE_BEGIN
        FOR_ITEMS(512 + (l == 0 ? 32 : 0)) {
            if (it < 512) normmod_item(p, l, it);
            else { int j = it - 512; hynorm_item(p, j >> 4, (j >> 3) & 1, j & 7, smem); }
        }
        PHASE_END
        PHASE_BEGIN
        {
            EpiProj ep{(bf16_t*)(p.ws + WS_PROJ), (bf16_t*)(p.ws + WS_ZT)};
            const bf16_t* A = (const bf16_t*)(p.ws + WS_HB);
            const bf16_t* Bt = (const bf16_t*)(p.ws + WS_WTIN) + (size_t)l * 2944 * 1024;
            FOR_ITEMS(96 * 23 + (l == 0 ? 1152 : 0)) {
                if (it < 96 * 23) { const int xq = it >> 3, xx = it & 7; gemm_tile(A, 1024, Bt, 1024, 1024, (8 * (xq / 23) + xx) * 128, (xq % 23) * 128, smem, ep); }
                else rt_item(p, it - 96 * 23, smem);
            }
        }
        PHASE_END
        PHASE_BEGIN
        FOR_ITEMS(128 + 256 + 512 + 416 + 256) {
            if (it < 128) { int j = it; gla_item(p, l, 32 + (j >> 3), (j >> 1) & 3, j & 1, 0, smem); }
            else if (it < 384 || it >= 1312) hy2_item(p, l, 0, it < 384 ? it - 128 : 256 + it - 1312, smem);
            else if (it < 896) { int j = it - 384; s5_item(p, l, 32 + (j >> 5), (j >> 1) & 15, j & 1, 0, smem); }
            else mlaprep_item(p, l, it - 896, smem);
        }
        PHASE_END
        PHASE_BEGIN
        FOR_ITEMS(384 + 128 + 768 + 256 + 256 + 256) {
            if (it < 384) { int j = it; gla_item(p, l, 47 - (j >> 3), (j >> 1) & 3, j & 1, 1, smem); }
            else if (it < 512 || (it >= 1536 && it < 1792)) attn_item(p, l, it < 512 ? it - 384 : 128 + it - 1536, smem);
            else if (it < 1280) { int j = it - 512; int sc = 47 - (j >> 4), g = j & 15; for (int dir = 0; dir < 2; ++dir) s5_item(p, l, sc, g, dir, 1, smem); }
            else hy2_item(p, l, 1, it < 1536 ? it - 1280 : 256 + it - 1792, smem);
        }
        PHASE_END
        PHASE_BEGIN
        {
            EpiGlu eg{&p, l};
            const bf16_t* A = (const bf16_t*)(p.ws + WS_GS5);
            const bf16_t* Bt = (const bf16_t*)(p.ws + WS_WTGLU) + (size_t)l * 256 * 256;
            FOR_ITEMS(192 + 512 + 768) {
                if (it < 192) gemm_tile(A, 256, Bt, 256, 256, (it >> 1) * 128, (it & 1) * 128, smem, eg);
                else if (it < 704) glafin_item(p, l, it - 192);
                else hyfin_item(p, it - 704, smem);
            }
        }
        PHASE_END
        PHASE_BEGIN
        {
            EpiOut eo{&p, l};
            const bf16_t* A = (const bf16_t*)(p.ws + WS_HB);
            const bf16_t* Bt = (const bf16_t*)(p.ws + WS_WTOUT) + (size_t)l * 1024 * 1024;
            FOR_ITEMS(96 * 8) { const int xq = it >> 3, xx = it & 7; gemm_tile(A, 1024, Bt, 1024, 1024, (8 * (xq >> 3) + xx) * 128, (xq & 7) * 128, smem, eo); }
        }
        PHASE_END
    }
}

extern "C" void kernel_launch(void* const* d_in, const int* in_sizes, int n_in, void* d_out, int out_size, void* d_ws, size_t ws_size,
                              hipStream_t stream) {
    static int grid_blocks = 0;
    if (!grid_blocks) {
        int dev = 0, cus = 0, per_cu = 0;
        hipGetDevice(&dev);
        hipDeviceGetAttribute(&cus, hipDeviceAttributeMultiprocessorCount, dev);
        hipOccupancyMaxActiveBlocksPerMultiprocessor(&per_cu, mega, 256, 0);
        if (per_cu > 2) per_cu = 2;
        if (per_cu < 1) per_cu = 1;
        grid_blocks = cus * per_cu;
        if (ws_size < WS_END) fprintf(stderr, "workspace too small: %zu < %zu\n", ws_size, (size_t)WS_END);
    }
    hipMemsetAsync((unsigned char*)d_ws + WS_CTR, 0, XCD_BAR_WORDS * 4, stream);
    P p{};
    for (int i = 0; i < 42; ++i) p.in[i] = (const float*)d_in[i];
    p.out = (float*)d_out; p.ws = (unsigned char*)d_ws;
#if NPHASE_LAUNCH
    for (int ph = 0; ph < 13; ++ph) {
        int lo = ph, hi = ph + 1;
        hipLaunchKernelGGL(mega, dim3(grid_blocks), dim3(256), 0, stream, p, lo, hi);
    }
#else
    int lo = 0, hi = 13;
    void* args[] = {&p, &lo, &hi};
    hipError_t e = hipLaunchCooperativeKernel((void*)mega, dim3(grid_blocks), dim3(256), args, 0, stream);
    if (e != hipSuccess) fprintf(stderr, "cooperative launch failed: %s (grid %d)\n", hipGetErrorString(e), grid_blocks);
#endif
}
```

```cpp
#include <hip/hip_runtime.h>
#include <hip/hip_bf16.h>
#include <hip/hip_cooperative_groups.h>
#include <cstdio>
namespace cg = cooperative_groups;

typedef unsigned short bf16_t;
using bf16x8 = __attribute__((ext_vector_type(8))) short;
using bf16x4 = __attribute__((ext_vector_type(4))) short;
using f32x4 = __attribute__((ext_vector_type(4))) float;
using u32x4 = __attribute__((ext_vector_type(4))) unsigned;
using f32x2 = __attribute__((ext_vector_type(2))) float;
#define DI __device__ __forceinline__

constexpr int NTOK = 12288, NCTX = 8192, DM = 1024, NIN = 2944, NKT = 13312;
constexpr int C_CQ = 0, C_CKV = 192, C_KR = 320, C_GMLA = 352, C_HY = 608, C_GHY = 1376, C_S5 = 1632, C_GS5 = 1888,
              C_GQ = 2144, C_GK = 2272, C_GV = 2400, C_GG = 2656, C_GGLA = 2688;
constexpr size_t OFF_CKV = 12582912, OFF_KR = 14680064, OFF_S5 = 15204352, OFF_GLA = 15466496;

constexpr size_t al256(size_t x) { return (x + 255) & ~(size_t)255; }
constexpr size_t WS_MOD = 0;
constexpr size_t WS_WTIN = al256(WS_MOD + 2 * 3 * 3072 * 4);
constexpr size_t WS_WTOUT = al256(WS_WTIN + (size_t)2 * 2944 * 1024 * 2);
constexpr size_t WS_WTUQ = al256(WS_WTOUT + (size_t)2 * 1024 * 1024 * 2);
constexpr size_t WS_WTUKV = al256(WS_WTUQ + (size_t)2 * 384 * 192 * 2);
constexpr size_t WS_WTGLU = al256(WS_WTUKV + (size_t)2 * 512 * 128 * 2);
constexpr size_t WS_HF = al256(WS_WTGLU + (size_t)2 * 256 * 256 * 2);
constexpr size_t HF_LAYER = (size_t)(256 + 2048) * 1024;
constexpr size_t WS_HNORM = al256(WS_HF + 2 * HF_LAYER * 4);
constexpr size_t WS_HB = al256(WS_HNORM + 2 * 2 * 512 * 4);
constexpr size_t WS_PROJ = al256(WS_HB + (size_t)NTOK * 1024 * 2);
constexpr size_t WS_QB = al256(WS_PROJ + (size_t)NTOK * NIN * 2);
constexpr size_t WS_KB = al256(WS_QB + (size_t)4 * NTOK * 96 * 2);
constexpr size_t WS_VT = al256(WS_KB + (size_t)4 * NKT * 96 * 2);
constexpr size_t WS_ZT = al256(WS_VT + (size_t)4 * NKT * 64 * 2);
constexpr size_t WS_Y1T = al256(WS_ZT + (size_t)768 * NTOK * 2);
constexpr size_t WS_OUTT = al256(WS_Y1T + (size_t)256 * NTOK * 2);
constexpr size_t WS_RTL = al256(WS_OUTT + (size_t)256 * NTOK * 2);
constexpr size_t WS_RTC = al256(WS_RTL + (size_t)2 * 2 * 256 * 4096 * 2);
constexpr size_t WS_CTR = al256(WS_RTC + (size_t)2 * 2 * 256 * 512 * 2);
constexpr size_t WS_HPART = al256(WS_CTR + 16384);
constexpr size_t WS_YS5 = al256(WS_HPART + (size_t)2 * 288 * 1024 * 4);
constexpr size_t WS_GS5 = al256(WS_YS5 + (size_t)NTOK * 256 * 4);
constexpr size_t WS_OGLA = al256(WS_GS5 + (size_t)NTOK * 256 * 2);
constexpr size_t WS_S5LOC = al256(WS_OGLA + (size_t)2 * NTOK * 256 * 4);
constexpr size_t WS_GLALOC = al256(WS_S5LOC + (size_t)2 * 8 * 16 * 2 * 128 * 4);
constexpr size_t WS_S5T = al256(WS_GLALOC + (size_t)2 * 8 * 4 * 2 * 2080 * 4);
constexpr size_t S5T_STRIDE = 9216;
constexpr size_t WS_END = al256(WS_S5T + 64 * S5T_STRIDE);
static_assert(WS_END <= ((size_t)256 << 20), "workspace");

struct P { const float* in[42]; float* out; unsigned char* ws; };

enum { I_XP = 0, I_XS, I_C, I_CCKV, I_CKR, I_SS5, I_SGLA, I_CCTX, I_NORMW, I_ADAW, I_ADAB, I_WIN, I_WOUT, I_QAN, I_KVAN, I_WUQ, I_WUKV,
       I_QN, I_KN, I_HCW, I_HCB, I_HW1, I_HB1, I_HF1, I_HW2, I_HB2, I_HF2, I_HW3, I_HBIAS, I_AR, I_AI, I_LDT, I_BR, I_BI, I_CR, I_CI,
       I_S5D, I_GLUW, I_GLUB, I_GGW, I_GGB, I_GLAN };

DI bf16_t f2bf(float x) { __bf16 b = (__bf16)x; return __builtin_bit_cast(bf16_t, b); }
DI float bf2f(bf16_t h) { return __uint_as_float(((unsigned)h) << 16); }
DI float sigmoidf_(float x) { return 1.f / (1.f + __expf(-x)); }
DI float siluf_(float x) { return x / (1.f + __expf(-x)); }
DI float gelu_tanh(float x) { float u = 0.7978845608028654f * (x + 0.044715f * x * x * x); return 0.5f * x * (1.f + tanhf(u)); }
DI int cond_of(int tok) { return tok < NCTX ? 0 : 1 + ((tok - NCTX) >> 11); }
DI const float* xrow(const P& p, int l, int tok) {
    if (l == 0) return tok < NCTX ? p.in[I_XP] + (size_t)tok * DM : p.in[I_XS] + (size_t)(tok - NCTX) * DM;
    return p.out + (size_t)tok * DM;
}
DI int get_tid() { int t = threadIdx.x; asm volatile("" : "+v"(t)); return t; }
DI bf16x8 pack8_hw(float a0, float a1, float a2, float a3, float a4, float a5, float a6, float a7) {
    typedef __bf16 bfv8 __attribute__((ext_vector_type(8)));
    typedef float fv8 __attribute__((ext_vector_type(8)));
    fv8 v = {a0, a1, a2, a3, a4, a5, a6, a7};
    return __builtin_bit_cast(bf16x8, __builtin_convertvector(v, bfv8));
}
#define MFMA16(a, b, c) __builtin_amdgcn_mfma_f32_16x16x32_bf16((a), (b), (c), 0, 0, 0)

DI void tr_item(const float* __restrict__ src, int K, int N, bf16_t* __restrict__ dst, int kt, int nt, unsigned char* smem) {
    float* tile = (float*)smem;
    const int tid = get_tid(), k0 = kt * 64, n0 = nt * 64;
#pragma unroll
    for (int i = 0; i < 16; ++i) { int e = tid + 256 * i; int kk = e >> 6, nn = e & 63; tile[kk * 65 + nn] = src[(size_t)(k0 + kk) * N + n0 + nn]; }
    __syncthreads();
#pragma unroll
    for (int i = 0; i < 16; ++i) { int e = tid + 256 * i; int nn = e >> 6, kk = e & 63; dst[(size_t)(n0 + nn) * K + k0 + kk] = f2bf(tile[kk * 65 + nn]); }
    __syncthreads();
}

DI void ada_item(const P& p, int l, int cc, unsigned char* smem) {
    float* sc = (float*)smem;
    float* red = sc + 3 * 1024;
    const int tid = get_tid();
    for (int e = tid; e < 3 * 1024; e += 256) { int cnd = e >> 10, k = e & 1023; float v = cnd == 0 ? p.in[I_CCTX][k] : p.in[I_C][(cnd - 1) * 1024 + k]; sc[e] = siluf_(v); }
    __syncthreads();
    const int cq = tid & 15, kg = tid >> 4, n0 = cc * 64;
    const float* W = p.in[I_ADAW] + (size_t)l * 1024 * 3072 + n0 + 4 * cq;
    float acc[3][4];
#pragma unroll
    for (int a = 0; a < 3; ++a)
#pragma unroll
        for (int j = 0; j < 4; ++j) acc[a][j] = 0.f;
#pragma unroll 8
    for (int kk = 0; kk < 64; ++kk) {
        int k = kg * 64 + kk;
        float4 w = *(const float4*)(W + (size_t)k * 3072);
#pragma unroll
        for (int a = 0; a < 3; ++a) { float s = sc[a * 1024 + k]; acc[a][0] += s * w.x; acc[a][1] += s * w.y; acc[a][2] += s * w.z; acc[a][3] += s * w.w; }
    }
#pragma unroll
    for (int a = 0; a < 3; ++a)
#pragma unroll
        for (int j = 0; j < 4; ++j) red[(kg * 3 + a) * 64 + 4 * cq + j] = acc[a][j];
    __syncthreads();
    if (tid < 192) {
        int a = tid >> 6, n = tid & 63; float s = 0.f;
#pragma unroll
        for (int g = 0; g < 16; ++g) s += red[(g * 3 + a) * 64 + n];
        float* MOD = (float*)(p.ws + WS_MOD);
        MOD[(l * 3 + a) * 3072 + n0 + n] = s + p.in[I_ADAB][l * 3072 + n0 + n];
    }
    __syncthreads();
}

DI void hyfilt_item(const P& p, int l, int lsel, int tile, unsigned char* smem) {
    float* feat = (float*)smem;
    float* h1 = feat + 8 * 33;
    float* h2 = h1 + 8 * 64;
    const int tid = get_tid();
    const int L = lsel ? 2048 : 256;
    const int lag0 = tile * 8;
    const float Lf = (float)L;
    for (int e = tid; e < 8 * 33; e += 256) {
        int lg = e / 33, f = e % 33; float pos = (float)(lag0 + lg);
        float v;
        if (f == 0) v = pos / Lf;
        else {
            float w = 6.283185307179586f * pos / Lf;
            int bi = (f - 1) & 15; float band = 1e-4f + (float)bi * ((15.0f - 1e-4f) / 15.0f);
            v = (f <= 16) ? cosf(w * band) : sinf(w * band);
        }
        feat[e] = v;
    }
    __syncthreads();
    for (int e = tid; e < 8 * 64; e += 256) {
        int lg = e >> 6, j = e & 63; float s = p.in[I_HB1][l * 64 + j];
        for (int f = 0; f < 33; ++f) s += feat[lg * 33 + f] * p.in[I_HW1][(l * 33 + f) * 64 + j];
        h1[e] = sinf(p.in[I_HF1][l * 64 + j] * s);
    }
    __syncthreads();
    for (int e = tid; e < 8 * 64; e += 256) {
        int lg = e >> 6, j = e & 63; float s = p.in[I_HB2][l * 64 + j];
        for (int k = 0; k < 64; ++k) s += h1[lg * 64 + k] * p.in[I_HW2][(l * 64 + k) * 64 + j];
        h2[e] = sinf(p.in[I_HF2][l * 64 + j] * s);
    }
    __syncthreads();
    float acc[8][4];
#pragma unroll
    for (int a = 0; a < 8; ++a)
#pragma unroll
        for (int j = 0; j < 4; ++j) acc[a][j] = 0.f;
    const float* W3 = p.in[I_HW3] + (size_t)l * 64 * 1024 + 4 * tid;
#pragma unroll 4
    for (int k = 0; k < 64; ++k) {
        float4 w = *(const float4*)(W3 + k * 1024);
#pragma unroll
        for (int a = 0; a < 8; ++a) { float hv = h2[a * 64 + k]; acc[a][0] += hv * w.x; acc[a][1] += hv * w.y; acc[a][2] += hv * w.z; acc[a][3] += hv * w.w; }
    }
    float* HF = (float*)(p.ws + WS_HF) + (size_t)l * HF_LAYER + (lsel ? (size_t)256 * 1024 : 0);
    const float d0 = 15.350567286626973f, d1 = 3.0701134573253946f;
    float4 ps = make_float4(0.f, 0.f, 0.f, 0.f);
#pragma unroll
    for (int a = 0; a < 8; ++a) {
        float t = (float)(lag0 + a) / Lf;
        float4 o;
        float* op = (float*)&o;
#pragma unroll
        for (int j = 0; j < 4; ++j) {
            int ch = (4 * tid + j) & 255;
            float delta = d0 + (float)ch * ((d1 - d0) / 255.0f);
            op[j] = acc[a][j] * (expf(-t * delta) + 0.05f);
        }
        *(float4*)(HF + (size_t)(lag0 + a) * 1024 + 4 * tid) = o;
        const bool cnt = !(lag0 + a == 0 && 4 * tid >= 512);
        if (cnt) { ps.x += fabsf(o.x); ps.y += fabsf(o.y); ps.z += fabsf(o.z); ps.w += fabsf(o.w); }
    }
    *(float4*)((float*)(p.ws + WS_HPART) + ((size_t)l * 288 + (lsel ? 32 : 0) + tile) * 1024 + 4 * tid) = ps;
    __syncthreads();
}

DI void hynorm_item(const P& p, int l, int lsel, int cc, unsigned char* smem) {
    float* red = (float*)smem;
    const int tid = get_tid(), c = tid & 63, lg = tid >> 6;
    const int ntile = lsel ? 256 : 32;
    const float* PT = (const float*)(p.ws + WS_HPART) + ((size_t)l * 288 + (lsel ? 32 : 0)) * 1024;
    const int col = cc * 64 + c;
    float s = 0.f;
#pragma unroll 8
    for (int t = lg; t < ntile; t += 4) s += PT[(size_t)t * 1024 + col] + PT[(size_t)t * 1024 + 512 + col];
    red[lg * 64 + c] = s;
    __syncthreads();
    if (tid < 64) {
        float t = red[tid] + red[64 + tid] + red[128 + tid] + red[192 + tid];
        ((float*)(p.ws + WS_HNORM))[(l * 2 + lsel) * 512 + col] = 1.f / t;
    }
    __syncthreads();
}

DI void normmod_item(const P& p, int l, int item) {
    const int tid_ = get_tid(); const int lane = tid_ & 63, w = tid_ >> 6;
    float4 v[6][4]; float ss[6];
#pragma unroll
    for (int j = 0; j < 6; ++j) {
        const float* x = xrow(p, l, (item * 6 + j) * 4 + w);
        ss[j] = 0.f;
#pragma unroll
        for (int i = 0; i < 4; ++i) v[j][i] = *(const float4*)(x + lane * 4 + 256 * i);
    }
#pragma unroll
    for (int j = 0; j < 6; ++j) {
#pragma unroll
        for (int i = 0; i < 4; ++i) ss[j] += v[j][i].x * v[j][i].x + v[j][i].y * v[j][i].y + v[j][i].z * v[j][i].z + v[j][i].w * v[j][i].w;
#pragma unroll
        for (int o = 1; o < 64; o <<= 1) ss[j] += __shfl_xor(ss[j], o);
    }
#pragma unroll
    for (int j = 0; j < 6; ++j) {
        const int tok = (item * 6 + j) * 4 + w;
        const float r = rsqrtf(ss[j] * (1.f / 1024.f) + 1e-6f);
        const float* MOD = (const float*)(p.ws + WS_MOD) + (l * 3 + cond_of(tok)) * 3072;
        bf16_t* HB = (bf16_t*)(p.ws + WS_HB) + (size_t)tok * 1024;
#pragma unroll
        for (int i = 0; i < 4; ++i) {
            int c = lane * 4 + 256 * i;
            float4 nw = *(const float4*)(p.in[I_NORMW] + l * 1024 + c);
            float4 sh = *(const float4*)(MOD + c), sc = *(const float4*)(MOD + 1024 + c);
            bf16x4 o;
            o[0] = (short)f2bf(v[j][i].x * r * nw.x * (1.f + sc.x) + sh.x);
            o[1] = (short)f2bf(v[j][i].y * r * nw.y * (1.f + sc.y) + sh.y);
            o[2] = (short)f2bf(v[j][i].z * r * nw.z * (1.f + sc.z) + sh.z);
            o[3] = (short)f2bf(v[j][i].w * r * nw.w * (1.f + sc.w) + sh.w);
            *(bf16x4*)(HB + c) = o;
        }
    }
}

template <class Epi>
DI void gemm_tile(const bf16_t* __restrict__ A, int lda, const bf16_t* __restrict__ Bt, int ldb, int K, int m0, int n0,
                          unsigned char* smem, Epi epi) {
    bf16_t* As = (bf16_t*)smem;
    bf16_t* Bs = As + 128 * 72;
    const int tid = get_tid(), lane = tid & 63, w = tid >> 6;
    const int wm = w & 1, wn = w >> 1, lr = lane & 15, quad = lane >> 4;
    f32x4 acc[4][4];
#pragma unroll
    for (int a = 0; a < 4; ++a)
#pragma unroll
        for (int b = 0; b < 4; ++b) acc[a][b] = (f32x4){0.f, 0.f, 0.f, 0.f};
    u32x4 ra[4], rb[4], ra2[4], rb2[4];
    const bf16_t* Ag = A + (size_t)(m0 + (tid >> 3)) * lda + (tid & 7) * 8;
    const bf16_t* Bg = Bt + (size_t)(n0 + (tid >> 3)) * ldb + (tid & 7) * 8;
#pragma unroll
    for (int i = 0; i < 4; ++i) { ra[i] = *(const u32x4*)(Ag + (size_t)(32 * i) * lda); rb[i] = *(const u32x4*)(Bg + (size_t)(32 * i) * ldb); }
#pragma unroll
    for (int i = 0; i < 4; ++i) { ra2[i] = *(const u32x4*)(Ag + (size_t)(32 * i) * lda + 64); rb2[i] = *(const u32x4*)(Bg + (size_t)(32 * i) * ldb + 64); }
#define GEMM_STEP(RA, RB, KNEXT)                                                                                   \
    {                                                                                                                \
        _Pragma("unroll") for (int i = 0; i < 4; ++i) {                                                              \
            *(u32x4*)(As + ((tid >> 3) + 32 * i) * 72 + (tid & 7) * 8) = RA[i];                                      \
            *(u32x4*)(Bs + ((tid >> 3) + 32 * i) * 72 + (tid & 7) * 8) = RB[i];                                      \
        }                                                                                                            \
        __syncthreads();                                                                                             \
        if ((KNEXT) < K) {                                                                                           \
            _Pragma("unroll") for (int i = 0; i < 4; ++i) {                                                          \
                RA[i] = *(const u32x4*)(Ag + (size_t)(32 * i) * lda + (KNEXT));                                      \
                RB[i] = *(const u32x4*)(Bg + (size_t)(32 * i) * ldb + (KNEXT));                                      \
            }                                                                                                        \
        }                                                                                                            \
        _Pragma("unroll") for (int ks = 0; ks < 2; ++ks) {                                                           \
            bf16x8 af[4], bfr[4];                                                                                    \
            _Pragma("unroll") for (int t = 0; t < 4; ++t) {                                                          \
                af[t] = *(const bf16x8*)(As + (wm * 64 + t * 16 + lr) * 72 + ks * 32 + quad * 8);                    \
                bfr[t] = *(const bf16x8*)(Bs + (wn * 64 + t * 16 + lr) * 72 + ks * 32 + quad * 8);                   \
            }                                                                                                        \
            _Pragma("unroll") for (int nt = 0; nt < 4; ++nt)                                                         \
                _Pragma("unroll") for (int mt = 0; mt < 4; ++mt) acc[nt][mt] = MFMA16(bfr[nt], af[mt], acc[nt][mt]); \
        }                                                                                                            \
        __syncthreads();                                                                                             \
    }
    for (int k0 = 0; k0 < K; k0 += 128) {
        GEMM_STEP(ra, rb, k0 + 128)
        GEMM_STEP(ra2, rb2, k0 + 192)
    }
#undef GEMM_STEP
    if constexpr (Epi::kPre) {
        f32x4 xs[4][4], gs[4];
#pragma unroll
        for (int nt = 0; nt < 4; ++nt) {
            gs[nt] = epi.gate(m0, n0 + wn * 64 + nt * 16 + quad * 4);
#pragma unroll
            for (int mt = 0; mt < 4; ++mt) xs[nt][mt] = epi.load(m0 + wm * 64 + mt * 16 + lr, n0 + wn * 64 + nt * 16 + quad * 4);
        }
#pragma unroll
        for (int nt = 0; nt < 4; ++nt)
#pragma unroll
            for (int mt = 0; mt < 4; ++mt) epi.store(m0 + wm * 64 + mt * 16 + lr, n0 + wn * 64 + nt * 16 + quad * 4, acc[nt][mt], xs[nt][mt], gs[nt]);
    } else {
#pragma unroll
        for (int nt = 0; nt < 4; ++nt)
#pragma unroll
            for (int mt = 0; mt < 4; ++mt) epi(m0 + wm * 64 + mt * 16 + lr, n0 + wn * 64 + nt * 16 + quad * 4, acc[nt][mt]);
    }
}

struct EpiProj {
    static constexpr bool kPre = false;
    bf16_t* out; bf16_t* zt;
    DI void operator()(int row, int col, f32x4 v) const {
        bf16x4 o; o[0] = (short)f2bf(v[0]); o[1] = (short)f2bf(v[1]); o[2] = (short)f2bf(v[2]); o[3] = (short)f2bf(v[3]);
        if (col >= C_HY && col < C_HY + 768) {
#pragma unroll
            for (int j = 0; j < 4; ++j) zt[(size_t)(col - C_HY + j) * NTOK + row] = (bf16_t)o[j];
        } else *(bf16x4*)(out + (size_t)row * NIN + col) = o;
    }
};
struct EpiOut {
    static constexpr bool kPre = true;
    const P* p; int l;
    DI f32x4 gate(int m0, int col) const { return *(const f32x4*)((const float*)(p->ws + WS_MOD) + (l * 3 + cond_of(m0)) * 3072 + 2048 + col); }
    DI f32x4 load(int row, int col) const { return *(const f32x4*)(xrow(*p, l, row) + col); }
    DI void store(int row, int col, f32x4 v, f32x4 x, f32x4 g) const { *(f32x4*)(p->out + (size_t)row * DM + col) = x + g * v; }
    DI void operator()(int row, int col, f32x4 v) const { store(row, col, v, load(row, col), gate(row, col)); }
};
struct EpiGlu {
    static constexpr bool kPre = false;
    const P* p; int l;
    DI void operator()(int row, int col, f32x4 v) const {
        const bf16_t* GS5 = (const bf16_t*)(p->ws + WS_GS5) + (size_t)row * 256 + col;
        const bf16_t* PR = (const bf16_t*)(p->ws + WS_PROJ) + (size_t)row * NIN + C_GS5 + col;
        bf16x4 gg = *(const bf16x4*)GS5, gs = *(const bf16x4*)PR;
        float4 b = *(const float4*)(p->in[I_GLUB] + l * 256 + col);
        const float bb[4] = {b.x, b.y, b.z, b.w};
        bf16x4 o;
#pragma unroll
        for (int j = 0; j < 4; ++j) { float g = bf2f((bf16_t)gg[j]); o[j] = (short)f2bf(g * sigmoidf_(v[j] + bb[j]) * siluf_(bf2f((bf16_t)gs[j]))); }
        *(bf16x4*)((bf16_t*)(p->ws + WS_HB) + (size_t)row * 1024 + 512 + col) = o;
    }
};

DI void mlaprep_item(const P& p, int l, int item, unsigned char* smem) {
    bf16_t* Aq = (bf16_t*)smem;
    bf16_t* Akv = Aq + 32 * 200;
    float* R = (float*)(Akv + 32 * 136);
    float* kr = R + 32 * 132;
    float* kn = kr + 32 * 32;
    float* cst = kn + 32 * 32;
    float* snt = cst + 32 * 16;
    const int tid = get_tid(), lane = tid & 63, w = tid >> 6, lr = lane & 15, quad = lane >> 4;
    const bool is_cache = item >= 384;
    int tok0 = 0, cb = 0, r0 = 0;
    if (!is_cache) tok0 = item * 32; else { cb = (item - 384) >> 4; r0 = ((item - 384) & 15) * 32; }
    const bool is_lat = !is_cache && tok0 >= NCTX;
    const bool do_rope = is_lat;
    int kbase, nkeys, kin0;
    if (is_cache) { kbase = 8192 + 2560 * cb; nkeys = 2560; kin0 = r0; }
    else if (is_lat) { int b = (tok0 - NCTX) >> 11; kbase = 8192 + 2560 * b; nkeys = 2560; kin0 = 512 + ((tok0 - NCTX) & 2047); }
    else { kbase = tok0 & ~255; nkeys = 256; kin0 = tok0 & 255; }
    const bf16_t* PR = (const bf16_t*)(p.ws + WS_PROJ);
    {
        const int t = tid >> 3, part = tid & 7;
        if (!is_cache) {
            const bf16_t* row = PR + (size_t)(tok0 + t) * NIN;
            const int tok = tok0 + t;
            {
                bf16x8 q[3];
#pragma unroll
                for (int c = 0; c < 3; ++c) q[c] = *(const bf16x8*)(row + C_CQ + part * 24 + 8 * c);
                float ss = 0.f;
#pragma unroll
                for (int c = 0; c < 3; ++c)
#pragma unroll
                    for (int j = 0; j < 8; ++j) { float x = bf2f((bf16_t)q[c][j]); ss += x * x; }
                ss += __shfl_xor(ss, 1); ss += __shfl_xor(ss, 2); ss += __shfl_xor(ss, 4);
                const float rq = rsqrtf(ss * (1.f / 192.f) + 1e-6f);
                const float4* wq4 = (const float4*)(p.in[I_QAN] + l * 192 + part * 24);
#pragma unroll
                for (int c = 0; c < 3; ++c) {
                    float4 w0 = wq4[2 * c], w1 = wq4[2 * c + 1];
                    bf16x8 o;
                    o[0] = (short)f2bf(bf2f((bf16_t)q[c][0]) * rq * w0.x); o[1] = (short)f2bf(bf2f((bf16_t)q[c][1]) * rq * w0.y);
                    o[2] = (short)f2bf(bf2f((bf16_t)q[c][2]) * rq * w0.z); o[3] = (short)f2bf(bf2f((bf16_t)q[c][3]) * rq * w0.w);
                    o[4] = (short)f2bf(bf2f((bf16_t)q[c][4]) * rq * w1.x); o[5] = (short)f2bf(bf2f((bf16_t)q[c][5]) * rq * w1.y);
                    o[6] = (short)f2bf(bf2f((bf16_t)q[c][6]) * rq * w1.z); o[7] = (short)f2bf(bf2f((bf16_t)q[c][7]) * rq * w1.w);
                    *(bf16x8*)(Aq + t * 200 + part * 24 + 8 * c) = o;
                }
            }
            {
                bf16x8 k[2];
#pragma unroll
                for (int c = 0; c < 2; ++c) k[c] = *(const bf16x8*)(row + C_CKV + part * 16 + 8 * c);
                float ss = 0.f;
#pragma unroll
                for (int c = 0; c < 2; ++c)
#pragma unroll
                    for (int j = 0; j < 8; ++j) { float x = bf2f((bf16_t)k[c][j]); ss += x * x; }
                ss += __shfl_xor(ss, 1); ss += __shfl_xor(ss, 2); ss += __shfl_xor(ss, 4);
                const float rk = rsqrtf(ss * (1.f / 128.f) + 1e-6f);
                const float4* wk4 = (const float4*)(p.in[I_KVAN] + l * 128 + part * 16);
                float* oc = p.out + OFF_CKV + ((size_t)((tok >> 8) * 2 + l) * 256 + (tok & 255)) * 128 + part * 16;
#pragma unroll
                for (int c = 0; c < 2; ++c) {
                    float4 w0 = wk4[2 * c], w1 = wk4[2 * c + 1];
                    float4 v0, v1;
                    v0.x = bf2f((bf16_t)k[c][0]) * rk * w0.x; v0.y = bf2f((bf16_t)k[c][1]) * rk * w0.y;
                    v0.z = bf2f((bf16_t)k[c][2]) * rk * w0.z; v0.w = bf2f((bf16_t)k[c][3]) * rk * w0.w;
                    v1.x = bf2f((bf16_t)k[c][4]) * rk * w1.x; v1.y = bf2f((bf16_t)k[c][5]) * rk * w1.y;
                    v1.z = bf2f((bf16_t)k[c][6]) * rk * w1.z; v1.w = bf2f((bf16_t)k[c][7]) * rk * w1.w;
                    bf16x8 o;
                    o[0] = (short)f2bf(v0.x); o[1] = (short)f2bf(v0.y); o[2] = (short)f2bf(v0.z); o[3] = (short)f2bf(v0.w);
                    o[4] = (short)f2bf(v1.x); o[5] = (short)f2bf(v1.y); o[6] = (short)f2bf(v1.z); o[7] = (short)f2bf(v1.w);
                    *(bf16x8*)(Akv + t * 136 + part * 16 + 8 * c) = o;
                    if (!is_lat) { *(float4*)(oc + 8 * c) = v0; *(float4*)(oc + 8 * c + 4) = v1; }
                }
            }
            {
                bf16x4 r4 = *(const bf16x4*)(row + C_KR + part * 4);
                float4 v = make_float4(bf2f((bf16_t)r4[0]), bf2f((bf16_t)r4[1]), bf2f((bf16_t)r4[2]), bf2f((bf16_t)r4[3]));
                *(float4*)(kr + t * 32 + part * 4) = v;
                if (!is_lat) *(float4*)(p.out + OFF_KR + ((size_t)((tok >> 8) * 2 + l) * 256 + (tok & 255)) * 32 + part * 4) = v;
            }
        } else {
            const float4* ck = (const float4*)(p.in[I_CCKV] + ((size_t)(cb * 2 + l) * 512 + r0 + t) * 128 + part * 16);
            const float4* ckr = (const float4*)(p.in[I_CKR] + ((size_t)(cb * 2 + l) * 512 + r0 + t) * 32 + part * 4);
#pragma unroll
            for (int c = 0; c < 2; ++c) {
                float4 v0 = ck[2 * c], v1 = ck[2 * c + 1];
                bf16x8 o;
                o[0] = (short)f2bf(v0.x); o[1] = (short)f2bf(v0.y); o[2] = (short)f2bf(v0.z); o[3] = (short)f2bf(v0.w);
                o[4] = (short)f2bf(v1.x); o[5] = (short)f2bf(v1.y); o[6] = (short)f2bf(v1.z); o[7] = (short)f2bf(v1.w);
                *(bf16x8*)(Akv + t * 136 + part * 16 + 8 * c) = o;
            }
            *(float4*)(kr + t * 32 + part * 4) = ckr[0];
        }
        if (do_rope) {
            for (int e = tid; e < 32 * 16; e += 256) {
                int tt = e >> 4, a = e & 15; int pos = (tok0 - NCTX + tt) & 2047;
                float pp = (a < 8) ? (float)(pos >> 6) : (float)(pos & 63);
                float inv = powf(10000.f, -(float)(a & 7) * 0.125f);
                float ang = pp * inv;
                cst[e] = cosf(ang); snt[e] = sinf(ang);
            }
        }
    }
    __syncthreads();
    const int mt = w & 1, nh = w >> 1;
    const float qscale = 0.10206207261596577f * 1.4426950408889634f;
    for (int h = 0; h < 4; ++h) {
        if (!is_cache) {
            f32x4 acc[3];
#pragma unroll
            for (int i = 0; i < 3; ++i) acc[i] = (f32x4){0.f, 0.f, 0.f, 0.f};
            const bf16_t* W = (const bf16_t*)(p.ws + WS_WTUQ) + (size_t)l * 384 * 192 + (size_t)(96 * h + 48 * nh + lr) * 192 + quad * 8;
#pragma unroll
            for (int ks = 0; ks < 6; ++ks) {
                bf16x8 xf = *(const bf16x8*)(Aq + (16 * mt + lr) * 200 + 32 * ks + quad * 8);
#pragma unroll
                for (int i = 0; i < 3; ++i) { bf16x8 wf = *(const bf16x8*)(W + (size_t)(16 * i) * 192 + 32 * ks); acc[i] = MFMA16(wf, xf, acc[i]); }
            }
#pragma unroll
            for (int i = 0; i < 3; ++i) *(f32x4*)(R + (16 * mt + lr) * 132 + 48 * nh + 16 * i + quad * 4) = acc[i];
            __syncthreads();
            {
                const int t = tid >> 3, part = tid & 7;
                float4* rp = (float4*)(R + t * 132 + part * 12);
                float4 x0 = rp[0], x1 = rp[1], x2 = rp[2];
                float ss = x0.x * x0.x + x0.y * x0.y + x0.z * x0.z + x0.w * x0.w + x1.x * x1.x + x1.y * x1.y + x1.z * x1.z + x1.w * x1.w
                         + x2.x * x2.x + x2.y * x2.y + x2.z * x2.z + x2.w * x2.w;
                ss += __shfl_xor(ss, 1); ss += __shfl_xor(ss, 2); ss += __shfl_xor(ss, 4);
                float r = rsqrtf(ss * (1.f / 96.f) + 1e-6f);
                const float4* wn = (const float4*)(p.in[I_QN] + l * 96 + part * 12);
                float4 w0 = wn[0], w1 = wn[1], w2 = wn[2];
                rp[0] = make_float4(x0.x * r * w0.x, x0.y * r * w0.y, x0.z * r * w0.z, x0.w * r * w0.w);
                rp[1] = make_float4(x1.x * r * w1.x, x1.y * r * w1.y, x1.z * r * w1.z, x1.w * r * w1.w);
                rp[2] = make_float4(x2.x * r * w2.x, x2.y * r * w2.y, x2.z * r * w2.z, x2.w * r * w2.w);
            }
            __syncthreads();
            {
                const int t = tid >> 3, part = tid & 7;
                bf16_t* Qo = (bf16_t*)(p.ws + WS_QB) + ((size_t)h * NTOK + tok0 + t) * 96;
                bf16_t qv[12];
#pragma unroll
                for (int j = 0; j < 12; ++j) {
                    int n = part * 12 + j; float v;
                    if (n < 64 || !do_rope) v = R[t * 132 + n];
                    else {
                        int i = (n - 64) & 7, half = ((n - 64) >> 3) & 1, ax = (n - 64) >> 4;
                        float x1 = R[t * 132 + 64 + 16 * ax + i], x2 = R[t * 132 + 64 + 16 * ax + 8 + i];
                        float c = cst[t * 16 + ax * 8 + i], s = snt[t * 16 + ax * 8 + i];
                        v = half == 0 ? x1 * c - x2 * s : x2 * c + x1 * s;
                    }
                    qv[j] = f2bf(v * qscale);
                }
#pragma unroll
                for (int c = 0; c < 3; ++c) { bf16x4 o; o[0] = (short)qv[4 * c]; o[1] = (short)qv[4 * c + 1]; o[2] = (short)qv[4 * c + 2]; o[3] = (short)qv[4 * c + 3]; *(bf16x4*)(Qo + part * 12 + 4 * c) = o; }
            }
            __syncthreads();
        }
        {
            f32x4 acc[4];
#pragma unroll
            for (int i = 0; i < 4; ++i) acc[i] = (f32x4){0.f, 0.f, 0.f, 0.f};
            const bf16_t* W = (const bf16_t*)(p.ws + WS_WTUKV) + (size_t)l * 512 * 128 + (size_t)(128 * h + 64 * nh + lr) * 128 + quad * 8;
#pragma unroll
            for (int ks = 0; ks < 4; ++ks) {
                bf16x8 xf = *(const bf16x8*)(Akv + (16 * mt + lr) * 136 + 32 * ks + quad * 8);
#pragma unroll
                for (int i = 0; i < 4; ++i) { bf16x8 wf = *(const bf16x8*)(W + (size_t)(16 * i) * 128 + 32 * ks); acc[i] = MFMA16(wf, xf, acc[i]); }
            }
#pragma unroll
            for (int i = 0; i < 4; ++i) *(f32x4*)(R + (16 * mt + lr) * 132 + 64 * nh + 16 * i + quad * 4) = acc[i];
        }
        __syncthreads();
        {
            const int t = tid >> 3, part = tid & 7;
            float4* rp = (float4*)(R + t * 132 + part * 8);
            float4 x0 = rp[0], x1 = rp[1], x2 = *(const float4*)(kr + t * 32 + part * 4);
            float ss = x0.x * x0.x + x0.y * x0.y + x0.z * x0.z + x0.w * x0.w + x1.x * x1.x + x1.y * x1.y + x1.z * x1.z + x1.w * x1.w
                     + x2.x * x2.x + x2.y * x2.y + x2.z * x2.z + x2.w * x2.w;
            ss += __shfl_xor(ss, 1); ss += __shfl_xor(ss, 2); ss += __shfl_xor(ss, 4);
            float r = rsqrtf(ss * (1.f / 96.f) + 1e-6f);
            const float4* wn = (const float4*)(p.in[I_KN] + l * 96 + part * 8);
            float4 w0 = wn[0], w1 = wn[1], w2 = *(const float4*)(p.in[I_KN] + l * 96 + 64 + part * 4);
            rp[0] = make_float4(x0.x * r * w0.x, x0.y * r * w0.y, x0.z * r * w0.z, x0.w * r * w0.w);
            rp[1] = make_float4(x1.x * r * w1.x, x1.y * r * w1.y, x1.z * r * w1.z, x1.w * r * w1.w);
            *(float4*)(kn + t * 32 + part * 4) = make_float4(x2.x * r * w2.x, x2.y * r * w2.y, x2.z * r * w2.z, x2.w * r * w2.w);
        }
        __syncthreads();
        {
            const int t = tid >> 3, part = tid & 7;
            bf16_t* Ko = (bf16_t*)(p.ws + WS_KB) + ((size_t)h * NKT + kbase + kin0 + t) * 96;
            bf16_t kv[12];
#pragma unroll
            for (int j = 0; j < 12; ++j) {
                int n = part * 12 + j; float v;
                if (n < 64) v = R[t * 132 + n];
                else if (!do_rope) v = kn[t * 32 + n - 64];
                else {
                    int i = (n - 64) & 7, half = ((n - 64) >> 3) & 1, ax = (n - 64) >> 4;
                    float x1 = kn[t * 32 + 16 * ax + i], x2 = kn[t * 32 + 16 * ax + 8 + i];
                    float c = cst[t * 16 + ax * 8 + i], s = snt[t * 16 + ax * 8 + i];
                    v = half == 0 ? x1 * c - x2 * s : x2 * c + x1 * s;
                }
                kv[j] = f2bf(v);
            }
#pragma unroll
            for (int c = 0; c < 3; ++c) { bf16x4 o; o[0] = (short)kv[4 * c]; o[1] = (short)kv[4 * c + 1]; o[2] = (short)kv[4 * c + 2]; o[3] = (short)kv[4 * c + 3]; *(bf16x4*)(Ko + part * 12 + 4 * c) = o; }
            const int dv = tid & 63, tg = tid >> 6;
            bf16x8 o;
#pragma unroll
            for (int j = 0; j < 8; ++j) o[j] = (short)f2bf(R[(tg * 8 + j) * 132 + 64 + dv]);
            bf16_t* Vo = (bf16_t*)(p.ws + WS_VT) + ((size_t)h * NKT + kbase) * 64 + (size_t)dv * nkeys + kin0 + tg * 8;
            *(bf16x8*)Vo = o;
        }
        __syncthreads();
    }
}

DI void attn_item(const P& p, int l, int item, unsigned char* smem) {
    bf16_t* Ks = (bf16_t*)smem;
    bf16_t* Vs = Ks + 64 * 104;
    const int tid = get_tid(), lane = tid & 63, w = tid >> 6, lr = lane & 15, quad = lane >> 4;
    int seq, h, qb;
    if (item < 128) { seq = 32 + (item >> 6); h = (item >> 4) & 3; qb = item & 15; }
    else { int j = item - 128; seq = j >> 3; h = (j >> 1) & 3; qb = j & 1; }
    int tokbase, nkeys, kbase;
    if (seq < 32) { tokbase = 256 * seq; nkeys = 256; kbase = 256 * seq; }
    else { tokbase = NCTX + 2048 * (seq - 32); nkeys = 2560; kbase = 8192 + 2560 * (seq - 32); }
    const bf16_t* Qp = (const bf16_t*)(p.ws + WS_QB) + ((size_t)h * NTOK + tokbase + qb * 128 + 32 * w) * 96;
    const bf16_t* Kp = (const bf16_t*)(p.ws + WS_KB) + ((size_t)h * NKT + kbase) * 96;
    const bf16_t* Vp = (const bf16_t*)(p.ws + WS_VT) + ((size_t)h * NKT + kbase) * 64;
    bf16x8 qf[2][3];
#pragma unroll
    for (int nt = 0; nt < 2; ++nt)
#pragma unroll
        for (int ks = 0; ks < 3; ++ks) qf[nt][ks] = *(const bf16x8*)(Qp + (16 * nt + lr) * 96 + 32 * ks + 8 * quad);
    f32x4 o[4][2];
#pragma unroll
    for (int a = 0; a < 4; ++a)
#pragma unroll
        for (int b = 0; b < 2; ++b) o[a][b] = (f32x4){0.f, 0.f, 0.f, 0.f};
    float mrow[2] = {-1e30f, -1e30f}, lsum[2] = {0.f, 0.f};
    u32x4 rk[3], rv[2];
    const int ntile = nkeys >> 6;
#pragma unroll
    for (int i = 0; i < 3; ++i) { int c = tid + 256 * i; rk[i] = *(const u32x4*)(Kp + (size_t)(c / 12) * 96 + (c % 12) * 8); }
#pragma unroll
    for (int i = 0; i < 2; ++i) { int c = tid + 256 * i; rv[i] = *(const u32x4*)(Vp + (size_t)(c >> 3) * nkeys + (c & 7) * 8); }
    for (int kt = 0; kt < ntile; ++kt) {
#pragma unroll
        for (int i = 0; i < 3; ++i) { int c = tid + 256 * i; *(u32x4*)(Ks + (c / 12) * 104 + (c % 12) * 8) = rk[i]; }
#pragma unroll
        for (int i = 0; i < 2; ++i) { int c = tid + 256 * i; *(u32x4*)(Vs + (c >> 3) * 72 + (c & 7) * 8) = rv[i]; }
        __syncthreads();
        if (kt + 1 < ntile) {
#pragma unroll
            for (int i = 0; i < 3; ++i) { int c = tid + 256 * i; rk[i] = *(const u32x4*)(Kp + (size_t)((kt + 1) * 64 + c / 12) * 96 + (c % 12) * 8); }
#pragma unroll
            for (int i = 0; i < 2; ++i) { int c = tid + 256 * i; rv[i] = *(const u32x4*)(Vp + (size_t)(c >> 3) * nkeys + (kt + 1) * 64 + (c & 7) * 8); }
        }
        f32x4 s[4][2];
#pragma unroll
        for (int a = 0; a < 4; ++a)
#pragma unroll
            for (int b = 0; b < 2; ++b) s[a][b] = (f32x4){0.f, 0.f, 0.f, 0.f};
#pragma unroll
        for (int ks = 0; ks < 3; ++ks)
#pragma unroll
            for (int mt = 0; mt < 4; ++mt) {
                bf16x8 kf = *(const bf16x8*)(Ks + (16 * mt + lr) * 104 + 32 * ks + 8 * quad);
#pragma unroll
                for (int nt = 0; nt < 2; ++nt) s[mt][nt] = MFMA16(kf, qf[nt][ks], s[mt][nt]);
            }
        bf16x8 pf[2][2];
#pragma unroll
        for (int nt = 0; nt < 2; ++nt) {
            float mx = -1e30f;
#pragma unroll
            for (int mt = 0; mt < 4; ++mt)
#pragma unroll
                for (int j = 0; j < 4; ++j) mx = fmaxf(mx, s[mt][nt][j]);
            mx = fmaxf(mx, __shfl_xor(mx, 16)); mx = fmaxf(mx, __shfl_xor(mx, 32));
            float mnew = fmaxf(mrow[nt], mx);
            float alpha = __builtin_amdgcn_exp2f(mrow[nt] - mnew);
            mrow[nt] = mnew;
            float rs = 0.f;
#pragma unroll
            for (int mt = 0; mt < 4; ++mt)
#pragma unroll
                for (int j = 0; j < 4; ++j) { float pv = __builtin_amdgcn_exp2f(s[mt][nt][j] - mnew); s[mt][nt][j] = pv; rs += pv; }
            lsum[nt] = lsum[nt] * alpha + rs;
#pragma unroll
            for (int dt = 0; dt < 4; ++dt) { o[dt][nt][0] *= alpha; o[dt][nt][1] *= alpha; o[dt][nt][2] *= alpha; o[dt][nt][3] *= alpha; }
#pragma unroll
            for (int kk = 0; kk < 2; ++kk)
                pf[kk][nt] = pack8_hw(s[2 * kk][nt][0], s[2 * kk][nt][1], s[2 * kk][nt][2], s[2 * kk][nt][3],
                                      s[2 * kk + 1][nt][0], s[2 * kk + 1][nt][1], s[2 * kk + 1][nt][2], s[2 * kk + 1][nt][3]);
        }
#pragma unroll
        for (int kk = 0; kk < 2; ++kk)
#pragma unroll
            for (int dt = 0; dt < 4; ++dt) {
                bf16x4 lo = *(const bf16x4*)(Vs + (16 * dt + lr) * 72 + 32 * kk + 4 * quad);
                bf16x4 hi = *(const bf16x4*)(Vs + (16 * dt + lr) * 72 + 32 * kk + 16 + 4 * quad);
                bf16x8 vf = __builtin_shufflevector(lo, hi, 0, 1, 2, 3, 4, 5, 6, 7);
#pragma unroll
                for (int nt = 0; nt < 2; ++nt) o[dt][nt] = MFMA16(vf, pf[kk][nt], o[dt][nt]);
            }
        __syncthreads();
    }
    const bf16_t* PR = (const bf16_t*)(p.ws + WS_PROJ);
    bf16_t* HB = (bf16_t*)(p.ws + WS_HB);
#pragma unroll
    for (int nt = 0; nt < 2; ++nt) {
        float lt = lsum[nt]; lt += __shfl_xor(lt, 16); lt += __shfl_xor(lt, 32);
        float inv = 1.f / lt;
        int tok = tokbase + qb * 128 + 32 * w + 16 * nt + lr;
#pragma unroll
        for (int dt = 0; dt < 4; ++dt) {
            int col = h * 64 + 16 * dt + 4 * quad;
            bf16x4 g = *(const bf16x4*)(PR + (size_t)tok * NIN + C_GMLA + col);
            bf16x4 ov;
#pragma unroll
            for (int j = 0; j < 4; ++j) ov[j] = (short)f2bf(o[dt][nt][j] * inv * siluf_(bf2f((bf16_t)g[j])));
            *(bf16x4*)(HB + (size_t)tok * 1024 + col) = ov;
        }
    }
}

DI void rt_item(const P& p, int item, unsigned char* smem) {
    float* tile = (float*)smem;
    const int tid = get_tid();
    int l = item / 576, r = item % 576;
    int order = r / 288; r %= 288;
    int cht = r / 72, xt = r % 72;
    const int lsel = xt >= 8 ? 1 : 0; if (lsel) xt -= 8;
    const int L = lsel ? 2048 : 256, x0 = xt * 64, ch0 = cht * 64;
    const float* HF = (const float*)(p.ws + WS_HF) + (size_t)l * HF_LAYER + (lsel ? (size_t)256 * 1024 : 0) + order * 256 + ch0;
    const float* HN = (const float*)(p.ws + WS_HNORM) + (l * 2 + lsel) * 512 + order * 256 + ch0;
#pragma unroll
    for (int i = 0; i < 16; ++i) {
        int e = tid + 256 * i; int xx = e >> 6, cc = e & 63;
        int d = L - 1 - (x0 + xx);
        float v = 0.f;
        if (d >= 0) v = HF[(size_t)d * 1024 + cc]; else if (d > -L) v = HF[(size_t)(-d) * 1024 + 512 + cc];
        tile[xx * 65 + cc] = v * HN[cc];
    }
    __syncthreads();
    bf16_t* RT = lsel ? (bf16_t*)(p.ws + WS_RTL) + ((size_t)(l * 2 + order) * 256 + ch0) * 4096 : (bf16_t*)(p.ws + WS_RTC) + ((size_t)(l * 2 + order) * 256 + ch0) * 512;
    const int XL = 2 * L;
#pragma unroll
    for (int i = 0; i < 16; ++i) { int e = tid + 256 * i; int cc = e >> 6, xx = e & 63; RT[(size_t)cc * XL + x0 + xx] = f2bf(tile[xx * 65 + cc]); }
    __syncthreads();
}

DI void hy_short4(const P& p, int l, int ch768, int tokseq0, int L, int t, float* o) {
    const bf16_t* Z = (const bf16_t*)(p.ws + WS_ZT) + (size_t)ch768 * NTOK + tokseq0 + t;
    const float* cw = p.in[I_HCW] + l * 3 * 768 + ch768;
    const float w0 = cw[0], w1 = cw[768], w2 = cw[1536], bb = p.in[I_HCB][l * 768 + ch768];
    bf16x4 m = *(const bf16x4*)Z;
    const float zm = t > 0 ? bf2f(Z[-1]) : 0.f;
    const float z0 = bf2f((bf16_t)m[0]), z1 = bf2f((bf16_t)m[1]), z2 = bf2f((bf16_t)m[2]), z3 = bf2f((bf16_t)m[3]);
    const float zp = t + 4 < L ? bf2f(Z[4]) : 0.f;
    o[0] = bb + w0 * zm + w1 * z0 + w2 * z1;
    o[1] = bb + w0 * z0 + w1 * z1 + w2 * z2;
    o[2] = bb + w0 * z1 + w1 * z2 + w2 * z3;
    o[3] = bb + w0 * z2 + w1 * z3 + w2 * zp;
}
DI bf16x8 hy_short8(const P& p, int l, int ch768, int tokseq0, int L, int t) {
    const bf16_t* Z = (const bf16_t*)(p.ws + WS_ZT) + (size_t)ch768 * NTOK + tokseq0 + t;
    const float* cw = p.in[I_HCW] + l * 3 * 768 + ch768;
    const float w0 = cw[0], w1 = cw[768], w2 = cw[1536], bb = p.in[I_HCB][l * 768 + ch768];
    bf16x8 m = *(const bf16x8*)Z;
    const float zm = t > 0 ? bf2f(Z[-1]) : 0.f;
    const float z0 = bf2f((bf16_t)m[0]), z1 = bf2f((bf16_t)m[1]), z2 = bf2f((bf16_t)m[2]), z3 = bf2f((bf16_t)m[3]);
    const float z4 = bf2f((bf16_t)m[4]), z5 = bf2f((bf16_t)m[5]), z6 = bf2f((bf16_t)m[6]), z7 = bf2f((bf16_t)m[7]);
    const float zp = t + 8 < L ? bf2f(Z[8]) : 0.f;
    bf16x8 o;
    o[0] = (short)f2bf(bb + w0 * zm + w1 * z0 + w2 * z1);
    o[1] = (short)f2bf(bb + w0 * z0 + w1 * z1 + w2 * z2);
    o[2] = (short)f2bf(bb + w0 * z1 + w1 * z2 + w2 * z3);
    o[3] = (short)f2bf(bb + w0 * z2 + w1 * z3 + w2 * z4);
    o[4] = (short)f2bf(bb + w0 * z3 + w1 * z4 + w2 * z5);
    o[5] = (short)f2bf(bb + w0 * z4 + w1 * z5 + w2 * z6);
    o[6] = (short)f2bf(bb + w0 * z5 + w1 * z6 + w2 * z7);
    o[7] = (short)f2bf(bb + w0 * z6 + w1 * z7 + w2 * zp);
    return o;
}

DI void hy2_item(const P& p, int l, int which, int item, unsigned char* smem) {
    const int tid = get_tid(), lane = tid & 63, w = tid >> 6, lr = lane & 15, quad = lane >> 4;
    const bool lat = item < 256;
    const int c = lat ? item : item - 256;
    const int XL = lat ? 4096 : 512;
    unsigned* c0 = (unsigned*)smem;
    unsigned* c1 = c0 + 2048 + 16;
    bf16_t* U = (bf16_t*)(c1 + 2048 + 16);
    const bf16_t* RT = lat ? (const bf16_t*)(p.ws + WS_RTL) + ((size_t)(l * 2 + which) * 256 + c) * 4096
                           : (const bf16_t*)(p.ws + WS_RTC) + ((size_t)(l * 2 + which) * 256 + c) * 512;
    const bf16_t* Y1T = (const bf16_t*)(p.ws + WS_Y1T) + (size_t)c * NTOK;
    for (int i = tid; i < XL / 8; i += 256) *(u32x4*)(c0 + 4 * i) = *(const u32x4*)(RT + 8 * i);
    if (lat) {
        for (int i = tid; i < 2 * 64 * 72 / 8; i += 256) *(u32x4*)(U + 8 * i) = (u32x4){0u, 0u, 0u, 0u};
    }
    __syncthreads();
    for (int i = tid; i < XL / 2; i += 256) { unsigned lo = c0[i], hi = (i + 1 < XL / 2) ? c0[i + 1] : 0u; c1[i] = (lo >> 16) | (hi << 16); }
    if (lat) {
        for (int i = tid; i < 512; i += 256) {
            int b = i >> 8, t = (i & 255) * 8;
            bf16x8 v = which == 0 ? hy_short8(p, l, c, NCTX + 2048 * b, 2048, t) : *(const bf16x8*)(Y1T + NCTX + 2048 * b + t);
            *(bf16x8*)(U + (size_t)(b * 64 + 16 + (t >> 6)) * 72 + (t & 63)) = v;
        }
    } else {
        for (int i = tid; i < 1024; i += 256) {
            int b = i >> 5, t = (i & 31) * 8;
            bf16x8 v = which == 0 ? hy_short8(p, l, c, 256 * b, 256, t) : *(const bf16x8*)(Y1T + 256 * b + t);
            *(bf16x8*)(U + b * 264 + t) = v;
        }
    }
    __syncthreads();
    const float bias = p.in[I_HBIAS][(l * 2 + which) * 256 + c];
    bf16_t* OT = (which == 0 ? (bf16_t*)(p.ws + WS_Y1T) : (bf16_t*)(p.ws + WS_OUTT)) + (size_t)c * NTOK;
    const int xch = (which == 0 ? 256 : 512) + c;
    const int par = (lr + 1) & 1;
    const unsigned* cp = par ? c1 : c0;
    if (lat) {
        const int b = w >> 1, ih = w & 1;
        const int lane_dw = (2047 - lr - par) / 2 + 4 * quad;
        f32x4 acc[4];
#pragma unroll
        for (int i = 0; i < 4; ++i) acc[i] = (f32x4){0.f, 0.f, 0.f, 0.f};
        const int dlo = ih ? -15 : -31, dhi = ih ? 31 : 15;
        for (int dl = dlo; dl <= dhi; ++dl) {
#pragma unroll
            for (int ks = 0; ks < 2; ++ks) {
                bf16x8 bfr = *(const bf16x8*)(U + (size_t)(b * 64 + 16 + 16 * ih + lr - dl) * 72 + 32 * ks + 8 * quad);
#pragma unroll
                for (int mt = 0; mt < 4; ++mt) {
                    const unsigned* ap = cp + lane_dw - 32 * dl - 8 * mt + 16 * ks;
                    u32x4 av; av[0] = ap[0]; av[1] = ap[1]; av[2] = ap[2]; av[3] = ap[3];
                    acc[mt] = MFMA16(__builtin_bit_cast(bf16x8, av), bfr, acc[mt]);
                }
            }
        }
        const int tokseq0 = NCTX + 2048 * b;
#pragma unroll
        for (int mt = 0; mt < 4; ++mt) {
            const int t = 64 * (16 * ih + lr) + 16 * mt + 4 * quad;
            float x[4]; hy_short4(p, l, xch, tokseq0, 2048, t, x);
            bf16x4 uu = *(const bf16x4*)(U + (size_t)(b * 64 + 16 + (t >> 6)) * 72 + (t & 63));
            bf16x4 o;
#pragma unroll
            for (int j = 0; j < 4; ++j) o[j] = (short)f2bf(x[j] * (acc[mt][j] + bias * bf2f((bf16_t)uu[j])));
            *(bf16x4*)(OT + tokseq0 + t) = o;
        }
    } else {
        const int lane_dw = (255 - lr - par) / 2 + 4 * quad;
        f32x4 acc[4][2];
#pragma unroll
        for (int i = 0; i < 4; ++i) { acc[i][0] = (f32x4){0.f, 0.f, 0.f, 0.f}; acc[i][1] = (f32x4){0.f, 0.f, 0.f, 0.f}; }
#pragma unroll 2
        for (int ks = 0; ks < 8; ++ks) {
            bf16x8 b0 = *(const bf16x8*)(U + lr * 264 + 32 * ks + 8 * quad);
            bf16x8 b1 = *(const bf16x8*)(U + (16 + lr) * 264 + 32 * ks + 8 * quad);
#pragma unroll
            for (int mi = 0; mi < 4; ++mi) {
                const unsigned* ap = cp + lane_dw - 8 * (4 * w + mi) + 16 * ks;
                u32x4 av; av[0] = ap[0]; av[1] = ap[1]; av[2] = ap[2]; av[3] = ap[3];
                bf16x8 af = __builtin_bit_cast(bf16x8, av);
                acc[mi][0] = MFMA16(af, b0, acc[mi][0]);
                acc[mi][1] = MFMA16(af, b1, acc[mi][1]);
            }
        }
#pragma unroll
        for (int mi = 0; mi < 4; ++mi)
#pragma unroll
            for (int nt = 0; nt < 2; ++nt) {
                const int b = 16 * nt + lr, t = 16 * (4 * w + mi) + 4 * quad;
                float x[4]; hy_short4(p, l, xch, 256 * b, 256, t, x);
                bf16x4 uu = *(const bf16x4*)(U + b * 264 + t);
                bf16x4 o;
#pragma unroll
                for (int j = 0; j < 4; ++j) o[j] = (short)f2bf(x[j] * (acc[mi][nt][j] + bias * bf2f((bf16_t)uu[j])));
                *(bf16x4*)(OT + 256 * b + t) = o;
            }
    }
    __syncthreads();
}

DI void hyfin_item(const P& p, int item, unsigned char* smem) {
    bf16_t* tile = (bf16_t*)smem;
    const int tid = get_tid();
    const int tok0 = (item >> 2) * 64, ch0 = (item & 3) * 64;
    {
        const int cc = tid >> 2, part = tid & 3;
        const bf16_t* src = (const bf16_t*)(p.ws + WS_OUTT) + (size_t)(ch0 + cc) * NTOK + tok0 + part * 16;
        *(u32x4*)(tile + cc * 72 + part * 16) = *(const u32x4*)src;
        *(u32x4*)(tile + cc * 72 + part * 16 + 8) = *(const u32x4*)(src + 8);
    }
    __syncthreads();
    {
        const int tt = tid >> 2, part = tid & 3;
        const bf16_t* g = (const bf16_t*)(p.ws + WS_PROJ) + (size_t)(tok0 + tt) * NIN + C_GHY + ch0 + part * 16;
        bf16x8 g0 = *(const bf16x8*)g, g1 = *(const bf16x8*)(g + 8);
        bf16x8 o0, o1;
#pragma unroll
        for (int j = 0; j < 8; ++j) {
            o0[j] = (short)f2bf(bf2f(tile[(part * 16 + j) * 72 + tt]) * siluf_(bf2f((bf16_t)g0[j])));
            o1[j] = (short)f2bf(bf2f(tile[(part * 16 + 8 + j) * 72 + tt]) * siluf_(bf2f((bf16_t)g1[j])));
        }
        bf16_t* dst = (bf16_t*)(p.ws + WS_HB) + (size_t)(tok0 + tt) * 1024 + 256 + ch0 + part * 16;
        *(bf16x8*)dst = o0; *(bf16x8*)(dst + 8) = o1;
    }
    __syncthreads();
}

DI bf16x8 pack8(float a0, float a1, float a2, float a3, float a4, float a5, float a6, float a7) {
    typedef __bf16 bfv8 __attribute__((ext_vector_type(8)));
    typedef float fv8 __attribute__((ext_vector_type(8)));
    fv8 v = {a0, a1, a2, a3, a4, a5, a6, a7};
    return __builtin_bit_cast(bf16x8, __builtin_convertvector(v, bfv8));
}
DI void s5prep_item(const P& p, int item) {
    const int tid = get_tid();
    if (tid < 64) {
        const int pst = tid;
        unsigned char* T = p.ws + WS_S5T + (size_t)item * S5T_STRIDE;
        const int pidx = item * 64 + pst;
        const float are = fminf(p.in[I_AR][pidx], -1e-4f), aim = p.in[I_AI][pidx];
        const float dt = expf(p.in[I_LDT][item]);
        float abr, abi, Ar, Ai;
        { float m = expf(are * dt); float sn, cn; sincosf(aim * dt, &sn, &cn); abr = m * cn; abi = m * sn; }
        { float m = expf(are * dt * 256.f); float sn, cn; sincosf(aim * dt * 256.f, &sn, &cn); Ar = m * cn; Ai = m * sn; }
        ((float2*)T)[pst] = make_float2(abr, abi);
        ((float2*)T)[64 + pst] = make_float2(Ar, Ai);
        float nr = abr - 1.f, ni = abi; float den = 1.f / (are * are + aim * aim);
        float cfr = (nr * are + ni * aim) * den, cfi = (ni * are - nr * aim) * den;
        bf16_t* Bt = (bf16_t*)(T + 1024);
        bf16_t* Ct = (bf16_t*)(T + 1024 + 4096);
        for (int i = 0; i < 16; ++i) {
            float br = p.in[I_BR][(size_t)pidx * 16 + i], bi = p.in[I_BI][(size_t)pidx * 16 + i];
            Bt[(2 * pst) * 16 + i] = f2bf(cfr * br - cfi * bi);
            Bt[(2 * pst + 1) * 16 + i] = f2bf(cfr * bi + cfi * br);
            size_t ci = (size_t)(item * 16 + i) * 64 + pst;
            Ct[i * 128 + 2 * pst] = f2bf(p.in[I_CR][ci]);
            Ct[i * 128 + 2 * pst + 1] = f2bf(-p.in[I_CI][ci]);
        }
    }
}
DI void s5_item(const P& p, int l, int sc, int g, int dir, int mode, unsigned char* smem) {
    bf16_t* Ub = (bf16_t*)smem;
    float* H = (float*)(Ub + 256 * 16);
    const int tid = get_tid(), lane = tid & 63, w = tid >> 6, lr = lane & 15, quad = lane >> 4;
    const int pst = lane;
    const bool lat = sc >= 32;
    const int tokc = lat ? NCTX + 256 * (sc - 32) : 256 * sc;
    const int lb = lat ? (sc - 32) >> 3 : 0, lj = lat ? (sc - 32) & 7 : 0;
    const bf16_t* PR = (const bf16_t*)(p.ws + WS_PROJ);
    for (int e = tid; e < 512; e += 256) *(u32x4*)(Ub + 8 * e) = *(const u32x4*)(PR + (size_t)(tokc + (e >> 1)) * NIN + C_S5 + 16 * g + 8 * (e & 1));
    const unsigned char* T = p.ws + WS_S5T + (size_t)((l * 2 + dir) * 16 + g) * S5T_STRIDE;
    const float2 ab = ((const float2*)T)[pst];
    const float abr = ab.x, abi = ab.y;
    bf16x8 afB[8];
#pragma unroll
    for (int mt = 0; mt < 8; ++mt) {
        afB[mt] = (bf16x8){0, 0, 0, 0, 0, 0, 0, 0};
        if (quad < 2) afB[mt] = *(const bf16x8*)((const bf16_t*)(T + 1024) + (16 * mt + lr) * 16 + 8 * quad);
    }
    bf16x8 afC[4];
    if (mode == 1) {
#pragma unroll
        for (int ks = 0; ks < 4; ++ks) afC[ks] = *(const bf16x8*)((const bf16_t*)(T + 1024 + 4096) + lr * 128 + 32 * ks + 8 * quad);
    }
    float hr = 0.f, hi = 0.f;
    if (mode == 1 && lat && w == 0) {
        const float* h0 = p.in[I_SS5] + ((size_t)(((lb * 2 + l) * 2 + dir) * 16 + g) * 64 + pst) * 2;
        hr = h0[0]; hi = h0[1];
        const float2 A2 = ((const float2*)T)[64 + pst];
        const float Ar = A2.x, Ai = A2.y;
        const float* LOC = (const float*)(p.ws + WS_S5LOC);
        if (dir == 0) {
            for (int j = 0; j < lj; ++j) {
                const float* lc = LOC + ((size_t)(((lb * 8 + j) * 16 + g) * 2 + dir) * 64 + pst) * 2;
                float nr = Ar * hr - Ai * hi + lc[0], ni = Ar * hi + Ai * hr + lc[1]; hr = nr; hi = ni;
            }
        } else {
            for (int j = 7; j > lj; --j) {
                const float* lc = LOC + ((size_t)(((lb * 8 + j) * 16 + g) * 2 + dir) * 64 + pst) * 2;
                float nr = Ar * hr - Ai * hi + lc[0], ni = Ar * hi + Ai * hr + lc[1]; hr = nr; hi = ni;
            }
        }
    }
    __syncthreads();
    for (int sbi = 0; sbi < 4; ++sbi) {
        const int sub = dir == 0 ? sbi : 3 - sbi;
        const int tl = sub * 64 + 16 * w + lr, tok = tokc + tl, ch = 16 * g + 4 * quad;
        float* YS = (float*)(p.ws + WS_YS5) + (size_t)tok * 256 + ch;
        float4 pv = make_float4(0.f, 0.f, 0.f, 0.f);
        if (mode == 1 && dir == 1) pv = *(const float4*)YS;
        {
            bf16x8 bfr = (bf16x8){0, 0, 0, 0, 0, 0, 0, 0};
            if (quad < 2) bfr = *(const bf16x8*)(Ub + tl * 16 + 8 * quad);
#pragma unroll
            for (int mt = 0; mt < 8; ++mt) {
                f32x4 acc = MFMA16(afB[mt], bfr, ((f32x4){0.f, 0.f, 0.f, 0.f}));
                *(f32x4*)(H + (16 * w + lr) * 132 + 16 * mt + 4 * quad) = acc;
            }
        }
        __syncthreads();
        if (w == 0) {
#pragma unroll 8
            for (int k = 0; k < 64; ++k) {
                int tt = dir == 0 ? k : 63 - k;
                float2 b = *(const float2*)(H + tt * 132 + 2 * pst);
                float nr = abr * hr - abi * hi + b.x, ni = abr * hi + abi * hr + b.y; hr = nr; hi = ni;
                *(float2*)(H + tt * 132 + 2 * pst) = make_float2(hr, hi);
            }
        }
        __syncthreads();
        if (mode == 1) {
            f32x4 acc = (f32x4){0.f, 0.f, 0.f, 0.f};
#pragma unroll
            for (int ks = 0; ks < 4; ++ks) {
                const float* hp = H + (16 * w + lr) * 132 + 32 * ks + 8 * quad;
                float4 x0 = *(const float4*)hp, x1 = *(const float4*)(hp + 4);
                bf16x8 bfr = pack8(x0.x, x0.y, x0.z, x0.w, x1.x, x1.y, x1.z, x1.w);
                acc = MFMA16(afC[ks], bfr, acc);
            }
            if (dir == 0) {
                bf16x4 uu = *(const bf16x4*)(Ub + tl * 16 + 4 * quad);
                float4 dd = *(const float4*)(p.in[I_S5D] + l * 256 + ch);
                float4 o;
                o.x = dd.x * bf2f((bf16_t)uu[0]) + acc[0]; o.y = dd.y * bf2f((bf16_t)uu[1]) + acc[1];
                o.z = dd.z * bf2f((bf16_t)uu[2]) + acc[2]; o.w = dd.w * bf2f((bf16_t)uu[3]) + acc[3];
                *(float4*)YS = o;
            } else {
                bf16x4 o;
                o[0] = (short)f2bf(gelu_tanh(pv.x + acc[0])); o[1] = (short)f2bf(gelu_tanh(pv.y + acc[1]));
                o[2] = (short)f2bf(gelu_tanh(pv.z + acc[2])); o[3] = (short)f2bf(gelu_tanh(pv.w + acc[3]));
                *(bf16x4*)((bf16_t*)(p.ws + WS_GS5) + (size_t)tok * 256 + ch) = o;
            }
            __syncthreads();
        }
    }
    if (w == 0) {
        if (mode == 0) {
            float* lc = (float*)(p.ws + WS_S5LOC) + ((size_t)(((lb * 8 + lj) * 16 + g) * 2 + dir) * 64 + pst) * 2;
            lc[0] = hr; lc[1] = hi;
        } else if (!lat) {
            float* o = p.out + OFF_S5 + ((size_t)(((sc * 2 + l) * 2 + dir) * 16 + g) * 64 + pst) * 2;
            o[0] = hr; o[1] = hi;
        }
    }
    __syncthreads();
}

DI void gla_item(const P& p, int l, int sc, int head, int dir, int mode, unsigned char* smem) {
    float* qs = (float*)smem;
    float* ks = qs + 1024;
    float* ds = ks + 1024;
    float* vs = ds + 1024;
    float* gl = vs + 2048;
    float* gwl = gl + 512;
    float* ob = gwl + 544;
    const int tid = get_tid(), lane = tid & 63, w = tid >> 6;
    const int e = 16 * w + (lane & 15), dq = lane >> 4;
    const bool lat = sc >= 32;
    const int tokc = lat ? NCTX + 256 * (sc - 32) : 256 * sc;
    const int lb = lat ? (sc - 32) >> 3 : 0, lj = lat ? (sc - 32) & 7 : 0;
    const bf16_t* PR = (const bf16_t*)(p.ws + WS_PROJ);
    float S[8];
#pragma unroll
    for (int i = 0; i < 8; ++i) S[i] = 0.f;
    float acum[8];
#pragma unroll
    for (int i = 0; i < 8; ++i) acum[i] = 1.f;
    for (int i = tid; i < 544; i += 256)
        gwl[i] = i < 512 ? p.in[I_GGW][(size_t)((l * 2 + dir) * 16 + (i >> 5)) * 128 + 32 * head + (i & 31)] : p.in[I_GGB][(l * 2 + dir) * 128 + 32 * head + (i - 512)];
    if (mode == 1 && lat) {
        const float* s0 = p.in[I_SGLA] + (size_t)(((lb * 2 + l) * 2 + dir) * 4 + head) * 2048;
#pragma unroll
        for (int i = 0; i < 8; ++i) S[i] = s0[(8 * dq + i) * 64 + e];
        const float* LOC = (const float*)(p.ws + WS_GLALOC);
        if (dir == 0) {
            for (int j = 0; j < lj; ++j) {
                const float* lc = LOC + (size_t)(((lb * 8 + j) * 4 + head) * 2 + dir) * 2080;
#pragma unroll
                for (int i = 0; i < 8; ++i) S[i] = lc[2048 + 8 * dq + i] * S[i] + lc[(8 * dq + i) * 64 + e];
            }
        } else {
            for (int j = 7; j > lj; --j) {
                const float* lc = LOC + (size_t)(((lb * 8 + j) * 4 + head) * 2 + dir) * 2080;
#pragma unroll
                for (int i = 0; i < 8; ++i) S[i] = lc[2048 + 8 * dq + i] * S[i] + lc[(8 * dq + i) * 64 + e];
            }
        }
    }
    float* OG = (float*)(p.ws + WS_OGLA) + (size_t)dir * NTOK * 256;
    bf16x8 rqk, rv8, rg8 = (bf16x8){0, 0, 0, 0, 0, 0, 0, 0};
    const int qk_t = (tid & 127) >> 2, qk_c = (tid & 3) * 8, qk_col = (tid < 128 ? C_GQ : C_GK) + 32 * head + qk_c;
    {
        const int sub = dir == 0 ? 0 : 7; const int tk0 = tokc + sub * 32;
        rqk = *(const bf16x8*)(PR + (size_t)(tk0 + qk_t) * NIN + qk_col);
        rv8 = *(const bf16x8*)(PR + (size_t)(tk0 + (tid >> 3)) * NIN + C_GV + 64 * head + (tid & 7) * 8);
        if (tid < 64) rg8 = *(const bf16x8*)(PR + (size_t)(tk0 + (tid >> 1)) * NIN + C_GG + 16 * dir + (tid & 1) * 8);
    }
    for (int sbi = 0; sbi < 8; ++sbi) {
        const int sub = dir == 0 ? sbi : 7 - sbi;
        const int tk0 = tokc + sub * 32;
        __syncthreads();
        {
            float* dq_ = (tid < 128 ? qs : ks) + qk_t * 32 + qk_c;
            const float sc_ = tid < 128 ? 0.17677669529663687f : 1.f;
            *(float4*)dq_ = make_float4(bf2f((bf16_t)rqk[0]) * sc_, bf2f((bf16_t)rqk[1]) * sc_, bf2f((bf16_t)rqk[2]) * sc_, bf2f((bf16_t)rqk[3]) * sc_);
            *(float4*)(dq_ + 4) = make_float4(bf2f((bf16_t)rqk[4]) * sc_, bf2f((bf16_t)rqk[5]) * sc_, bf2f((bf16_t)rqk[6]) * sc_, bf2f((bf16_t)rqk[7]) * sc_);
            float* dv_ = vs + (tid >> 3) * 64 + (tid & 7) * 8;
            *(float4*)dv_ = make_float4(bf2f((bf16_t)rv8[0]), bf2f((bf16_t)rv8[1]), bf2f((bf16_t)rv8[2]), bf2f((bf16_t)rv8[3]));
            *(float4*)(dv_ + 4) = make_float4(bf2f((bf16_t)rv8[4]), bf2f((bf16_t)rv8[5]), bf2f((bf16_t)rv8[6]), bf2f((bf16_t)rv8[7]));
            if (tid < 64) {
                float* dg_ = gl + (tid >> 1) * 16 + (tid & 1) * 8;
                *(float4*)dg_ = make_float4(bf2f((bf16_t)rg8[0]), bf2f((bf16_t)rg8[1]), bf2f((bf16_t)rg8[2]), bf2f((bf16_t)rg8[3]));
                *(float4*)(dg_ + 4) = make_float4(bf2f((bf16_t)rg8[4]), bf2f((bf16_t)rg8[5]), bf2f((bf16_t)rg8[6]), bf2f((bf16_t)rg8[7]));
            }
        }
        __syncthreads();
        if (sbi < 7) {
            const int nsub = dir == 0 ? sbi + 1 : 6 - sbi; const int nk0 = tokc + nsub * 32;
            rqk = *(const bf16x8*)(PR + (size_t)(nk0 + qk_t) * NIN + qk_col);
            rv8 = *(const bf16x8*)(PR + (size_t)(nk0 + (tid >> 3)) * NIN + C_GV + 64 * head + (tid & 7) * 8);
            if (tid < 64) rg8 = *(const bf16x8*)(PR + (size_t)(nk0 + (tid >> 1)) * NIN + C_GG + 16 * dir + (tid & 1) * 8);
        }
#pragma unroll
        for (int j = 0; j < 4; ++j) {
            int i = tid + 256 * j; int t = i >> 5, d = i & 31;
            float z = gwl[512 + d];
#pragma unroll
            for (int r = 0; r < 16; ++r) z += gl[t * 16 + r] * gwl[r * 32 + d];
            float ls = fminf(z, 0.f) - __logf(1.f + __expf(-fabsf(z)));
            ds[i] = __expf(ls * (1.f / 16.f));
        }
        __syncthreads();
        {
            f32x2 S2[4], A2[4];
#pragma unroll
            for (int i = 0; i < 4; ++i) { S2[i] = (f32x2){S[2 * i], S[2 * i + 1]}; A2[i] = (f32x2){acum[2 * i], acum[2 * i + 1]}; }
#pragma unroll 4
            for (int k = 0; k < 32; ++k) {
                const int t = dir == 0 ? k : 31 - k;
                const float4* ap = (const float4*)(ds + t * 32 + 8 * dq);
                const float4* kp = (const float4*)(ks + t * 32 + 8 * dq);
                const float4 a0 = ap[0], a1 = ap[1], k0 = kp[0], k1 = kp[1];
                const float v = vs[t * 64 + e];
                const f32x2 vv = (f32x2){v, v};
                const f32x2 a01 = (f32x2){a0.x, a0.y}, a23 = (f32x2){a0.z, a0.w}, a45 = (f32x2){a1.x, a1.y}, a67 = (f32x2){a1.z, a1.w};
                S2[0] = a01 * S2[0] + (f32x2){k0.x, k0.y} * vv;
                S2[1] = a23 * S2[1] + (f32x2){k0.z, k0.w} * vv;
                S2[2] = a45 * S2[2] + (f32x2){k1.x, k1.y} * vv;
                S2[3] = a67 * S2[3] + (f32x2){k1.z, k1.w} * vv;
                if (mode == 1) {
                    const float4* qp = (const float4*)(qs + t * 32 + 8 * dq);
                    const float4 q0 = qp[0], q1 = qp[1];
                    f32x2 oo = (f32x2){q0.x, q0.y} * S2[0];
                    oo = (f32x2){q0.z, q0.w} * S2[1] + oo;
                    oo = (f32x2){q1.x, q1.y} * S2[2] + oo;
                    oo = (f32x2){q1.z, q1.w} * S2[3] + oo;
                    ob[(t * 64 + e) * 4 + dq] = oo[0] + oo[1];
                } else {
                    A2[0] *= a01; A2[1] *= a23; A2[2] *= a45; A2[3] *= a67;
                }
            }
#pragma unroll
            for (int i = 0; i < 4; ++i) { S[2 * i] = S2[i][0]; S[2 * i + 1] = S2[i][1]; acum[2 * i] = A2[i][0]; acum[2 * i + 1] = A2[i][1]; }
        }
        if (mode == 1) {
            __syncthreads();
            const int t = tid >> 3, e0 = (tid & 7) * 8;
            float r[8];
#pragma unroll
            for (int j = 0; j < 8; ++j) { float4 x = *(const float4*)(ob + (t * 64 + e0 + j) * 4); r[j] = (x.x + x.y) + (x.z + x.w); }
            float* dst = OG + (size_t)(tk0 + t) * 256 + 64 * head + e0;
            *(float4*)dst = make_float4(r[0], r[1], r[2], r[3]);
            *(float4*)(dst + 4) = make_float4(r[4], r[5], r[6], r[7]);
        }
    }
    if (mode == 0) {
        float* lc = (float*)(p.ws + WS_GLALOC) + (size_t)(((lb * 8 + lj) * 4 + head) * 2 + dir) * 2080;
#pragma unroll
        for (int i = 0; i < 8; ++i) lc[(8 * dq + i) * 64 + e] = S[i];
        if (w == 0 && (lane & 15) == 0) {
#pragma unroll
            for (int i = 0; i < 8; ++i) lc[2048 + 8 * dq + i] = acum[i];
        }
    } else if (!lat) {
        float* o = p.out + OFF_GLA + (size_t)(((sc * 2 + l) * 2 + dir) * 4 + head) * 2048;
#pragma unroll
        for (int i = 0; i < 8; ++i) o[(8 * dq + i) * 64 + e] = S[i];
    }
    __syncthreads();
}

DI void glafin_item(const P& p, int l, int item) {
    const int tid_ = get_tid(); const int lane = tid_ & 63, w = tid_ >> 6;
    float4 a[2], b[2]; bf16x4 g[2];
#pragma unroll
    for (int j = 0; j < 2; ++j) {
        const int tok = (item * 2 + j) * 4 + w;
        const float* O0 = (const float*)(p.ws + WS_OGLA) + (size_t)tok * 256 + lane * 4;
        a[j] = *(const float4*)O0; b[j] = *(const float4*)(O0 + (size_t)NTOK * 256);
        g[j] = *(const bf16x4*)((const bf16_t*)(p.ws + WS_PROJ) + (size_t)tok * NIN + C_GGLA + lane * 4);
    }
    const float4 nw = *(const float4*)(p.in[I_GLAN] + l * 64 + (lane & 15) * 4);
#pragma unroll
    for (int j = 0; j < 2; ++j) {
        const int tok = (item * 2 + j) * 4 + w;
        float v[4] = {a[j].x + b[j].x, a[j].y + b[j].y, a[j].z + b[j].z, a[j].w + b[j].w};
        float ss = v[0] * v[0] + v[1] * v[1] + v[2] * v[2] + v[3] * v[3];
        ss += __shfl_xor(ss, 1); ss += __shfl_xor(ss, 2); ss += __shfl_xor(ss, 4); ss += __shfl_xor(ss, 8);
        float r = rsqrtf(ss * (1.f / 64.f) + 1e-6f);
        bf16x4 o;
        o[0] = (short)f2bf(v[0] * r * nw.x * siluf_(bf2f((bf16_t)g[j][0])));
        o[1] = (short)f2bf(v[1] * r * nw.y * siluf_(bf2f((bf16_t)g[j][1])));
        o[2] = (short)f2bf(v[2] * r * nw.z * siluf_(bf2f((bf16_t)g[j][2])));
        o[3] = (short)f2bf(v[3] * r * nw.w * siluf_(bf2f((bf16_t)g[j][3])));
        *(bf16x4*)((bf16_t*)(p.ws + WS_HB) + (size_t)tok * 1024 + 768 + lane * 4) = o;
    }
}

#define XB_TMO      128
#define XB_XCNT(j)  (256  + 64 * (j))
#define XB_XSUB(j)  (1280 + 64 * (j))
#define XB_XGEN(j)  (2304 + 64 * (j))
#define XB_TOP      3328
#define XB_TOPGEN   3392
#define XCD_BAR_WORDS 3456
#define XB_SPIN_CAP (1u << 18)
#define LAS __attribute__((address_space(3)))
DI unsigned xb_ld(unsigned* p)              { return __hip_atomic_load(p, __ATOMIC_RELAXED, __HIP_MEMORY_SCOPE_AGENT); }
DI unsigned xb_add(unsigned* p, unsigned v) { return __hip_atomic_fetch_add(p, v, __ATOMIC_RELAXED, __HIP_MEMORY_SCOPE_AGENT); }
DI unsigned xb_xcc_id() { return (unsigned)__builtin_amdgcn_s_getreg((3 << 11) | 20) & 0xFu; }
#define XB_SPIN(cond, bar) do { unsigned _sp = 0; while (cond) { __builtin_amdgcn_s_sleep(1); \
    if ((++_sp & 255u) == 0u) { if (xb_ld(&(bar)[XB_TMO])) break; if (_sp > XB_SPIN_CAP) { atomicAdd(&(bar)[XB_TMO], 1u); break; } } } } while (0)
struct XcdBarrier { unsigned* bar; unsigned x; volatile LAS unsigned* st; };
DI XcdBarrier xcd_barrier_post(unsigned* bar, volatile LAS unsigned* st) {
    XcdBarrier b; b.bar = bar; b.x = xb_xcc_id(); b.st = st;
    if (threadIdx.x == 0) (void)xb_add(&bar[XB_XCNT(b.x)], 1u);
    return b;
}
DI void xcd_barrier_complete(unsigned* bar, unsigned x, unsigned& nloc, unsigned& nx) {
    const unsigned G = gridDim.x * gridDim.y * gridDim.z;
    unsigned sum, cnt, mine, sp = 0u;
    for (;;) {
        sum = 0u; cnt = 0u; mine = 0u;
#pragma unroll
        for (unsigned j = 0; j < 16; ++j) { const unsigned c = xb_ld(&bar[XB_XCNT(j)]); sum += c; cnt += (c > 0u) ? 1u : 0u; mine = (j == x) ? c : mine; }
        if (sum == G) break;
        __builtin_amdgcn_s_sleep(1);
        if ((++sp & 255u) == 0u) { if (xb_ld(&bar[XB_TMO])) break; if (sp > XB_SPIN_CAP) { atomicAdd(&bar[XB_TMO], 1u); break; } }
    }
    nloc = mine > 0u ? mine : 1u; nx = cnt > 0u ? cnt : 1u;
}
DI void xcd_barrier(const XcdBarrier& b) {
    asm volatile("s_waitcnt vmcnt(0)" ::: "memory");
    __syncthreads();
    if (threadIdx.x == 0) {
        unsigned* bar = b.bar;
        __builtin_amdgcn_s_waitcnt(0);
        unsigned nloc = b.st[0], nx = b.st[1];
        if (nloc == 0u) { xcd_barrier_complete(bar, b.x, nloc, nx); b.st[0] = nloc; b.st[1] = nx; }
        const unsigned old = xb_add(&bar[XB_XSUB(b.x)], 1u);
        const unsigned gen = old / nloc;
        if (old + 1u == (gen + 1u) * nloc) {
            __builtin_amdgcn_fence(__ATOMIC_RELEASE, "agent");
            asm volatile("s_waitcnt vmcnt(0)" ::: "memory");
            const unsigned og = xb_add(&bar[XB_TOP], 1u);
            const unsigned tg = og / nx;
            if (og + 1u == (tg + 1u) * nx) xb_add(&bar[XB_TOPGEN], 1u);
            else XB_SPIN(xb_ld(&bar[XB_TOPGEN]) == tg, bar);
            __builtin_amdgcn_fence(__ATOMIC_ACQUIRE, "agent");
            xb_add(&bar[XB_XGEN(b.x)], 1u);
            asm volatile("s_waitcnt vmcnt(0)" ::: "memory");
        } else {
            XB_SPIN(xb_ld(&bar[XB_XGEN(b.x)]) == gen, bar);
            __builtin_amdgcn_fence(__ATOMIC_ACQUIRE, "agent");
            asm volatile("s_waitcnt vmcnt(0)" ::: "memory");
        }
    }
    __syncthreads();
}

constexpr int SMEM_BYTES = 59392;
#ifndef NPHASE_LAUNCH
#define NPHASE_LAUNCH 0
#endif

DI int next_item(unsigned* ctr, int* slot) {
    __syncthreads();
    if (threadIdx.x == 0) *slot = (int)atomicAdd(ctr, 1u);
    __syncthreads();
    return __builtin_amdgcn_readfirstlane(*slot);
}

__global__ void __launch_bounds__(256, 2) mega(P pk, int ph_lo, int ph_hi) {
    __shared__ __attribute__((aligned(16))) unsigned char smem[SMEM_BYTES];
    __shared__ P p;
    __shared__ int s_next;
    if (threadIdx.x < 42) p.in[threadIdx.x] = pk.in[threadIdx.x];
    if (threadIdx.x == 42) p.out = pk.out;
    if (threadIdx.x == 43) p.ws = pk.ws;
    __syncthreads();
    cg::grid_group grid = cg::this_grid();
    __shared__ uint4 xb_words;
    if (threadIdx.x == 0) xb_words = make_uint4(0u, 0u, 0u, 0u);
    __syncthreads();
    XcdBarrier xbar = xcd_barrier_post((unsigned*)(pk.ws + WS_CTR), (volatile LAS unsigned*)&xb_words);
    if (ph_lo < 0) grid.sync();
    int ph = 0;
#define PHASE_BEGIN if (ph >= ph_lo && ph < ph_hi) {
#define PHASE_END   if (ph + 1 < ph_hi) xcd_barrier(xbar); } ++ph;
#define FOR_ITEMS(N) for (int it = blockIdx.x; it < (N); it += gridDim.x)

    PHASE_BEGIN
    FOR_ITEMS(2756 + 64) {
        if (it >= 2756) s5prep_item(p, it - 2756);
        else if (it < 96) ada_item(p, it / 48, it % 48, smem);
        else if (it < 96 + 576) { int j = it - 96; int l = j / 288, r = j % 288; int ls = r < 256 ? 1 : 0; hyfilt_item(p, l, ls, ls ? r : r - 256, smem); }
        else {
            int j = it - 672; int l = j / 1042, r = j % 1042;
            if (r < 736) tr_item(p.in[I_WIN] + (size_t)l * 1024 * 2944, 1024, 2944, (bf16_t*)(p.ws + WS_WTIN) + (size_t)l * 2944 * 1024, r / 46, r % 46, smem);
            else if (r < 992) { r -= 736; tr_item(p.in[I_WOUT] + (size_t)l * 1024 * 1024, 1024, 1024, (bf16_t*)(p.ws + WS_WTOUT) + (size_t)l * 1024 * 1024, r / 16, r % 16, smem); }
            else if (r < 1010) { r -= 992; tr_item(p.in[I_WUQ] + (size_t)l * 192 * 384, 192, 384, (bf16_t*)(p.ws + WS_WTUQ) + (size_t)l * 384 * 192, r / 6, r % 6, smem); }
            else if (r < 1026) { r -= 1010; tr_item(p.in[I_WUKV] + (size_t)l * 128 * 512, 128, 512, (bf16_t*)(p.ws + WS_WTUKV) + (size_t)l * 512 * 128, r / 8, r % 8, smem); }
            else { r -= 1026; tr_item(p.in[I_GLUW] + (size_t)l * 256 * 256, 256, 256, (bf16_t*)(p.ws + WS_WTGLU) + (size_t)l * 256 * 256, r / 4, r % 4, smem); }
        }
    }
    PHASE_END

    for (int l = 0; l < 2; ++l) {
        PHASE_BEGIN
        FOR_ITEMS(512 + (l == 0 ? 32 : 0)) {
            if (it < 512) normmod_item(p, l, it);
            else { int j = it - 512; hynorm_item(p, j >> 4, (j >> 3) & 1, j & 7, smem); }
        }
        PHASE_END
        PHASE_BEGIN
        {
            EpiProj ep{(bf16_t*)(p.ws + WS_PROJ), (bf16_t*)(p.ws + WS_ZT)};
            const bf16_t* A = (const bf16_t*)(p.ws + WS_HB);
            const bf16_t* Bt = (const bf16_t*)(p.ws + WS_WTIN) + (size_t)l * 2944 * 1024;
            FOR_ITEMS(96 * 23 + (l == 0 ? 1152 : 0)) {
                if (it < 96 * 23) { const int xq = it >> 3, xx = it & 7; gemm_tile(A, 1024, Bt, 1024, 1024, (8 * (xq / 23) + xx) * 128, (xq % 23) * 128, smem, ep); }
                else rt_item(p, it - 96 * 23, smem);
            }
        }
        PHASE_END
        PHASE_BEGIN
        FOR_ITEMS(128 + 256 + 512 + 416 + 256) {
            if (it < 128) { int j = it; gla_item(p, l, 32 + (j >> 3), (j >> 1) & 3, j & 1, 0, smem); }
            else if (it < 384 || it >= 1312) hy2_item(p, l, 0, it < 384 ? it - 128 : 256 + it - 1312, smem);
            else if (it < 896) { int j = it - 384; s5_item(p, l, 32 + (j >> 5), (j >> 1) & 15, j & 1, 0, smem); }
            else mlaprep_item(p, l, it - 896, smem);
        }
        PHASE_END
        PHASE_BEGIN
        FOR_ITEMS(384 + 128 + 768 + 256 + 256 + 256) {
            if (it < 384) { int j = it; gla_item(p, l, 47 - (j >> 3), (j >> 1) & 3, j & 1, 1, smem); }
            else if (it < 512 || (it >= 1536 && it < 1792)) attn_item(p, l, it < 512 ? it - 384 : 128 + it - 1536, smem);
            else if (it < 1280) { int j = it - 512; int sc = 47 - (j >> 4), g = j & 15; for (int dir = 0; dir < 2; ++dir) s5_item(p, l, sc, g, dir, 1, smem); }
            else hy2_item(p, l, 1, it < 1536 ? it - 1280 : 256 + it - 1792, smem);
        }
        PHASE_END
        PHASE_BEGIN
        {
            EpiGlu eg{&p, l};
            const bf16_t* A = (const bf16_t*)(p.ws + WS_GS5);
            const bf16_t* Bt = (const bf16_t*)(p.ws + WS_WTGLU) + (size_t)l * 256 * 256;
            FOR_ITEMS(192 + 512 + 768) {
                if (it < 192) gemm_tile(A, 256, Bt, 256, 256, (it >> 1) * 128, (it & 1) * 128, smem, eg);
                else if (it < 704) { for (int k = 0; k < 3; ++k) glafin_item(p, l, (it - 192) * 3 + k); }
                else hyfin_item(p, it - 704, smem);
            }
        }
        PHASE_END
        PHASE_BEGIN
        {
            EpiOut eo{&p, l};
            const bf16_t* A = (const bf16_t*)(p.ws + WS_HB);
            const bf16_t* Bt = (const bf16_t*)(p.ws + WS_WTOUT) + (size_t)l * 1024 * 1024;
            FOR_ITEMS(96 * 8) { const int xq = it >> 3, xx = it & 7; gemm_tile(A, 1024, Bt, 1024, 1024, (8 * (xq >> 3) + xx) * 128, (xq & 7) * 128, smem, eo); }
        }
        PHASE_END
    }
}

extern "C" void kernel_launch(void* const* d_in, const int* in_sizes, int n_in, void* d_out, int out_size, void* d_ws, size_t ws_size,
                              hipStream_t stream) {
    static int grid_blocks = 0;
    if (!grid_blocks) {
        int dev = 0, cus = 0, per_cu = 0;
        hipGetDevice(&dev);
        hipDeviceGetAttribute(&cus, hipDeviceAttributeMultiprocessorCount, dev);
        hipOccupancyMaxActiveBlocksPerMultiprocessor(&per_cu, mega, 256, 0);
        if (per_cu > 2) per_cu = 2;
        if (per_cu < 1) per_cu = 1;
        grid_blocks = cus * per_cu;
        if (ws_size < WS_END) fprintf(stderr, "workspace too small: %zu < %zu\n", ws_size, (size_t)WS_END);
    }
    hipMemsetAsync((unsigned char*)d_ws + WS_CTR, 0, XCD_BAR_WORDS * 4, stream);
    P p{};
    for (int i = 0; i < 42; ++i) p.in[i] = (const float*)d_in[i];
    p.out = (float*)d_out; p.ws = (unsigned char*)d_ws;
#if NPHASE_LAUNCH
    for (int ph = 0; ph < 13; ++ph) {
        int lo = ph, hi = ph + 1;
        hipLaunchKernelGGL(mega, dim3(grid_blocks), dim3(256), 0, stream, p, lo, hi);
    }
#else
    int lo = 0, hi = 13;
    void* args[] = {&p, &lo, &hi};
    hipError_t e = hipLaunchCooperativeKernel((void*)mega, dim3(grid_blocks), dim3(256), args, 0, stream);
    if (e != hipSuccess) fprintf(stderr, "cooperative launch failed: %s (grid %d)\n", hipGetErrorString(e), grid_blocks);
#endif
}
```

```cpp
#include <hip/hip_runtime.h>
#include <hip/hip_bf16.h>
#include <hip/hip_cooperative_groups.h>
#include <cstdio>
namespace cg = cooperative_groups;

typedef unsigned short bf16_t;
using bf16x8 = __attribute__((ext_vector_type(8))) short;
using bf16x4 = __attribute__((ext_vector_type(4))) short;
using f32x4 = __attribute__((ext_vector_type(4))) float;
using u32x4 = __attribute__((ext_vector_type(4))) unsigned;
using f32x2 = __attribute__((ext_vector_type(2))) float;
#define DI __device__ __forceinline__

constexpr int NTOK = 12288, NCTX = 8192, DM = 1024, NIN = 2944, NKT = 13312;
constexpr int C_CQ = 0, C_CKV = 192, C_KR = 320, C_GMLA = 352, C_HY = 608, C_GHY = 1376, C_S5 = 1632, C_GS5 = 1888,
              C_GQ = 2144, C_GK = 2272, C_GV = 2400, C_GG = 2656, C_GGLA = 2688;
constexpr size_t OFF_CKV = 12582912, OFF_KR = 14680064, OFF_S5 = 15204352, OFF_GLA = 15466496;

constexpr size_t al256(size_t x) { return (x + 255) & ~(size_t)255; }
constexpr size_t WS_MOD = 0;
constexpr size_t WS_WTIN = al256(WS_MOD + 2 * 3 * 3072 * 4);
constexpr size_t WS_WTOUT = al256(WS_WTIN + (size_t)2 * 2944 * 1024 * 2);
constexpr size_t WS_WTUQ = al256(WS_WTOUT + (size_t)2 * 1024 * 1024 * 2);
constexpr size_t WS_WTUKV = al256(WS_WTUQ + (size_t)2 * 384 * 192 * 2);
constexpr size_t WS_WTGLU = al256(WS_WTUKV + (size_t)2 * 512 * 128 * 2);
constexpr size_t WS_HF = al256(WS_WTGLU + (size_t)2 * 256 * 256 * 2);
constexpr size_t HF_LAYER = (size_t)(256 + 2048) * 1024;
constexpr size_t WS_HNORM = al256(WS_HF + 2 * HF_LAYER * 4);
constexpr size_t WS_HB = al256(WS_HNORM + 2 * 2 * 512 * 4);
constexpr size_t WS_PROJ = al256(WS_HB + (size_t)NTOK * 1024 * 2);
constexpr size_t WS_QB = al256(WS_PROJ + (size_t)NTOK * NIN * 2);
constexpr size_t WS_KB = al256(WS_QB + (size_t)4 * NTOK * 96 * 2);
constexpr size_t WS_VT = al256(WS_KB + (size_t)4 * NKT * 96 * 2);
constexpr size_t WS_ZT = al256(WS_VT + (size_t)4 * NKT * 64 * 2);
constexpr size_t WS_Y1T = al256(WS_ZT + (size_t)768 * NTOK * 2);
constexpr size_t WS_OUTT = al256(WS_Y1T + (size_t)256 * NTOK * 2);
constexpr size_t WS_RTL = al256(WS_OUTT + (size_t)256 * NTOK * 2);
constexpr size_t WS_RTC = al256(WS_RTL + (size_t)2 * 2 * 256 * 4096 * 2);
constexpr size_t WS_CTR = al256(WS_RTC + (size_t)2 * 2 * 256 * 512 * 2);
constexpr size_t WS_HPART = al256(WS_CTR + 16384);
constexpr size_t WS_YS5 = al256(WS_HPART + (size_t)2 * 288 * 1024 * 4);
constexpr size_t WS_GS5 = al256(WS_YS5 + (size_t)NTOK * 256 * 4);
constexpr size_t WS_OGLA = al256(WS_GS5 + (size_t)NTOK * 256 * 2);
constexpr size_t WS_S5LOC = al256(WS_OGLA + (size_t)2 * NTOK * 256 * 4);
constexpr size_t WS_GLALOC = al256(WS_S5LOC + (size_t)2 * 8 * 16 * 2 * 128 * 4);
constexpr size_t WS_S5T = al256(WS_GLALOC + (size_t)2 * 8 * 4 * 2 * 2080 * 4);
constexpr size_t S5T_STRIDE = 9216;
constexpr size_t WS_END = al256(WS_S5T + 64 * S5T_STRIDE);
static_assert(WS_END <= ((size_t)256 << 20), "workspace");

struct P { const float* in[42]; float* out; unsigned char* ws; };

enum { I_XP = 0, I_XS, I_C, I_CCKV, I_CKR, I_SS5, I_SGLA, I_CCTX, I_NORMW, I_ADAW, I_ADAB, I_WIN, I_WOUT, I_QAN, I_KVAN, I_WUQ, I_WUKV,
       I_QN, I_KN, I_HCW, I_HCB, I_HW1, I_HB1, I_HF1, I_HW2, I_HB2, I_HF2, I_HW3, I_HBIAS, I_AR, I_AI, I_LDT, I_BR, I_BI, I_CR, I_CI,
       I_S5D, I_GLUW, I_GLUB, I_GGW, I_GGB, I_GLAN };

DI bf16_t f2bf(float x) { __bf16 b = (__bf16)x; return __builtin_bit_cast(bf16_t, b); }
DI float bf2f(bf16_t h) { return __uint_as_float(((unsigned)h) << 16); }
DI float sigmoidf_(float x) { return 1.f / (1.f + __expf(-x)); }
DI float siluf_(float x) { return x / (1.f + __expf(-x)); }
DI float gelu_tanh(float x) { float u = 0.7978845608028654f * (x + 0.044715f * x * x * x); return 0.5f * x * (1.f + tanhf(u)); }
DI int cond_of(int tok) { return tok < NCTX ? 0 : 1 + ((tok - NCTX) >> 11); }
DI const float* xrow(const P& p, int l, int tok) {
    if (l == 0) return tok < NCTX ? p.in[I_XP] + (size_t)tok * DM : p.in[I_XS] + (size_t)(tok - NCTX) * DM;
    return p.out + (size_t)tok * DM;
}
DI int get_tid() { int t = threadIdx.x; asm volatile("" : "+v"(t)); return t; }
DI bf16x8 pack8_hw(float a0, float a1, float a2, float a3, float a4, float a5, float a6, float a7) {
    typedef __bf16 bfv8 __attribute__((ext_vector_type(8)));
    typedef float fv8 __attribute__((ext_vector_type(8)));
    fv8 v = {a0, a1, a2, a3, a4, a5, a6, a7};
    return __builtin_bit_cast(bf16x8, __builtin_convertvector(v, bfv8));
}
#define MFMA16(a, b, c) __builtin_amdgcn_mfma_f32_16x16x32_bf16((a), (b), (c), 0, 0, 0)

DI void tr_item(const float* __restrict__ src, int K, int N, bf16_t* __restrict__ dst, int kt, int nt, unsigned char* smem) {
    float* tile = (float*)smem;
    const int tid = get_tid(), k0 = kt * 64, n0 = nt * 64;
#pragma unroll
    for (int i = 0; i < 16; ++i) { int e = tid + 256 * i; int kk = e >> 6, nn = e & 63; tile[kk * 65 + nn] = src[(size_t)(k0 + kk) * N + n0 + nn]; }
    __syncthreads();
#pragma unroll
    for (int i = 0; i < 16; ++i) { int e = tid + 256 * i; int nn = e >> 6, kk = e & 63; dst[(size_t)(n0 + nn) * K + k0 + kk] = f2bf(tile[kk * 65 + nn]); }
    __syncthreads();
}

DI void ada_item(const P& p, int l, int cc, unsigned char* smem) {
    float* sc = (float*)smem;
    float* red = sc + 3 * 1024;
    const int tid = get_tid();
    for (int e = tid; e < 3 * 1024; e += 256) { int cnd = e >> 10, k = e & 1023; float v = cnd == 0 ? p.in[I_CCTX][k] : p.in[I_C][(cnd - 1) * 1024 + k]; sc[e] = siluf_(v); }
    __syncthreads();
    const int cq = tid & 15, kg = tid >> 4, n0 = cc * 64;
    const float* W = p.in[I_ADAW] + (size_t)l * 1024 * 3072 + n0 + 4 * cq;
    float acc[3][4];
#pragma unroll
    for (int a = 0; a < 3; ++a)
#pragma unroll
        for (int j = 0; j < 4; ++j) acc[a][j] = 0.f;
#pragma unroll 8
    for (int kk = 0; kk < 64; ++kk) {
        int k = kg * 64 + kk;
        float4 w = *(const float4*)(W + (size_t)k * 3072);
#pragma unroll
        for (int a = 0; a < 3; ++a) { float s = sc[a * 1024 + k]; acc[a][0] += s * w.x; acc[a][1] += s * w.y; acc[a][2] += s * w.z; acc[a][3] += s * w.w; }
    }
#pragma unroll
    for (int a = 0; a < 3; ++a)
#pragma unroll
        for (int j = 0; j < 4; ++j) red[(kg * 3 + a) * 64 + 4 * cq + j] = acc[a][j];
    __syncthreads();
    if (tid < 192) {
        int a = tid >> 6, n = tid & 63; float s = 0.f;
#pragma unroll
        for (int g = 0; g < 16; ++g) s += red[(g * 3 + a) * 64 + n];
        float* MOD = (float*)(p.ws + WS_MOD);
        MOD[(l * 3 + a) * 3072 + n0 + n] = s + p.in[I_ADAB][l * 3072 + n0 + n];
    }
    __syncthreads();
}

DI void hyfilt_item(const P& p, int l, int lsel, int tile, unsigned char* smem) {
    float* feat = (float*)smem;
    float* h1 = feat + 8 * 33;
    float* h2 = h1 + 8 * 64;
    const int tid = get_tid();
    const int L = lsel ? 2048 : 256;
    const int lag0 = tile * 8;
    const float Lf = (float)L;
    for (int e = tid; e < 8 * 33; e += 256) {
        int lg = e / 33, f = e % 33; float pos = (float)(lag0 + lg);
        float v;
        if (f == 0) v = pos / Lf;
        else {
            float w = 6.283185307179586f * pos / Lf;
            int bi = (f - 1) & 15; float band = 1e-4f + (float)bi * ((15.0f - 1e-4f) / 15.0f);
            v = (f <= 16) ? cosf(w * band) : sinf(w * band);
        }
        feat[e] = v;
    }
    __syncthreads();
    for (int e = tid; e < 8 * 64; e += 256) {
        int lg = e >> 6, j = e & 63; float s = p.in[I_HB1][l * 64 + j];
        for (int f = 0; f < 33; ++f) s += feat[lg * 33 + f] * p.in[I_HW1][(l * 33 + f) * 64 + j];
        h1[e] = sinf(p.in[I_HF1][l * 64 + j] * s);
    }
    __syncthreads();
    for (int e = tid; e < 8 * 64; e += 256) {
        int lg = e >> 6, j = e & 63; float s = p.in[I_HB2][l * 64 + j];
        for (int k = 0; k < 64; ++k) s += h1[lg * 64 + k] * p.in[I_HW2][(l * 64 + k) * 64 + j];
        h2[e] = sinf(p.in[I_HF2][l * 64 + j] * s);
    }
    __syncthreads();
    float acc[8][4];
#pragma unroll
    for (int a = 0; a < 8; ++a)
#pragma unroll
        for (int j = 0; j < 4; ++j) acc[a][j] = 0.f;
    const float* W3 = p.in[I_HW3] + (size_t)l * 64 * 1024 + 4 * tid;
#pragma unroll 4
    for (int k = 0; k < 64; ++k) {
        float4 w = *(const float4*)(W3 + k * 1024);
#pragma unroll
        for (int a = 0; a < 8; ++a) { float hv = h2[a * 64 + k]; acc[a][0] += hv * w.x; acc[a][1] += hv * w.y; acc[a][2] += hv * w.z; acc[a][3] += hv * w.w; }
    }
    float* HF = (float*)(p.ws + WS_HF) + (size_t)l * HF_LAYER + (lsel ? (size_t)256 * 1024 : 0);
    const float d0 = 15.350567286626973f, d1 = 3.0701134573253946f;
    float4 ps = make_float4(0.f, 0.f, 0.f, 0.f);
#pragma unroll
    for (int a = 0; a < 8; ++a) {
        float t = (float)(lag0 + a) / Lf;
        float4 o;
        float* op = (float*)&o;
#pragma unroll
        for (int j = 0; j < 4; ++j) {
            int ch = (4 * tid + j) & 255;
            float delta = d0 + (float)ch * ((d1 - d0) / 255.0f);
            op[j] = acc[a][j] * (expf(-t * delta) + 0.05f);
        }
        *(float4*)(HF + (size_t)(lag0 + a) * 1024 + 4 * tid) = o;
        const bool cnt = !(lag0 + a == 0 && 4 * tid >= 512);
        if (cnt) { ps.x += fabsf(o.x); ps.y += fabsf(o.y); ps.z += fabsf(o.z); ps.w += fabsf(o.w); }
    }
    *(float4*)((float*)(p.ws + WS_HPART) + ((size_t)l * 288 + (lsel ? 32 : 0) + tile) * 1024 + 4 * tid) = ps;
    __syncthreads();
}

DI void hynorm_item(const P& p, int l, int lsel, int cc, unsigned char* smem) {
    float* red = (float*)smem;
    const int tid = get_tid(), c = tid & 63, lg = tid >> 6;
    const int ntile = lsel ? 256 : 32;
    const float* PT = (const float*)(p.ws + WS_HPART) + ((size_t)l * 288 + (lsel ? 32 : 0)) * 1024;
    const int col = cc * 64 + c;
    float s = 0.f;
#pragma unroll 8
    for (int t = lg; t < ntile; t += 4) s += PT[(size_t)t * 1024 + col] + PT[(size_t)t * 1024 + 512 + col];
    red[lg * 64 + c] = s;
    __syncthreads();
    if (tid < 64) {
        float t = red[tid] + red[64 + tid] + red[128 + tid] + red[192 + tid];
        ((float*)(p.ws + WS_HNORM))[(l * 2 + lsel) * 512 + col] = 1.f / t;
    }
    __syncthreads();
}

DI void normmod_item(const P& p, int l, int item) {
    const int tid_ = get_tid(); const int lane = tid_ & 63, w = tid_ >> 6;
    float4 v[6][4]; float ss[6];
#pragma unroll
    for (int j = 0; j < 6; ++j) {
        const float* x = xrow(p, l, (item * 6 + j) * 4 + w);
        ss[j] = 0.f;
#pragma unroll
        for (int i = 0; i < 4; ++i) v[j][i] = *(const float4*)(x + lane * 4 + 256 * i);
    }
#pragma unroll
    for (int j = 0; j < 6; ++j) {
#pragma unroll
        for (int i = 0; i < 4; ++i) ss[j] += v[j][i].x * v[j][i].x + v[j][i].y * v[j][i].y + v[j][i].z * v[j][i].z + v[j][i].w * v[j][i].w;
#pragma unroll
        for (int o = 1; o < 64; o <<= 1) ss[j] += __shfl_xor(ss[j], o);
    }
#pragma unroll
    for (int j = 0; j < 6; ++j) {
        const int tok = (item * 6 + j) * 4 + w;
        const float r = rsqrtf(ss[j] * (1.f / 1024.f) + 1e-6f);
        const float* MOD = (const float*)(p.ws + WS_MOD) + (l * 3 + cond_of(tok)) * 3072;
        bf16_t* HB = (bf16_t*)(p.ws + WS_HB) + (size_t)tok * 1024;
#pragma unroll
        for (int i = 0; i < 4; ++i) {
            int c = lane * 4 + 256 * i;
            float4 nw = *(const float4*)(p.in[I_NORMW] + l * 1024 + c);
            float4 sh = *(const float4*)(MOD + c), sc = *(const float4*)(MOD + 1024 + c);
            bf16x4 o;
            o[0] = (short)f2bf(v[j][i].x * r * nw.x * (1.f + sc.x) + sh.x);
            o[1] = (short)f2bf(v[j][i].y * r * nw.y * (1.f + sc.y) + sh.y);
            o[2] = (short)f2bf(v[j][i].z * r * nw.z * (1.f + sc.z) + sh.z);
            o[3] = (short)f2bf(v[j][i].w * r * nw.w * (1.f + sc.w) + sh.w);
            *(bf16x4*)(HB + c) = o;
        }
    }
}

template <class Epi>
DI void gemm_tile(const bf16_t* __restrict__ A, int lda, const bf16_t* __restrict__ Bt, int ldb, int K, int m0, int n0,
                          unsigned char* smem, Epi epi) {
    bf16_t* As = (bf16_t*)smem;
    bf16_t* Bs = As + 128 * 72;
    const int tid = get_tid(), lane = tid & 63, w = tid >> 6;
    const int wm = w & 1, wn = w >> 1, lr = lane & 15, quad = lane >> 4;
    f32x4 acc[4][4];
#pragma unroll
    for (int a = 0; a < 4; ++a)
#pragma unroll
        for (int b = 0; b < 4; ++b) acc[a][b] = (f32x4){0.f, 0.f, 0.f, 0.f};
    u32x4 ra[4], rb[4], ra2[4], rb2[4];
    const bf16_t* Ag = A + (size_t)(m0 + (tid >> 3)) * lda + (tid & 7) * 8;
    const bf16_t* Bg = Bt + (size_t)(n0 + (tid >> 3)) * ldb + (tid & 7) * 8;
#pragma unroll
    for (int i = 0; i < 4; ++i) { ra[i] = *(const u32x4*)(Ag + (size_t)(32 * i) * lda); rb[i] = *(const u32x4*)(Bg + (size_t)(32 * i) * ldb); }
#pragma unroll
    for (int i = 0; i < 4; ++i) { ra2[i] = *(const u32x4*)(Ag + (size_t)(32 * i) * lda + 64); rb2[i] = *(const u32x4*)(Bg + (size_t)(32 * i) * ldb + 64); }
#define GEMM_STEP(RA, RB, KNEXT)                                                                                   \
    {                                                                                                                \
        _Pragma("unroll") for (int i = 0; i < 4; ++i) {                                                              \
            *(u32x4*)(As + ((tid >> 3) + 32 * i) * 72 + (tid & 7) * 8) = RA[i];                                      \
            *(u32x4*)(Bs + ((tid >> 3) + 32 * i) * 72 + (tid & 7) * 8) = RB[i];                                      \
        }                                                                                                            \
        __syncthreads();                                                                                             \
        if ((KNEXT) < K) {                                                                                           \
            _Pragma("unroll") for (int i = 0; i < 4; ++i) {                                                          \
                RA[i] = *(const u32x4*)(Ag + (size_t)(32 * i) * lda + (KNEXT));                                      \
                RB[i] = *(const u32x4*)(Bg + (size_t)(32 * i) * ldb + (KNEXT));                                      \
            }                                                                                                        \
        }                                                                                                            \
        _Pragma("unroll") for (int ks = 0; ks < 2; ++ks) {                                                           \
            bf16x8 af[4], bfr[4];                                                                                    \
            _Pragma("unroll") for (int t = 0; t < 4; ++t) {                                                          \
                af[t] = *(const bf16x8*)(As + (wm * 64 + t * 16 + lr) * 72 + ks * 32 + quad * 8);                    \
                bfr[t] = *(const bf16x8*)(Bs + (wn * 64 + t * 16 + lr) * 72 + ks * 32 + quad * 8);                   \
            }                                                                                                        \
            _Pragma("unroll") for (int nt = 0; nt < 4; ++nt)                                                         \
                _Pragma("unroll") for (int mt = 0; mt < 4; ++mt) acc[nt][mt] = MFMA16(bfr[nt], af[mt], acc[nt][mt]); \
        }                                                                                                            \
        __syncthreads();                                                                                             \
    }
    for (int k0 = 0; k0 < K; k0 += 128) {
        GEMM_STEP(ra, rb, k0 + 128)
        GEMM_STEP(ra2, rb2, k0 + 192)
    }
#undef GEMM_STEP
    if constexpr (Epi::kPre) {
        f32x4 xs[4][4], gs[4];
#pragma unroll
        for (int nt = 0; nt < 4; ++nt) {
            gs[nt] = epi.gate(m0, n0 + wn * 64 + nt * 16 + quad * 4);
#pragma unroll
            for (int mt = 0; mt < 4; ++mt) xs[nt][mt] = epi.load(m0 + wm * 64 + mt * 16 + lr, n0 + wn * 64 + nt * 16 + quad * 4);
        }
#pragma unroll
        for (int nt = 0; nt < 4; ++nt)
#pragma unroll
            for (int mt = 0; mt < 4; ++mt) epi.store(m0 + wm * 64 + mt * 16 + lr, n0 + wn * 64 + nt * 16 + quad * 4, acc[nt][mt], xs[nt][mt], gs[nt]);
    } else {
#pragma unroll
        for (int nt = 0; nt < 4; ++nt)
#pragma unroll
            for (int mt = 0; mt < 4; ++mt) epi(m0 + wm * 64 + mt * 16 + lr, n0 + wn * 64 + nt * 16 + quad * 4, acc[nt][mt]);
    }
}

struct EpiProj {
    static constexpr bool kPre = false;
    bf16_t* out; bf16_t* zt;
    DI void operator()(int row, int col, f32x4 v) const {
        bf16x4 o; o[0] = (short)f2bf(v[0]); o[1] = (short)f2bf(v[1]); o[2] = (short)f2bf(v[2]); o[3] = (short)f2bf(v[3]);
        if (col >= C_HY && col < C_HY + 768) {
#pragma unroll
            for (int j = 0; j < 4; ++j) zt[(size_t)(col - C_HY + j) * NTOK + row] = (bf16_t)o[j];
        } else *(bf16x4*)(out + (size_t)row * NIN + col) = o;
    }
};
struct EpiOut {
    static constexpr bool kPre = true;
    const P* p; int l;
    DI f32x4 gate(int m0, int col) const { return *(const f32x4*)((const float*)(p->ws + WS_MOD) + (l * 3 + cond_of(m0)) * 3072 + 2048 + col); }
    DI f32x4 load(int row, int col) const { return *(const f32x4*)(xrow(*p, l, row) + col); }
    DI void store(int row, int col, f32x4 v, f32x4 x, f32x4 g) const { *(f32x4*)(p->out + (size_t)row * DM + col) = x + g * v; }
    DI void operator()(int row, int col, f32x4 v) const { store(row, col, v, load(row, col), gate(row, col)); }
};
struct EpiGlu {
    static constexpr bool kPre = true;
    const P* p; int l;
    DI f32x4 gate(int m0, int col) const { return *(const f32x4*)(p->in[I_GLUB] + l * 256 + col); }
    DI f32x4 load(int row, int col) const {
        const bf16x4 gg = *(const bf16x4*)((const bf16_t*)(p->ws + WS_GS5) + (size_t)row * 256 + col);
        const bf16x4 gs = *(const bf16x4*)((const bf16_t*)(p->ws + WS_PROJ) + (size_t)row * NIN + C_GS5 + col);
        return __builtin_bit_cast(f32x4, __builtin_shufflevector(gg, gs, 0, 1, 2, 3, 4, 5, 6, 7));
    }
    DI void store(int row, int col, f32x4 v, f32x4 x, f32x4 b) const {
        const bf16x8 pk = __builtin_bit_cast(bf16x8, x);
        bf16x4 o;
#pragma unroll
        for (int j = 0; j < 4; ++j) { float g = bf2f((bf16_t)pk[j]); o[j] = (short)f2bf(g * sigmoidf_(v[j] + b[j]) * siluf_(bf2f((bf16_t)pk[4 + j]))); }
        *(bf16x4*)((bf16_t*)(p->ws + WS_HB) + (size_t)row * 1024 + 512 + col) = o;
    }
    DI void operator()(int row, int col, f32x4 v) const { store(row, col, v, load(row, col), gate(row, col)); }
};

DI void mlaprep_item(const P& p, int l, int item, unsigned char* smem) {
    bf16_t* Aq = (bf16_t*)smem;
    bf16_t* Akv = Aq + 32 * 200;
    float* R = (float*)(Akv + 32 * 136);
    float* kr = R + 32 * 132;
    float* kn = kr + 32 * 32;
    float* cst = kn + 32 * 32;
    float* snt = cst + 32 * 16;
    const int tid = get_tid(), lane = tid & 63, w = tid >> 6, lr = lane & 15, quad = lane >> 4;
    const bool is_cache = item >= 384;
    int tok0 = 0, cb = 0, r0 = 0;
    if (!is_cache) tok0 = item * 32; else { cb = (item - 384) >> 4; r0 = ((item - 384) & 15) * 32; }
    const bool is_lat = !is_cache && tok0 >= NCTX;
    const bool do_rope = is_lat;
    int kbase, nkeys, kin0;
    if (is_cache) { kbase = 8192 + 2560 * cb; nkeys = 2560; kin0 = r0; }
    else if (is_lat) { int b = (tok0 - NCTX) >> 11; kbase = 8192 + 2560 * b; nkeys = 2560; kin0 = 512 + ((tok0 - NCTX) & 2047); }
    else { kbase = tok0 & ~255; nkeys = 256; kin0 = tok0 & 255; }
    const bf16_t* PR = (const bf16_t*)(p.ws + WS_PROJ);
    {
        const int t = tid >> 3, part = tid & 7;
        if (!is_cache) {
            const bf16_t* row = PR + (size_t)(tok0 + t) * NIN;
            const int tok = tok0 + t;
            {
                bf16x8 q[3];
#pragma unroll
                for (int c = 0; c < 3; ++c) q[c] = *(const bf16x8*)(row + C_CQ + part * 24 + 8 * c);
                float ss = 0.f;
#pragma unroll
                for (int c = 0; c < 3; ++c)
#pragma unroll
                    for (int j = 0; j < 8; ++j) { float x = bf2f((bf16_t)q[c][j]); ss += x * x; }
                ss += __shfl_xor(ss, 1); ss += __shfl_xor(ss, 2); ss += __shfl_xor(ss, 4);
                const float rq = rsqrtf(ss * (1.f / 192.f) + 1e-6f);
                const float4* wq4 = (const float4*)(p.in[I_QAN] + l * 192 + part * 24);
#pragma unroll
                for (int c = 0; c < 3; ++c) {
                    float4 w0 = wq4[2 * c], w1 = wq4[2 * c + 1];
                    bf16x8 o;
                    o[0] = (short)f2bf(bf2f((bf16_t)q[c][0]) * rq * w0.x); o[1] = (short)f2bf(bf2f((bf16_t)q[c][1]) * rq * w0.y);
                    o[2] = (short)f2bf(bf2f((bf16_t)q[c][2]) * rq * w0.z); o[3] = (short)f2bf(bf2f((bf16_t)q[c][3]) * rq * w0.w);
                    o[4] = (short)f2bf(bf2f((bf16_t)q[c][4]) * rq * w1.x); o[5] = (short)f2bf(bf2f((bf16_t)q[c][5]) * rq * w1.y);
                    o[6] = (short)f2bf(bf2f((bf16_t)q[c][6]) * rq * w1.z); o[7] = (short)f2bf(bf2f((bf16_t)q[c][7]) * rq * w1.w);
                    *(bf16x8*)(Aq + t * 200 + part * 24 + 8 * c) = o;
                }
            }
            {
                bf16x8 k[2];
#pragma unroll
                for (int c = 0; c < 2; ++c) k[c] = *(const bf16x8*)(row + C_CKV + part * 16 + 8 * c);
                float ss = 0.f;
#pragma unroll
                for (int c = 0; c < 2; ++c)
#pragma unroll
                    for (int j = 0; j < 8; ++j) { float x = bf2f((bf16_t)k[c][j]); ss += x * x; }
                ss += __shfl_xor(ss, 1); ss += __shfl_xor(ss, 2); ss += __shfl_xor(ss, 4);
                const float rk = rsqrtf(ss * (1.f / 128.f) + 1e-6f);
                const float4* wk4 = (const float4*)(p.in[I_KVAN] + l * 128 + part * 16);
                float* oc = p.out + OFF_CKV + ((size_t)((tok >> 8) * 2 + l) * 256 + (tok & 255)) * 128 + part * 16;
#pragma unroll
                for (int c = 0; c < 2; ++c) {
                    float4 w0 = wk4[2 * c], w1 = wk4[2 * c + 1];
                    float4 v0, v1;
                    v0.x = bf2f((bf16_t)k[c][0]) * rk * w0.x; v0.y = bf2f((bf16_t)k[c][1]) * rk * w0.y;
                    v0.z = bf2f((bf16_t)k[c][2]) * rk * w0.z; v0.w = bf2f((bf16_t)k[c][3]) * rk * w0.w;
                    v1.x = bf2f((bf16_t)k[c][4]) * rk * w1.x; v1.y = bf2f((bf16_t)k[c][5]) * rk * w1.y;
                    v1.z = bf2f((bf16_t)k[c][6]) * rk * w1.z; v1.w = bf2f((bf16_t)k[c][7]) * rk * w1.w;
                    bf16x8 o;
                    o[0] = (short)f2bf(v0.x); o[1] = (short)f2bf(v0.y); o[2] = (short)f2bf(v0.z); o[3] = (short)f2bf(v0.w);
                    o[4] = (short)f2bf(v1.x); o[5] = (short)f2bf(v1.y); o[6] = (short)f2bf(v1.z); o[7] = (short)f2bf(v1.w);
                    *(bf16x8*)(Akv + t * 136 + part * 16 + 8 * c) = o;
                    if (!is_lat) { *(float4*)(oc + 8 * c) = v0; *(float4*)(oc + 8 * c + 4) = v1; }
                }
            }
            {
                bf16x4 r4 = *(const bf16x4*)(row + C_KR + part * 4);
                float4 v = make_float4(bf2f((bf16_t)r4[0]), bf2f((bf16_t)r4[1]), bf2f((bf16_t)r4[2]), bf2f((bf16_t)r4[3]));
                *(float4*)(kr + t * 32 + part * 4) = v;
                if (!is_lat) *(float4*)(p.out + OFF_KR + ((size_t)((tok >> 8) * 2 + l) * 256 + (tok & 255)) * 32 + part * 4) = v;
            }
        } else {
            const float4* ck = (const float4*)(p.in[I_CCKV] + ((size_t)(cb * 2 + l) * 512 + r0 + t) * 128 + part * 16);
            const float4* ckr = (const float4*)(p.in[I_CKR] + ((size_t)(cb * 2 + l) * 512 + r0 + t) * 32 + part * 4);
#pragma unroll
            for (int c = 0; c < 2; ++c) {
                float4 v0 = ck[2 * c], v1 = ck[2 * c + 1];
                bf16x8 o;
                o[0] = (short)f2bf(v0.x); o[1] = (short)f2bf(v0.y); o[2] = (short)f2bf(v0.z); o[3] = (short)f2bf(v0.w);
                o[4] = (short)f2bf(v1.x); o[5] = (short)f2bf(v1.y); o[6] = (short)f2bf(v1.z); o[7] = (short)f2bf(v1.w);
                *(bf16x8*)(Akv + t * 136 + part * 16 + 8 * c) = o;
            }
            *(float4*)(kr + t * 32 + part * 4) = ckr[0];
        }
        if (do_rope) {
            for (int e = tid; e < 32 * 16; e += 256) {
                int tt = e >> 4, a = e & 15; int pos = (tok0 - NCTX + tt) & 2047;
                float pp = (a < 8) ? (float)(pos >> 6) : (float)(pos & 63);
                float inv = powf(10000.f, -(float)(a & 7) * 0.125f);
                float ang = pp * inv;
                cst[e] = cosf(ang); snt[e] = sinf(ang);
            }
        }
    }
    __syncthreads();
    const int mt = w & 1, nh = w >> 1;
    const float qscale = 0.10206207261596577f * 1.4426950408889634f;
    for (int h = 0; h < 4; ++h) {
        if (!is_cache) {
            f32x4 acc[3];
#pragma unroll
            for (int i = 0; i < 3; ++i) acc[i] = (f32x4){0.f, 0.f, 0.f, 0.f};
            const bf16_t* W = (const bf16_t*)(p.ws + WS_WTUQ) + (size_t)l * 384 * 192 + (size_t)(96 * h + 48 * nh + lr) * 192 + quad * 8;
#pragma unroll
            for (int ks = 0; ks < 6; ++ks) {
                bf16x8 xf = *(const bf16x8*)(Aq + (16 * mt + lr) * 200 + 32 * ks + quad * 8);
#pragma unroll
                for (int i = 0; i < 3; ++i) { bf16x8 wf = *(const bf16x8*)(W + (size_t)(16 * i) * 192 + 32 * ks); acc[i] = MFMA16(wf, xf, acc[i]); }
            }
#pragma unroll
            for (int i = 0; i < 3; ++i) *(f32x4*)(R + (16 * mt + lr) * 132 + 48 * nh + 16 * i + quad * 4) = acc[i];
            __syncthreads();
            {
                const int t = tid >> 3, part = tid & 7;
                float4* rp = (float4*)(R + t * 132 + part * 12);
                float4 x0 = rp[0], x1 = rp[1], x2 = rp[2];
                float ss = x0.x * x0.x + x0.y * x0.y + x0.z * x0.z + x0.w * x0.w + x1.x * x1.x + x1.y * x1.y + x1.z * x1.z + x1.w * x1.w
                         + x2.x * x2.x + x2.y * x2.y + x2.z * x2.z + x2.w * x2.w;
                ss += __shfl_xor(ss, 1); ss += __shfl_xor(ss, 2); ss += __shfl_xor(ss, 4);
                float r = rsqrtf(ss * (1.f / 96.f) + 1e-6f);
                const float4* wn = (const float4*)(p.in[I_QN] + l * 96 + part * 12);
                float4 w0 = wn[0], w1 = wn[1], w2 = wn[2];
                rp[0] = make_float4(x0.x * r * w0.x, x0.y * r * w0.y, x0.z * r * w0.z, x0.w * r * w0.w);
                rp[1] = make_float4(x1.x * r * w1.x, x1.y * r * w1.y, x1.z * r * w1.z, x1.w * r * w1.w);
                rp[2] = make_float4(x2.x * r * w2.x, x2.y * r * w2.y, x2.z * r * w2.z, x2.w * r * w2.w);
            }
            __syncthreads();
            {
                const int t = tid >> 3, part = tid & 7;
                bf16_t* Qo = (bf16_t*)(p.ws + WS_QB) + ((size_t)h * NTOK + tok0 + t) * 96;
                bf16_t qv[12];
#pragma unroll
                for (int j = 0; j < 12; ++j) {
                    int n = part * 12 + j; float v;
                    if (n < 64 || !do_rope) v = R[t * 132 + n];
                    else {
                        int i = (n - 64) & 7, half = ((n - 64) >> 3) & 1, ax = (n - 64) >> 4;
                        float x1 = R[t * 132 + 64 + 16 * ax + i], x2 = R[t * 132 + 64 + 16 * ax + 8 + i];
                        float c = cst[t * 16 + ax * 8 + i], s = snt[t * 16 + ax * 8 + i];
                        v = half == 0 ? x1 * c - x2 * s : x2 * c + x1 * s;
                    }
                    qv[j] = f2bf(v * qscale);
                }
#pragma unroll
                for (int c = 0; c < 3; ++c) { bf16x4 o; o[0] = (short)qv[4 * c]; o[1] = (short)qv[4 * c + 1]; o[2] = (short)qv[4 * c + 2]; o[3] = (short)qv[4 * c + 3]; *(bf16x4*)(Qo + part * 12 + 4 * c) = o; }
            }
            __syncthreads();
        }
        {
            f32x4 acc[4];
#pragma unroll
            for (int i = 0; i < 4; ++i) acc[i] = (f32x4){0.f, 0.f, 0.f, 0.f};
            const bf16_t* W = (const bf16_t*)(p.ws + WS_WTUKV) + (size_t)l * 512 * 128 + (size_t)(128 * h + 64 * nh + lr) * 128 + quad * 8;
#pragma unroll
            for (int ks = 0; ks < 4; ++ks) {
                bf16x8 xf = *(const bf16x8*)(Akv + (16 * mt + lr) * 136 + 32 * ks + quad * 8);
#pragma unroll
                for (int i = 0; i < 4; ++i) { bf16x8 wf = *(const bf16x8*)(W + (size_t)(16 * i) * 128 + 32 * ks); acc[i] = MFMA16(wf, xf, acc[i]); }
            }
#pragma unroll
            for (int i = 0; i < 4; ++i) *(f32x4*)(R + (16 * mt + lr) * 132 + 64 * nh + 16 * i + quad * 4) = acc[i];
        }
        __syncthreads();
        {
            const int t = tid >> 3, part = tid & 7;
            float4* rp = (float4*)(R + t * 132 + part * 8);
            float4 x0 = rp[0], x1 = rp[1], x2 = *(const float4*)(kr + t * 32 + part * 4);
            float ss = x0.x * x0.x + x0.y * x0.y + x0.z * x0.z + x0.w * x0.w + x1.x * x1.x + x1.y * x1.y + x1.z * x1.z + x1.w * x1.w
                     + x2.x * x2.x + x2.y * x2.y + x2.z * x2.z + x2.w * x2.w;
            ss += __shfl_xor(ss, 1); ss += __shfl_xor(ss, 2); ss += __shfl_xor(ss, 4);
            float r = rsqrtf(ss * (1.f / 96.f) + 1e-6f);
            const float4* wn = (const float4*)(p.in[I_KN] + l * 96 + part * 8);
            float4 w0 = wn[0], w1 = wn[1], w2 = *(const float4*)(p.in[I_KN] + l * 96 + 64 + part * 4);
            rp[0] = make_float4(x0.x * r * w0.x, x0.y * r * w0.y, x0.z * r * w0.z, x0.w * r * w0.w);
            rp[1] = make_float4(x1.x * r * w1.x, x1.y * r * w1.y, x1.z * r * w1.z, x1.w * r * w1.w);
            *(float4*)(kn + t * 32 + part * 4) = make_float4(x2.x * r * w2.x, x2.y * r * w2.y, x2.z * r * w2.z, x2.w * r * w2.w);
        }
        __syncthreads();
        {
            const int t = tid >> 3, part = tid & 7;
            bf16_t* Ko = (bf16_t*)(p.ws + WS_KB) + ((size_t)h * NKT + kbase + kin0 + t) * 96;
            bf16_t kv[12];
#pragma unroll
            for (int j = 0; j < 12; ++j) {
                int n = part * 12 + j; float v;
                if (n < 64) v = R[t * 132 + n];
                else if (!do_rope) v = kn[t * 32 + n - 64];
                else {
                    int i = (n - 64) & 7, half = ((n - 64) >> 3) & 1, ax = (n - 64) >> 4;
                    float x1 = kn[t * 32 + 16 * ax + i], x2 = kn[t * 32 + 16 * ax + 8 + i];
                    float c = cst[t * 16 + ax * 8 + i], s = snt[t * 16 + ax * 8 + i];
                    v = half == 0 ? x1 * c - x2 * s : x2 * c + x1 * s;
                }
                kv[j] = f2bf(v);
            }
#pragma unroll
            for (int c = 0; c < 3; ++c) { bf16x4 o; o[0] = (short)kv[4 * c]; o[1] = (short)kv[4 * c + 1]; o[2] = (short)kv[4 * c + 2]; o[3] = (short)kv[4 * c + 3]; *(bf16x4*)(Ko + part * 12 + 4 * c) = o; }
            const int dv = tid & 63, tg = tid >> 6;
            bf16x8 o;
#pragma unroll
            for (int j = 0; j < 8; ++j) o[j] = (short)f2bf(R[(tg * 8 + j) * 132 + 64 + dv]);
            bf16_t* Vo = (bf16_t*)(p.ws + WS_VT) + ((size_t)h * NKT + kbase) * 64 + (size_t)dv * nkeys + kin0 + tg * 8;
            *(bf16x8*)Vo = o;
        }
        __syncthreads();
    }
}

DI void attn_item(const P& p, int l, int item, unsigned char* smem) {
    bf16_t* Ks = (bf16_t*)smem;
    bf16_t* Vs = Ks + 64 * 104;
    const int tid = get_tid(), lane = tid & 63, w = tid >> 6, lr = lane & 15, quad = lane >> 4;
    int seq, h, qb;
    if (item < 128) { seq = 32 + (item >> 6); h = (item >> 4) & 3; qb = item & 15; }
    else { int j = item - 128; seq = j >> 3; h = (j >> 1) & 3; qb = j & 1; }
    int tokbase, nkeys, kbase;
    if (seq < 32) { tokbase = 256 * seq; nkeys = 256; kbase = 256 * seq; }
    else { tokbase = NCTX + 2048 * (seq - 32); nkeys = 2560; kbase = 8192 + 2560 * (seq - 32); }
    const bf16_t* Qp = (const bf16_t*)(p.ws + WS_QB) + ((size_t)h * NTOK + tokbase + qb * 128 + 32 * w) * 96;
    const bf16_t* Kp = (const bf16_t*)(p.ws + WS_KB) + ((size_t)h * NKT + kbase) * 96;
    const bf16_t* Vp = (const bf16_t*)(p.ws + WS_VT) + ((size_t)h * NKT + kbase) * 64;
    bf16x8 qf[2][3];
#pragma unroll
    for (int nt = 0; nt < 2; ++nt)
#pragma unroll
        for (int ks = 0; ks < 3; ++ks) qf[nt][ks] = *(const bf16x8*)(Qp + (16 * nt + lr) * 96 + 32 * ks + 8 * quad);
    f32x4 o[4][2];
#pragma unroll
    for (int a = 0; a < 4; ++a)
#pragma unroll
        for (int b = 0; b < 2; ++b) o[a][b] = (f32x4){0.f, 0.f, 0.f, 0.f};
    float mrow[2] = {-1e30f, -1e30f}, lsum[2] = {0.f, 0.f};
    u32x4 rk[3], rv[2];
    const int ntile = nkeys >> 6;
#pragma unroll
    for (int i = 0; i < 3; ++i) { int c = tid + 256 * i; rk[i] = *(const u32x4*)(Kp + (size_t)(c / 12) * 96 + (c % 12) * 8); }
#pragma unroll
    for (int i = 0; i < 2; ++i) { int c = tid + 256 * i; rv[i] = *(const u32x4*)(Vp + (size_t)(c >> 3) * nkeys + (c & 7) * 8); }
    for (int kt = 0; kt < ntile; ++kt) {
#pragma unroll
        for (int i = 0; i < 3; ++i) { int c = tid + 256 * i; *(u32x4*)(Ks + (c / 12) * 104 + (c % 12) * 8) = rk[i]; }
#pragma unroll
        for (int i = 0; i < 2; ++i) { int c = tid + 256 * i; *(u32x4*)(Vs + (c >> 3) * 72 + (c & 7) * 8) = rv[i]; }
        __syncthreads();
        if (kt + 1 < ntile) {
#pragma unroll
            for (int i = 0; i < 3; ++i) { int c = tid + 256 * i; rk[i] = *(const u32x4*)(Kp + (size_t)((kt + 1) * 64 + c / 12) * 96 + (c % 12) * 8); }
#pragma unroll
            for (int i = 0; i < 2; ++i) { int c = tid + 256 * i; rv[i] = *(const u32x4*)(Vp + (size_t)(c >> 3) * nkeys + (kt + 1) * 64 + (c & 7) * 8); }
        }
        f32x4 s[4][2];
#pragma unroll
        for (int a = 0; a < 4; ++a)
#pragma unroll
            for (int b = 0; b < 2; ++b) s[a][b] = (f32x4){0.f, 0.f, 0.f, 0.f};
#pragma unroll
        for (int ks = 0; ks < 3; ++ks)
#pragma unroll
            for (int mt = 0; mt < 4; ++mt) {
                bf16x8 kf = *(const bf16x8*)(Ks + (16 * mt + lr) * 104 + 32 * ks + 8 * quad);
#pragma unroll
                for (int nt = 0; nt < 2; ++nt) s[mt][nt] = MFMA16(kf, qf[nt][ks], s[mt][nt]);
            }
        bf16x8 pf[2][2];
#pragma unroll
        for (int nt = 0; nt < 2; ++nt) {
            float mx = -1e30f;
#pragma unroll
            for (int mt = 0; mt < 4; ++mt)
#pragma unroll
                for (int j = 0; j < 4; ++j) mx = fmaxf(mx, s[mt][nt][j]);
            mx = fmaxf(mx, __shfl_xor(mx, 16)); mx = fmaxf(mx, __shfl_xor(mx, 32));
            float mnew = fmaxf(mrow[nt], mx);
            float alpha = __builtin_amdgcn_exp2f(mrow[nt] - mnew);
            mrow[nt] = mnew;
            float rs = 0.f;
#pragma unroll
            for (int mt = 0; mt < 4; ++mt)
#pragma unroll
                for (int j = 0; j < 4; ++j) { float pv = __builtin_amdgcn_exp2f(s[mt][nt][j] - mnew); s[mt][nt][j] = pv; rs += pv; }
            lsum[nt] = lsum[nt] * alpha + rs;
#pragma unroll
            for (int dt = 0; dt < 4; ++dt) { o[dt][nt][0] *= alpha; o[dt][nt][1] *= alpha; o[dt][nt][2] *= alpha; o[dt][nt][3] *= alpha; }
#pragma unroll
            for (int kk = 0; kk < 2; ++kk)
                pf[kk][nt] = pack8_hw(s[2 * kk][nt][0], s[2 * kk][nt][1], s[2 * kk][nt][2], s[2 * kk][nt][3],
                                      s[2 * kk + 1][nt][0], s[2 * kk + 1][nt][1], s[2 * kk + 1][nt][2], s[2 * kk + 1][nt][3]);
        }
#pragma unroll
        for (int kk = 0; kk < 2; ++kk)
#pragma unroll
            for (int dt = 0; dt < 4; ++dt) {
                bf16x4 lo = *(const bf16x4*)(Vs + (16 * dt + lr) * 72 + 32 * kk + 4 * quad);
                bf16x4 hi = *(const bf16x4*)(Vs + (16 * dt + lr) * 72 + 32 * kk + 16 + 4 * quad);
                bf16x8 vf = __builtin_shufflevector(lo, hi, 0, 1, 2, 3, 4, 5, 6, 7);
#pragma unroll
                for (int nt = 0; nt < 2; ++nt) o[dt][nt] = MFMA16(vf, pf[kk][nt], o[dt][nt]);
            }
        __syncthreads();
    }
    const bf16_t* PR = (const bf16_t*)(p.ws + WS_PROJ);
    bf16_t* HB = (bf16_t*)(p.ws + WS_HB);
    bf16x4 gpre[2][4];
#pragma unroll
    for (int nt = 0; nt < 2; ++nt)
#pragma unroll
        for (int dt = 0; dt < 4; ++dt)
            gpre[nt][dt] = *(const bf16x4*)(PR + (size_t)(tokbase + qb * 128 + 32 * w + 16 * nt + lr) * NIN + C_GMLA + h * 64 + 16 * dt + 4 * quad);
#pragma unroll
    for (int nt = 0; nt < 2; ++nt) {
        float lt = lsum[nt]; lt += __shfl_xor(lt, 16); lt += __shfl_xor(lt, 32);
        float inv = 1.f / lt;
        int tok = tokbase + qb * 128 + 32 * w + 16 * nt + lr;
#pragma unroll
        for (int dt = 0; dt < 4; ++dt) {
            int col = h * 64 + 16 * dt + 4 * quad;
            bf16x4 g = gpre[nt][dt];
            bf16x4 ov;
#pragma unroll
            for (int j = 0; j < 4; ++j) ov[j] = (short)f2bf(o[dt][nt][j] * inv * siluf_(bf2f((bf16_t)g[j])));
            *(bf16x4*)(HB + (size_t)tok * 1024 + col) = ov;
        }
    }
}

DI void rt_item(const P& p, int item, unsigned char* smem) {
    float* tile = (float*)smem;
    const int tid = get_tid();
    int l = item / 576, r = item % 576;
    int order = r / 288; r %= 288;
    int cht = r / 72, xt = r % 72;
    const int lsel = xt >= 8 ? 1 : 0; if (lsel) xt -= 8;
    const int L = lsel ? 2048 : 256, x0 = xt * 64, ch0 = cht * 64;
    const float* HF = (const float*)(p.ws + WS_HF) + (size_t)l * HF_LAYER + (lsel ? (size_t)256 * 1024 : 0) + order * 256 + ch0;
    const float* HN = (const float*)(p.ws + WS_HNORM) + (l * 2 + lsel) * 512 + order * 256 + ch0;
#pragma unroll
    for (int i = 0; i < 16; ++i) {
        int e = tid + 256 * i; int xx = e >> 6, cc = e & 63;
        int d = L - 1 - (x0 + xx);
        float v = 0.f;
        if (d >= 0) v = HF[(size_t)d * 1024 + cc]; else if (d > -L) v = HF[(size_t)(-d) * 1024 + 512 + cc];
        tile[xx * 65 + cc] = v * HN[cc];
    }
    __syncthreads();
    bf16_t* RT = lsel ? (bf16_t*)(p.ws + WS_RTL) + ((size_t)(l * 2 + order) * 256 + ch0) * 4096 : (bf16_t*)(p.ws + WS_RTC) + ((size_t)(l * 2 + order) * 256 + ch0) * 512;
    const int XL = 2 * L;
#pragma unroll
    for (int i = 0; i < 16; ++i) { int e = tid + 256 * i; int cc = e >> 6, xx = e & 63; RT[(size_t)cc * XL + x0 + xx] = f2bf(tile[xx * 65 + cc]); }
    __syncthreads();
}

DI void hy_short4(const P& p, int l, int ch768, int tokseq0, int L, int t, float* o) {
    const bf16_t* Z = (const bf16_t*)(p.ws + WS_ZT) + (size_t)ch768 * NTOK + tokseq0 + t;
    const float* cw = p.in[I_HCW] + l * 3 * 768 + ch768;
    const float w0 = cw[0], w1 = cw[768], w2 = cw[1536], bb = p.in[I_HCB][l * 768 + ch768];
    bf16x4 m = *(const bf16x4*)Z;
    const float zm = t > 0 ? bf2f(Z[-1]) : 0.f;
    const float z0 = bf2f((bf16_t)m[0]), z1 = bf2f((bf16_t)m[1]), z2 = bf2f((bf16_t)m[2]), z3 = bf2f((bf16_t)m[3]);
    const float zp = t + 4 < L ? bf2f(Z[4]) : 0.f;
    o[0] = bb + w0 * zm + w1 * z0 + w2 * z1;
    o[1] = bb + w0 * z0 + w1 * z1 + w2 * z2;
    o[2] = bb + w0 * z1 + w1 * z2 + w2 * z3;
    o[3] = bb + w0 * z2 + w1 * z3 + w2 * zp;
}
DI bf16x8 hy_short8(const P& p, int l, int ch768, int tokseq0, int L, int t) {
    const bf16_t* Z = (const bf16_t*)(p.ws + WS_ZT) + (size_t)ch768 * NTOK + tokseq0 + t;
    const float* cw = p.in[I_HCW] + l * 3 * 768 + ch768;
    const float w0 = cw[0], w1 = cw[768], w2 = cw[1536], bb = p.in[I_HCB][l * 768 + ch768];
    bf16x8 m = *(const bf16x8*)Z;
    const float zm = t > 0 ? bf2f(Z[-1]) : 0.f;
    const float z0 = bf2f((bf16_t)m[0]), z1 = bf2f((bf16_t)m[1]), z2 = bf2f((bf16_t)m[2]), z3 = bf2f((bf16_t)m[3]);
    const float z4 = bf2f((bf16_t)m[4]), z5 = bf2f((bf16_t)m[5]), z6 = bf2f((bf16_t)m[6]), z7 = bf2f((bf16_t)m[7]);
    const float zp = t + 8 < L ? bf2f(Z[8]) : 0.f;
    bf16x8 o;
    o[0] = (short)f2bf(bb + w0 * zm + w1 * z0 + w2 * z1);
    o[1] = (short)f2bf(bb + w0 * z0 + w1 * z1 + w2 * z2);
    o[2] = (short)f2bf(bb + w0 * z1 + w1 * z2 + w2 * z3);
    o[3] = (short)f2bf(bb + w0 * z2 + w1 * z3 + w2 * z4);
    o[4] = (short)f2bf(bb + w0 * z3 + w1 * z4 + w2 * z5);
    o[5] = (short)f2bf(bb + w0 * z4 + w1 * z5 + w2 * z6);
    o[6] = (short)f2bf(bb + w0 * z5 + w1 * z6 + w2 * z7);
    o[7] = (short)f2bf(bb + w0 * z6 + w1 * z7 + w2 * zp);
    return o;
}

DI void hy2_item(const P& p, int l, int which, int item, unsigned char* smem) {
    const int tid = get_tid(), lane = tid & 63, w = tid >> 6, lr = lane & 15, quad = lane >> 4;
    const bool lat = item < 256;
    const int c = lat ? item : item - 256;
    const int XL = lat ? 4096 : 512;
    unsigned* c0 = (unsigned*)smem;
    unsigned* c1 = c0 + 2048 + 16;
    bf16_t* U = (bf16_t*)(c1 + 2048 + 16);
    const bf16_t* RT = lat ? (const bf16_t*)(p.ws + WS_RTL) + ((size_t)(l * 2 + which) * 256 + c) * 4096
                           : (const bf16_t*)(p.ws + WS_RTC) + ((size_t)(l * 2 + which) * 256 + c) * 512;
    const bf16_t* Y1T = (const bf16_t*)(p.ws + WS_Y1T) + (size_t)c * NTOK;
    for (int i = tid; i < XL / 8; i += 256) *(u32x4*)(c0 + 4 * i) = *(const u32x4*)(RT + 8 * i);
    if (lat) {
        for (int i = tid; i < 2 * 64 * 72 / 8; i += 256) *(u32x4*)(U + 8 * i) = (u32x4){0u, 0u, 0u, 0u};
    }
    __syncthreads();
    for (int i = tid; i < XL / 2; i += 256) { unsigned lo = c0[i], hi = (i + 1 < XL / 2) ? c0[i + 1] : 0u; c1[i] = (lo >> 16) | (hi << 16); }
    if (lat) {
        for (int i = tid; i < 512; i += 256) {
            int b = i >> 8, t = (i & 255) * 8;
            bf16x8 v = which == 0 ? hy_short8(p, l, c, NCTX + 2048 * b, 2048, t) : *(const bf16x8*)(Y1T + NCTX + 2048 * b + t);
            *(bf16x8*)(U + (size_t)(b * 64 + 16 + (t >> 6)) * 72 + (t & 63)) = v;
        }
    } else {
        for (int i = tid; i < 1024; i += 256) {
            int b = i >> 5, t = (i & 31) * 8;
            bf16x8 v = which == 0 ? hy_short8(p, l, c, 256 * b, 256, t) : *(const bf16x8*)(Y1T + 256 * b + t);
            *(bf16x8*)(U + b * 264 + t) = v;
        }
    }
    __syncthreads();
    const float bias = p.in[I_HBIAS][(l * 2 + which) * 256 + c];
    bf16_t* OT = (which == 0 ? (bf16_t*)(p.ws + WS_Y1T) : (bf16_t*)(p.ws + WS_OUTT)) + (size_t)c * NTOK;
    const int xch = (which == 0 ? 256 : 512) + c;
    const int par = (lr + 1) & 1;
    const unsigned* cp = par ? c1 : c0;
    if (lat) {
        const int b = w >> 1, ih = w & 1;
        const int lane_dw = (2047 - lr - par) / 2 + 4 * quad;
        f32x4 acc[4];
#pragma unroll
        for (int i = 0; i < 4; ++i) acc[i] = (f32x4){0.f, 0.f, 0.f, 0.f};
        const int dlo = ih ? -15 : -31, dhi = ih ? 31 : 15;
        for (int dl = dlo; dl <= dhi; ++dl) {
#pragma unroll
            for (int ks = 0; ks < 2; ++ks) {
                bf16x8 bfr = *(const bf16x8*)(U + (size_t)(b * 64 + 16 + 16 * ih + lr - dl) * 72 + 32 * ks + 8 * quad);
#pragma unroll
                for (int mt = 0; mt < 4; ++mt) {
                    const unsigned* ap = cp + lane_dw - 32 * dl - 8 * mt + 16 * ks;
                    u32x4 av; av[0] = ap[0]; av[1] = ap[1]; av[2] = ap[2]; av[3] = ap[3];
                    acc[mt] = MFMA16(__builtin_bit_cast(bf16x8, av), bfr, acc[mt]);
                }
            }
        }
        const int tokseq0 = NCTX + 2048 * b;
#pragma unroll
        for (int mt = 0; mt < 4; ++mt) {
            const int t = 64 * (16 * ih + lr) + 16 * mt + 4 * quad;
            float x[4]; hy_short4(p, l, xch, tokseq0, 2048, t, x);
            bf16x4 uu = *(const bf16x4*)(U + (size_t)(b * 64 + 16 + (t >> 6)) * 72 + (t & 63));
            bf16x4 o;
#pragma unroll
            for (int j = 0; j < 4; ++j) o[j] = (short)f2bf(x[j] * (acc[mt][j] + bias * bf2f((bf16_t)uu[j])));
            *(bf16x4*)(OT + tokseq0 + t) = o;
        }
    } else {
        const int lane_dw = (255 - lr - par) / 2 + 4 * quad;
        f32x4 acc[4][2];
#pragma unroll
        for (int i = 0; i < 4; ++i) { acc[i][0] = (f32x4){0.f, 0.f, 0.f, 0.f}; acc[i][1] = (f32x4){0.f, 0.f, 0.f, 0.f}; }
#pragma unroll 2
        for (int ks = 0; ks < 8; ++ks) {
            bf16x8 b0 = *(const bf16x8*)(U + lr * 264 + 32 * ks + 8 * quad);
            bf16x8 b1 = *(const bf16x8*)(U + (16 + lr) * 264 + 32 * ks + 8 * quad);
#pragma unroll
            for (int mi = 0; mi < 4; ++mi) {
                const unsigned* ap = cp + lane_dw - 8 * (4 * w + mi) + 16 * ks;
                u32x4 av; av[0] = ap[0]; av[1] = ap[1]; av[2] = ap[2]; av[3] = ap[3];
                bf16x8 af = __builtin_bit_cast(bf16x8, av);
                acc[mi][0] = MFMA16(af, b0, acc[mi][0]);
                acc[mi][1] = MFMA16(af, b1, acc[mi][1]);
            }
        }
#pragma unroll
        for (int mi = 0; mi < 4; ++mi)
#pragma unroll
            for (int nt = 0; nt < 2; ++nt) {
                const int b = 16 * nt + lr, t = 16 * (4 * w + mi) + 4 * quad;
                float x[4]; hy_short4(p, l, xch, 256 * b, 256, t, x);
                bf16x4 uu = *(const bf16x4*)(U + b * 264 + t);
                bf16x4 o;
#pragma unroll
                for (int j = 0; j < 4; ++j) o[j] = (short)f2bf(x[j] * (acc[mi][nt][j] + bias * bf2f((bf16_t)uu[j])));
                *(bf16x4*)(OT + 256 * b + t) = o;
            }
    }
    __syncthreads();
}

DI void hyfin_item(const P& p, int item, unsigned char* smem) {
    bf16_t* tile = (bf16_t*)smem;
    const int tid = get_tid();
    const int tok0 = (item >> 2) * 64, ch0 = (item & 3) * 64;
    {
        const int cc = tid >> 2, part = tid & 3;
        const bf16_t* src = (const bf16_t*)(p.ws + WS_OUTT) + (size_t)(ch0 + cc) * NTOK + tok0 + part * 16;
        *(u32x4*)(tile + cc * 72 + part * 16) = *(const u32x4*)src;
        *(u32x4*)(tile + cc * 72 + part * 16 + 8) = *(const u32x4*)(src + 8);
    }
    __syncthreads();
    {
        const int tt = tid >> 2, part = tid & 3;
        const bf16_t* g = (const bf16_t*)(p.ws + WS_PROJ) + (size_t)(tok0 + tt) * NIN + C_GHY + ch0 + part * 16;
        bf16x8 g0 = *(const bf16x8*)g, g1 = *(const bf16x8*)(g + 8);
        bf16x8 o0, o1;
#pragma unroll
        for (int j = 0; j < 8; ++j) {
            o0[j] = (short)f2bf(bf2f(tile[(part * 16 + j) * 72 + tt]) * siluf_(bf2f((bf16_t)g0[j])));
            o1[j] = (short)f2bf(bf2f(tile[(part * 16 + 8 + j) * 72 + tt]) * siluf_(bf2f((bf16_t)g1[j])));
        }
        bf16_t* dst = (bf16_t*)(p.ws + WS_HB) + (size_t)(tok0 + tt) * 1024 + 256 + ch0 + part * 16;
        *(bf16x8*)dst = o0; *(bf16x8*)(dst + 8) = o1;
    }
    __syncthreads();
}

DI bf16x8 pack8(float a0, float a1, float a2, float a3, float a4, float a5, float a6, float a7) {
    typedef __bf16 bfv8 __attribute__((ext_vector_type(8)));
    typedef float fv8 __attribute__((ext_vector_type(8)));
    fv8 v = {a0, a1, a2, a3, a4, a5, a6, a7};
    return __builtin_bit_cast(bf16x8, __builtin_convertvector(v, bfv8));
}
DI void s5prep_item(const P& p, int item) {
    const int tid = get_tid();
    if (tid < 64) {
        const int pst = tid;
        unsigned char* T = p.ws + WS_S5T + (size_t)item * S5T_STRIDE;
        const int pidx = item * 64 + pst;
        const float are = fminf(p.in[I_AR][pidx], -1e-4f), aim = p.in[I_AI][pidx];
        const float dt = expf(p.in[I_LDT][item]);
        float abr, abi, Ar, Ai;
        { float m = expf(are * dt); float sn, cn; sincosf(aim * dt, &sn, &cn); abr = m * cn; abi = m * sn; }
        { float m = expf(are * dt * 256.f); float sn, cn; sincosf(aim * dt * 256.f, &sn, &cn); Ar = m * cn; Ai = m * sn; }
        ((float2*)T)[pst] = make_float2(abr, abi);
        ((float2*)T)[64 + pst] = make_float2(Ar, Ai);
        float nr = abr - 1.f, ni = abi; float den = 1.f / (are * are + aim * aim);
        float cfr = (nr * are + ni * aim) * den, cfi = (ni * are - nr * aim) * den;
        bf16_t* Bt = (bf16_t*)(T + 1024);
        bf16_t* Ct = (bf16_t*)(T + 1024 + 4096);
        for (int i = 0; i < 16; ++i) {
            float br = p.in[I_BR][(size_t)pidx * 16 + i], bi = p.in[I_BI][(size_t)pidx * 16 + i];
            Bt[(2 * pst) * 16 + i] = f2bf(cfr * br - cfi * bi);
            Bt[(2 * pst + 1) * 16 + i] = f2bf(cfr * bi + cfi * br);
            size_t ci = (size_t)(item * 16 + i) * 64 + pst;
            Ct[i * 128 + 2 * pst] = f2bf(p.in[I_CR][ci]);
            Ct[i * 128 + 2 * pst + 1] = f2bf(-p.in[I_CI][ci]);
        }
    }
}
DI void s5_item(const P& p, int l, int sc, int g, int dir, int mode, unsigned char* smem) {
    bf16_t* Ub = (bf16_t*)smem;
    float* H = (float*)(Ub + 256 * 16);
    const int tid = get_tid(), lane = tid & 63, w = tid >> 6, lr = lane & 15, quad = lane >> 4;
    const int pst = lane;
    const bool lat = sc >= 32;
    const int tokc = lat ? NCTX + 256 * (sc - 32) : 256 * sc;
    const int lb = lat ? (sc - 32) >> 3 : 0, lj = lat ? (sc - 32) & 7 : 0;
    const bf16_t* PR = (const bf16_t*)(p.ws + WS_PROJ);
    for (int e = tid; e < 512; e += 256) *(u32x4*)(Ub + 8 * e) = *(const u32x4*)(PR + (size_t)(tokc + (e >> 1)) * NIN + C_S5 + 16 * g + 8 * (e & 1));
    const unsigned char* T = p.ws + WS_S5T + (size_t)((l * 2 + dir) * 16 + g) * S5T_STRIDE;
    const float2 ab = ((const float2*)T)[pst];
    const float abr = ab.x, abi = ab.y;
    bf16x8 afB[8];
#pragma unroll
    for (int mt = 0; mt < 8; ++mt) {
        afB[mt] = (bf16x8){0, 0, 0, 0, 0, 0, 0, 0};
        if (quad < 2) afB[mt] = *(const bf16x8*)((const bf16_t*)(T + 1024) + (16 * mt + lr) * 16 + 8 * quad);
    }
    bf16x8 afC[4];
    if (mode == 1) {
#pragma unroll
        for (int ks = 0; ks < 4; ++ks) afC[ks] = *(const bf16x8*)((const bf16_t*)(T + 1024 + 4096) + lr * 128 + 32 * ks + 8 * quad);
    }
    float hr = 0.f, hi = 0.f;
    if (mode == 1 && lat && w == 0) {
        const float* h0 = p.in[I_SS5] + ((size_t)(((lb * 2 + l) * 2 + dir) * 16 + g) * 64 + pst) * 2;
        hr = h0[0]; hi = h0[1];
        const float2 A2 = ((const float2*)T)[64 + pst];
        const float Ar = A2.x, Ai = A2.y;
        const float* LOC = (const float*)(p.ws + WS_S5LOC);
        if (dir == 0) {
            for (int j = 0; j < lj; ++j) {
                const float* lc = LOC + ((size_t)(((lb * 8 + j) * 16 + g) * 2 + dir) * 64 + pst) * 2;
                float nr = Ar * hr - Ai * hi + lc[0], ni = Ar * hi + Ai * hr + lc[1]; hr = nr; hi = ni;
            }
        } else {
            for (int j = 7; j > lj; --j) {
                const float* lc = LOC + ((size_t)(((lb * 8 + j) * 16 + g) * 2 + dir) * 64 + pst) * 2;
                float nr = Ar * hr - Ai * hi + lc[0], ni = Ar * hi + Ai * hr + lc[1]; hr = nr; hi = ni;
            }
        }
    }
    __syncthreads();
    for (int sbi = 0; sbi < 4; ++sbi) {
        const int sub = dir == 0 ? sbi : 3 - sbi;
        const int tl = sub * 64 + 16 * w + lr, tok = tokc + tl, ch = 16 * g + 4 * quad;
        float* YS = (float*)(p.ws + WS_YS5) + (size_t)tok * 256 + ch;
        float4 pv = make_float4(0.f, 0.f, 0.f, 0.f);
        if (mode == 1 && dir == 1) pv = *(const float4*)YS;
        {
            bf16x8 bfr = (bf16x8){0, 0, 0, 0, 0, 0, 0, 0};
            if (quad < 2) bfr = *(const bf16x8*)(Ub + tl * 16 + 8 * quad);
#pragma unroll
            for (int mt = 0; mt < 8; ++mt) {
                f32x4 acc = MFMA16(afB[mt], bfr, ((f32x4){0.f, 0.f, 0.f, 0.f}));
                *(f32x4*)(H + (16 * w + lr) * 132 + 16 * mt + 4 * quad) = acc;
            }
        }
        __syncthreads();
        if (w == 0) {
#pragma unroll 8
            for (int k = 0; k < 64; ++k) {
                int tt = dir == 0 ? k : 63 - k;
                float2 b = *(const float2*)(H + tt * 132 + 2 * pst);
                float nr = abr * hr - abi * hi + b.x, ni = abr * hi + abi * hr + b.y; hr = nr; hi = ni;
                *(float2*)(H + tt * 132 + 2 * pst) = make_float2(hr, hi);
            }
        }
        __syncthreads();
        if (mode == 1) {
            f32x4 acc = (f32x4){0.f, 0.f, 0.f, 0.f};
#pragma unroll
            for (int ks = 0; ks < 4; ++ks) {
                const float* hp = H + (16 * w + lr) * 132 + 32 * ks + 8 * quad;
                float4 x0 = *(const float4*)hp, x1 = *(const float4*)(hp + 4);
                bf16x8 bfr = pack8(x0.x, x0.y, x0.z, x0.w, x1.x, x1.y, x1.z, x1.w);
                acc = MFMA16(afC[ks], bfr, acc);
            }
            if (dir == 0) {
                bf16x4 uu = *(const bf16x4*)(Ub + tl * 16 + 4 * quad);
                float4 dd = *(const float4*)(p.in[I_S5D] + l * 256 + ch);
                float4 o;
                o.x = dd.x * bf2f((bf16_t)uu[0]) + acc[0]; o.y = dd.y * bf2f((bf16_t)uu[1]) + acc[1];
                o.z = dd.z * bf2f((bf16_t)uu[2]) + acc[2]; o.w = dd.w * bf2f((bf16_t)uu[3]) + acc[3];
                *(float4*)YS = o;
            } else {
                bf16x4 o;
                o[0] = (short)f2bf(gelu_tanh(pv.x + acc[0])); o[1] = (short)f2bf(gelu_tanh(pv.y + acc[1]));
                o[2] = (short)f2bf(gelu_tanh(pv.z + acc[2])); o[3] = (short)f2bf(gelu_tanh(pv.w + acc[3]));
                *(bf16x4*)((bf16_t*)(p.ws + WS_GS5) + (size_t)tok * 256 + ch) = o;
            }
            __syncthreads();
        }
    }
    if (w == 0) {
        if (mode == 0) {
            float* lc = (float*)(p.ws + WS_S5LOC) + ((size_t)(((lb * 8 + lj) * 16 + g) * 2 + dir) * 64 + pst) * 2;
            lc[0] = hr; lc[1] = hi;
        } else if (!lat) {
            float* o = p.out + OFF_S5 + ((size_t)(((sc * 2 + l) * 2 + dir) * 16 + g) * 64 + pst) * 2;
            o[0] = hr; o[1] = hi;
        }
    }
    __syncthreads();
}

DI void gla_item(const P& p, int l, int sc, int head, int dir, int mode, unsigned char* smem) {
    float* qs = (float*)smem;
    float* ks = qs + 1024;
    float* ds = ks + 1024;
    float* vs = ds + 1024;
    float* gl = vs + 2048;
    float* gwl = gl + 512;
    float* ob = gwl + 544;
    const int tid = get_tid(), lane = tid & 63, w = tid >> 6;
    const int e = 16 * w + (lane & 15), dq = lane >> 4;
    const bool lat = sc >= 32;
    const int tokc = lat ? NCTX + 256 * (sc - 32) : 256 * sc;
    const int lb = lat ? (sc - 32) >> 3 : 0, lj = lat ? (sc - 32) & 7 : 0;
    const bf16_t* PR = (const bf16_t*)(p.ws + WS_PROJ);
    float S[8];
#pragma unroll
    for (int i = 0; i < 8; ++i) S[i] = 0.f;
    float acum[8];
#pragma unroll
    for (int i = 0; i < 8; ++i) acum[i] = 1.f;
    for (int i = tid; i < 544; i += 256)
        gwl[i] = i < 512 ? p.in[I_GGW][(size_t)((l * 2 + dir) * 16 + (i >> 5)) * 128 + 32 * head + (i & 31)] : p.in[I_GGB][(l * 2 + dir) * 128 + 32 * head + (i - 512)];
    if (mode == 1 && lat) {
        const float* s0 = p.in[I_SGLA] + (size_t)(((lb * 2 + l) * 2 + dir) * 4 + head) * 2048;
#pragma unroll
        for (int i = 0; i < 8; ++i) S[i] = s0[(8 * dq + i) * 64 + e];
        const float* LOC = (const float*)(p.ws + WS_GLALOC);
        if (dir == 0) {
            for (int j = 0; j < lj; ++j) {
                const float* lc = LOC + (size_t)(((lb * 8 + j) * 4 + head) * 2 + dir) * 2080;
#pragma unroll
                for (int i = 0; i < 8; ++i) S[i] = lc[2048 + 8 * dq + i] * S[i] + lc[(8 * dq + i) * 64 + e];
            }
        } else {
            for (int j = 7; j > lj; --j) {
                const float* lc = LOC + (size_t)(((lb * 8 + j) * 4 + head) * 2 + dir) * 2080;
#pragma unroll
                for (int i = 0; i < 8; ++i) S[i] = lc[2048 + 8 * dq + i] * S[i] + lc[(8 * dq + i) * 64 + e];
            }
        }
    }
    float* OG = (float*)(p.ws + WS_OGLA) + (size_t)dir * NTOK * 256;
    bf16x8 rqk, rv8, rg8 = (bf16x8){0, 0, 0, 0, 0, 0, 0, 0};
    const int qk_t = (tid & 127) >> 2, qk_c = (tid & 3) * 8, qk_col = (tid < 128 ? C_GQ : C_GK) + 32 * head + qk_c;
    {
        const int sub = dir == 0 ? 0 : 7; const int tk0 = tokc + sub * 32;
        rqk = *(const bf16x8*)(PR + (size_t)(tk0 + qk_t) * NIN + qk_col);
        rv8 = *(const bf16x8*)(PR + (size_t)(tk0 + (tid >> 3)) * NIN + C_GV + 64 * head + (tid & 7) * 8);
        if (tid < 64) rg8 = *(const bf16x8*)(PR + (size_t)(tk0 + (tid >> 1)) * NIN + C_GG + 16 * dir + (tid & 1) * 8);
    }
    for (int sbi = 0; sbi < 8; ++sbi) {
        const int sub = dir == 0 ? sbi : 7 - sbi;
        const int tk0 = tokc + sub * 32;
        __syncthreads();
        {
            float* dq_ = (tid < 128 ? qs : ks) + qk_t * 32 + qk_c;
            const float sc_ = tid < 128 ? 0.17677669529663687f : 1.f;
            *(float4*)dq_ = make_float4(bf2f((bf16_t)rqk[0]) * sc_, bf2f((bf16_t)rqk[1]) * sc_, bf2f((bf16_t)rqk[2]) * sc_, bf2f((bf16_t)rqk[3]) * sc_);
            *(float4*)(dq_ + 4) = make_float4(bf2f((bf16_t)rqk[4]) * sc_, bf2f((bf16_t)rqk[5]) * sc_, bf2f((bf16_t)rqk[6]) * sc_, bf2f((bf16_t)rqk[7]) * sc_);
            float* dv_ = vs + (tid >> 3) * 64 + (tid & 7) * 8;
            *(float4*)dv_ = make_float4(bf2f((bf16_t)rv8[0]), bf2f((bf16_t)rv8[1]), bf2f((bf16_t)rv8[2]), bf2f((bf16_t)rv8[3]));
            *(float4*)(dv_ + 4) = make_float4(bf2f((bf16_t)rv8[4]), bf2f((bf16_t)rv8[5]), bf2f((bf16_t)rv8[6]), bf2f((bf16_t)rv8[7]));
            if (tid < 64) {
                float* dg_ = gl + (tid >> 1) * 16 + (tid & 1) * 8;
                *(float4*)dg_ = make_float4(bf2f((bf16_t)rg8[0]), bf2f((bf16_t)rg8[1]), bf2f((bf16_t)rg8[2]), bf2f((bf16_t)rg8[3]));
                *(float4*)(dg_ + 4) = make_float4(bf2f((bf16_t)rg8[4]), bf2f((bf16_t)rg8[5]), bf2f((bf16_t)rg8[6]), bf2f((bf16_t)rg8[7]));
            }
        }
        __syncthreads();
        if (sbi < 7) {
            const int nsub = dir == 0 ? sbi + 1 : 6 - sbi; const int nk0 = tokc + nsub * 32;
            rqk = *(const bf16x8*)(PR + (size_t)(nk0 + qk_t) * NIN + qk_col);
            rv8 = *(const bf16x8*)(PR + (size_t)(nk0 + (tid >> 3)) * NIN + C_GV + 64 * head + (tid & 7) * 8);
            if (tid < 64) rg8 = *(const bf16x8*)(PR + (size_t)(nk0 + (tid >> 1)) * NIN + C_GG + 16 * dir + (tid & 1) * 8);
        }
#pragma unroll
        for (int j = 0; j < 4; ++j) {
            int i = tid + 256 * j; int t = i >> 5, d = i & 31;
            float z = gwl[512 + d];
#pragma unroll
            for (int r = 0; r < 16; ++r) z += gl[t * 16 + r] * gwl[r * 32 + d];
            float ls = fminf(z, 0.f) - __logf(1.f + __expf(-fabsf(z)));
            ds[i] = __expf(ls * (1.f / 16.f));
        }
        __syncthreads();
        {
            f32x2 S2[4], A2[4];
#pragma unroll
            for (int i = 0; i < 4; ++i) { S2[i] = (f32x2){S[2 * i], S[2 * i + 1]}; A2[i] = (f32x2){acum[2 * i], acum[2 * i + 1]}; }
#pragma unroll 4
            for (int k = 0; k < 32; ++k) {
                const int t = dir == 0 ? k : 31 - k;
                const float4* ap = (const float4*)(ds + t * 32 + 8 * dq);
                const float4* kp = (const float4*)(ks + t * 32 + 8 * dq);
                const float4 a0 = ap[0], a1 = ap[1], k0 = kp[0], k1 = kp[1];
                const float v = vs[t * 64 + e];
                const f32x2 vv = (f32x2){v, v};
                const f32x2 a01 = (f32x2){a0.x, a0.y}, a23 = (f32x2){a0.z, a0.w}, a45 = (f32x2){a1.x, a1.y}, a67 = (f32x2){a1.z, a1.w};
                S2[0] = a01 * S2[0] + (f32x2){k0.x, k0.y} * vv;
                S2[1] = a23 * S2[1] + (f32x2){k0.z, k0.w} * vv;
                S2[2] = a45 * S2[2] + (f32x2){k1.x, k1.y} * vv;
                S2[3] = a67 * S2[3] + (f32x2){k1.z, k1.w} * vv;
                if (mode == 1) {
                    const float4* qp = (const float4*)(qs + t * 32 + 8 * dq);
                    const float4 q0 = qp[0], q1 = qp[1];
                    f32x2 oo = (f32x2){q0.x, q0.y} * S2[0];
                    oo = (f32x2){q0.z, q0.w} * S2[1] + oo;
                    oo = (f32x2){q1.x, q1.y} * S2[2] + oo;
                    oo = (f32x2){q1.z, q1.w} * S2[3] + oo;
                    ob[(t * 64 + e) * 4 + dq] = oo[0] + oo[1];
                } else {
                    A2[0] *= a01; A2[1] *= a23; A2[2] *= a45; A2[3] *= a67;
                }
            }
#pragma unroll
            for (int i = 0; i < 4; ++i) { S[2 * i] = S2[i][0]; S[2 * i + 1] = S2[i][1]; acum[2 * i] = A2[i][0]; acum[2 * i + 1] = A2[i][1]; }
        }
        if (mode == 1) {
            __syncthreads();
            const int t = tid >> 3, e0 = (tid & 7) * 8;
            float r[8];
#pragma unroll
            for (int j = 0; j < 8; ++j) { float4 x = *(const float4*)(ob + (t * 64 + e0 + j) * 4); r[j] = (x.x + x.y) + (x.z + x.w); }
            float* dst = OG + (size_t)(tk0 + t) * 256 + 64 * head + e0;
            *(float4*)dst = make_float4(r[0], r[1], r[2], r[3]);
            *(float4*)(dst + 4) = make_float4(r[4], r[5], r[6], r[7]);
        }
    }
    if (mode == 0) {
        float* lc = (float*)(p.ws + WS_GLALOC) + (size_t)(((lb * 8 + lj) * 4 + head) * 2 + dir) * 2080;
#pragma unroll
        for (int i = 0; i < 8; ++i) lc[(8 * dq + i) * 64 + e] = S[i];
        if (w == 0 && (lane & 15) == 0) {
#pragma unroll
            for (int i = 0; i < 8; ++i) lc[2048 + 8 * dq + i] = acum[i];
        }
    } else if (!lat) {
        float* o = p.out + OFF_GLA + (size_t)(((sc * 2 + l) * 2 + dir) * 4 + head) * 2048;
#pragma unroll
        for (int i = 0; i < 8; ++i) o[(8 * dq + i) * 64 + e] = S[i];
    }
    __syncthreads();
}

DI void glafin_item(const P& p, int l, int item) {
    const int tid_ = get_tid(); const int lane = tid_ & 63, w = tid_ >> 6;
    float4 a[2], b[2]; bf16x4 g[2];
#pragma unroll
    for (int j = 0; j < 2; ++j) {
        const int tok = (item * 2 + j) * 4 + w;
        const float* O0 = (const float*)(p.ws + WS_OGLA) + (size_t)tok * 256 + lane * 4;
        a[j] = *(const float4*)O0; b[j] = *(const float4*)(O0 + (size_t)NTOK * 256);
        g[j] = *(const bf16x4*)((const bf16_t*)(p.ws + WS_PROJ) + (size_t)tok * NIN + C_GGLA + lane * 4);
    }
    const float4 nw = *(const float4*)(p.in[I_GLAN] + l * 64 + (lane & 15) * 4);
#pragma unroll
    for (int j = 0; j < 2; ++j) {
        const int tok = (item * 2 + j) * 4 + w;
        float v[4] = {a[j].x + b[j].x, a[j].y + b[j].y, a[j].z + b[j].z, a[j].w + b[j].w};
        float ss = v[0] * v[0] + v[1] * v[1] + v[2] * v[2] + v[3] * v[3];
        ss += __shfl_xor(ss, 1); ss += __shfl_xor(ss, 2); ss += __shfl_xor(ss, 4); ss += __shfl_xor(ss, 8);
        float r = rsqrtf(ss * (1.f / 64.f) + 1e-6f);
        bf16x4 o;
        o[0] = (short)f2bf(v[0] * r * nw.x * siluf_(bf2f((bf16_t)g[j][0])));
        o[1] = (short)f2bf(v[1] * r * nw.y * siluf_(bf2f((bf16_t)g[j][1])));
        o[2] = (short)f2bf(v[2] * r * nw.z * siluf_(bf2f((bf16_t)g[j][2])));
        o[3] = (short)f2bf(v[3] * r * nw.w * siluf_(bf2f((bf16_t)g[j][3])));
        *(bf16x4*)((bf16_t*)(p.ws + WS_HB) + (size_t)tok * 1024 + 768 + lane * 4) = o;
    }
}

#define XB_TMO      128
#define XB_XCNT(j)  (256  + 64 * (j))
#define XB_XSUB(j)  (1280 + 64 * (j))
#define XB_XGEN(j)  (2304 + 64 * (j))
#define XB_TOP      3328
#define XB_TOPGEN   3392
#define XCD_BAR_WORDS 3456
#define XB_SPIN_CAP (1u << 18)
#define LAS __attribute__((address_space(3)))
DI unsigned xb_ld(unsigned* p)              { return __hip_atomic_load(p, __ATOMIC_RELAXED, __HIP_MEMORY_SCOPE_AGENT); }
DI unsigned xb_add(unsigned* p, unsigned v) { return __hip_atomic_fetch_add(p, v, __ATOMIC_RELAXED, __HIP_MEMORY_SCOPE_AGENT); }
DI unsigned xb_xcc_id() { return (unsigned)__builtin_amdgcn_s_getreg((3 << 11) | 20) & 0xFu; }
#define XB_SPIN(cond, bar) do { unsigned _sp = 0; while (cond) { __builtin_amdgcn_s_sleep(1); \
    if ((++_sp & 255u) == 0u) { if (xb_ld(&(bar)[XB_TMO])) break; if (_sp > XB_SPIN_CAP) { atomicAdd(&(bar)[XB_TMO], 1u); break; } } } } while (0)
struct XcdBarrier { unsigned* bar; unsigned x; volatile LAS unsigned* st; };
DI XcdBarrier xcd_barrier_post(unsigned* bar, volatile LAS unsigned* st) {
    XcdBarrier b; b.bar = bar; b.x = xb_xcc_id(); b.st = st;
    if (threadIdx.x == 0) (void)xb_add(&bar[XB_XCNT(b.x)], 1u);
    return b;
}
DI void xcd_barrier_complete(unsigned* bar, unsigned x, unsigned& nloc, unsigned& nx) {
    const unsigned G = gridDim.x * gridDim.y * gridDim.z;
    unsigned sum, cnt, mine, sp = 0u;
    for (;;) {
        sum = 0u; cnt = 0u; mine = 0u;
#pragma unroll
        for (unsigned j = 0; j < 16; ++j) { const unsigned c = xb_ld(&bar[XB_XCNT(j)]); sum += c; cnt += (c > 0u) ? 1u : 0u; mine = (j == x) ? c : mine; }
        if (sum == G) break;
        __builtin_amdgcn_s_sleep(1);
        if ((++sp & 255u) == 0u) { if (xb_ld(&bar[XB_TMO])) break; if (sp > XB_SPIN_CAP) { atomicAdd(&bar[XB_TMO], 1u); break; } }
    }
    nloc = mine > 0u ? mine : 1u; nx = cnt > 0u ? cnt : 1u;
}
DI void xcd_barrier(const XcdBarrier& b) {
    asm volatile("s_waitcnt vmcnt(0)" ::: "memory");
    __syncthreads();
    if (threadIdx.x == 0) {
        unsigned* bar = b.bar;
        __builtin_amdgcn_s_waitcnt(0);
        unsigned nloc = b.st[0], nx = b.st[1];
        if (nloc == 0u) { xcd_barrier_complete(bar, b.x, nloc, nx); b.st[0] = nloc; b.st[1] = nx; }
        const unsigned old = xb_add(&bar[XB_XSUB(b.x)], 1u);
        const unsigned gen = old / nloc;
        if (old + 1u == (gen + 1u) * nloc) {
            __builtin_amdgcn_fence(__ATOMIC_RELEASE, "agent");
            asm volatile("s_waitcnt vmcnt(0)" ::: "memory");
            const unsigned og = xb_add(&bar[XB_TOP], 1u);
            const unsigned tg = og / nx;
            if (og + 1u == (tg + 1u) * nx) xb_add(&bar[XB_TOPGEN], 1u);
            else XB_SPIN(xb_ld(&bar[XB_TOPGEN]) == tg, bar);
            __builtin_amdgcn_fence(__ATOMIC_ACQUIRE, "agent");
            xb_add(&bar[XB_XGEN(b.x)], 1u);
            asm volatile("s_waitcnt vmcnt(0)" ::: "memory");
        } else {
            XB_SPIN(xb_ld(&bar[XB_XGEN(b.x)]) == gen, bar);
            __builtin_amdgcn_fence(__ATOMIC_ACQUIRE, "agent");
            asm volatile("s_waitcnt vmcnt(0)" ::: "memory");
        }
    }
    __syncthreads();
}

constexpr int SMEM_BYTES = 59392;
#ifndef NPHASE_LAUNCH
#define NPHASE_LAUNCH 0
#endif

DI int next_item(unsigned* ctr, int* slot) {
    __syncthreads();
    if (threadIdx.x == 0) *slot = (int)atomicAdd(ctr, 1u);
    __syncthreads();
    return __builtin_amdgcn_readfirstlane(*slot);
}

__global__ void __launch_bounds__(256, 2) mega(P pk, int ph_lo, int ph_hi) {
    __shared__ __attribute__((aligned(16))) unsigned char smem[SMEM_BYTES];
    __shared__ P p;
    __shared__ int s_next;
    if (threadIdx.x < 42) p.in[threadIdx.x] = pk.in[threadIdx.x];
    if (threadIdx.x == 42) p.out = pk.out;
    if (threadIdx.x == 43) p.ws = pk.ws;
    __syncthreads();
    cg::grid_group grid = cg::this_grid();
    __shared__ uint4 xb_words;
    if (threadIdx.x == 0) xb_words = make_uint4(0u, 0u, 0u, 0u);
    __syncthreads();
    XcdBarrier xbar = xcd_barrier_post((unsigned*)(pk.ws + WS_CTR), (volatile LAS unsigned*)&xb_words);
    if (ph_lo < 0) grid.sync();
    int ph = 0;
#define PHASE_BEGIN if (ph >= ph_lo && ph < ph_hi) {
#define PHASE_END   if (ph + 1 < ph_hi) xcd_barrier(xbar); } ++ph;
#define FOR_ITEMS(N) for (int it = blockIdx.x; it < (N); it += gridDim.x)

    PHASE_BEGIN
    FOR_ITEMS(2756 + 64) {
        if (it >= 2756) s5prep_item(p, it - 2756);
        else if (it < 96) ada_item(p, it / 48, it % 48, smem);
        else if (it < 96 + 576) { int j = it - 96; int l = j / 288, r = j % 288; int ls = r < 256 ? 1 : 0; hyfilt_item(p, l, ls, ls ? r : r - 256, smem); }
        else {
            int j = it - 672; int l = j / 1042, r = j % 1042;
            if (r < 736) tr_item(p.in[I_WIN] + (size_t)l * 1024 * 2944, 1024, 2944, (bf16_t*)(p.ws + WS_WTIN) + (size_t)l * 2944 * 1024, r / 46, r % 46, smem);
            else if (r < 992) { r -= 736; tr_item(p.in[I_WOUT] + (size_t)l * 1024 * 1024, 1024, 1024, (bf16_t*)(p.ws + WS_WTOUT) + (size_t)l * 1024 * 1024, r / 16, r % 16, smem); }
            else if (r < 1010) { r -= 992; tr_item(p.in[I_WUQ] + (size_t)l * 192 * 384, 192, 384, (bf16_t*)(p.ws + WS_WTUQ) + (size_t)l * 384 * 192, r / 6, r % 6, smem); }
            else if (r < 1026) { r -= 1010; tr_item(p.in[I_WUKV] + (size_t)l * 128 * 512, 128, 512, (bf16_t*)(p.ws + WS_WTUKV) + (size_t)l * 512 * 128, r / 8, r % 8, smem); }
            else { r -= 1026; tr_item(p.in[I_GLUW] + (size_t)l * 256 * 256, 256, 256, (bf16_t*)(p.ws + WS_WTGLU) + (size_t)l * 256 * 256, r / 4, r % 4, smem); }
        }
    }
    PHASE_END

    for (int l = 0; l < 2; ++l) {
        PHASE_BEGIN
        FOR_ITEMS(512 + (l == 0 ? 32 : 0)) {
            if (it < 512) normmod_item(p, l, it);
            else { int j = it - 512; hynorm_item(p, j >> 4, (j >> 3) & 1, j & 7, smem); }
        }
        PHASE_END
        PHASE_BEGIN
        {
            EpiProj ep{(bf16_t*)(p.ws + WS_PROJ), (bf16_t*)(p.ws + WS_ZT)};
            const bf16_t* A = (const bf16_t*)(p.ws + WS_HB);
            const bf16_t* Bt = (const bf16_t*)(p.ws + WS_WTIN) + (size_t)l * 2944 * 1024;
            FOR_ITEMS(96 * 23 + (l == 0 ? 1152 : 0)) {
                if (it < 96 * 23) { const int xq = it >> 3, xx = it & 7; gemm_tile(A, 1024, Bt, 1024, 1024, (8 * (xq / 23) + xx) * 128, (xq % 23) * 128, smem, ep); }
                else rt_item(p, it - 96 * 23, smem);
            }
        }
        PHASE_END
        PHASE_BEGIN
        FOR_ITEMS(128 + 256 + 512 + 416 + 256) {
            if (it < 128) { int j = it; gla_item(p, l, 32 + (j >> 3), (j >> 1) & 3, j & 1, 0, smem); }
            else if (it < 384 || it >= 1312) hy2_item(p, l, 0, it < 384 ? it - 128 : 256 + it - 1312, smem);
            else if (it < 896) { int j = it - 384; s5_item(p, l, 32 + (j >> 5), (j >> 1) & 15, j & 1, 0, smem); }
            else mlaprep_item(p, l, it - 896, smem);
        }
        PHASE_END
        PHASE_BEGIN
        FOR_ITEMS(384 + 128 + 768 + 256 + 256 + 256) {
            if (it < 384) { int j = it; gla_item(p, l, 47 - (j >> 3), (j >> 1) & 3, j & 1, 1, smem); }
            else if (it < 512 || (it >= 1536 && it < 1792)) attn_item(p, l, it < 512 ? it - 384 : 128 + it - 1536, smem);
            else if (it < 1280) { int j = it - 512; int sc = 47 - (j >> 4), g = j & 15; for (int dir = 0; dir < 2; ++dir) s5_item(p, l, sc, g, dir, 1, smem); }
            else hy2_item(p, l, 1, it < 1536 ? it - 1280 : 256 + it - 1792, smem);
        }
        PHASE_END
        PHASE_BEGIN
        {
            EpiGlu eg{&p, l};
            const bf16_t* A = (const bf16_t*)(p.ws + WS_GS5);
            const bf16_t* Bt = (const bf16_t*)(p.ws + WS_WTGLU) + (size_t)l * 256 * 256;
            FOR_ITEMS(192 + 512 + 768) {
                if (it < 192) gemm_tile(A, 256, Bt, 256, 256, (it >> 1) * 128, (it & 1) * 128, smem, eg);
                else if (it < 704) { for (int k = 0; k < 3; ++k) glafin_item(p, l, (it - 192) * 3 + k); }
                else hyfin_item(p, it - 704, smem);
            }
        }
        PHASE_END
        PHASE_BEGIN
        {
            EpiOut eo{&p, l};
            const bf16_t* A = (const bf16_t*)(p.ws + WS_HB);
            const bf16_t* Bt = (const bf16_t*)(p.ws + WS_WTOUT) + (size_t)l * 1024 * 1024;
            FOR_ITEMS(96 * 8) { const int xq = it >> 3, xx = it & 7; gemm_tile(A, 1024, Bt, 1024, 1024, (8 * (xq >> 3) + xx) * 128, (xq & 7) * 128, smem, eo); }
        }
        PHASE_END
    }
}

extern "C" void kernel_launch(void* const* d_in, const int* in_sizes, int n_in, void* d_out, int out_size, void* d_ws, size_t ws_size,
                              hipStream_t stream) {
    static int grid_blocks = 0;
    if (!grid_blocks) {
        int dev = 0, cus = 0, per_cu = 0;
        hipGetDevice(&dev);
        hipDeviceGetAttribute(&cus, hipDeviceAttributeMultiprocessorCount, dev);
        hipOccupancyMaxActiveBlocksPerMultiprocessor(&per_cu, mega, 256, 0);
        if (per_cu > 2) per_cu = 2;
        if (per_cu < 1) per_cu = 1;
        grid_blocks = cus * per_cu;
        if (ws_size < WS_END) fprintf(stderr, "workspace too small: %zu < %zu\n", ws_size, (size_t)WS_END);
    }
    hipMemsetAsync((unsigned char*)d_ws + WS_CTR, 0, XCD_BAR_WORDS * 4, stream);
    P p{};
    for (int i = 0; i < 42; ++i) p.in[i] = (const float*)d_in[i];
    p.out = (float*)d_out; p.ws = (unsigned char*)d_ws;
#if NPHASE_LAUNCH
    for (int ph = 0; ph < 13; ++ph) {
        int lo = ph, hi = ph + 1;
        hipLaunchKernelGGL(mega, dim3(grid_blocks), dim3(256), 0, stream, p, lo, hi);
    }
#else
    int lo = 0, hi = 13;
    void* args[] = {&p, &lo, &hi};
    hipError_t e = hipLaunchCooperativeKernel((void*)mega, dim3(grid_blocks), dim3(256), args, 0, stream);
    if (e != hipSuccess) fprintf(stderr, "cooperative launch failed: %s (grid %d)\n", hipGetErrorString(e), grid_blocks);
#endif
}
```

```cpp
#include <hip/hip_runtime.h>
#include <hip/hip_bf16.h>
#include <hip/hip_cooperative_groups.h>
#include <cstdio>
namespace cg = cooperative_groups;

typedef unsigned short bf16_t;
using bf16x8 = __attribute__((ext_vector_type(8))) short;
using bf16x4 = __attribute__((ext_vector_type(4))) short;
using f32x4 = __attribute__((ext_vector_type(4))) float;
using u32x4 = __attribute__((ext_vector_type(4))) unsigned;
using f32x2 = __attribute__((ext_vector_type(2))) float;
#define DI __device__ __forceinline__

constexpr int NTOK = 12288, NCTX = 8192, DM = 1024, NIN = 2944, NKT = 13312;
constexpr int C_CQ = 0, C_CKV = 192, C_KR = 320, C_GMLA = 352, C_HY = 608, C_GHY = 1376, C_S5 = 1632, C_GS5 = 1888,
              C_GQ = 2144, C_GK = 2272, C_GV = 2400, C_GG = 2656, C_GGLA = 2688;
constexpr size_t OFF_CKV = 12582912, OFF_KR = 14680064, OFF_S5 = 15204352, OFF_GLA = 15466496;

constexpr size_t al256(size_t x) { return (x + 255) & ~(size_t)255; }
constexpr size_t WS_MOD = 0;
constexpr size_t WS_WTIN = al256(WS_MOD + 2 * 3 * 3072 * 4);
constexpr size_t WS_WTOUT = al256(WS_WTIN + (size_t)2 * 2944 * 1024 * 2);
constexpr size_t WS_WTUQ = al256(WS_WTOUT + (size_t)2 * 1024 * 1024 * 2);
constexpr size_t WS_WTUKV = al256(WS_WTUQ + (size_t)2 * 384 * 192 * 2);
constexpr size_t WS_WTGLU = al256(WS_WTUKV + (size_t)2 * 512 * 128 * 2);
constexpr size_t WS_HF = al256(WS_WTGLU + (size_t)2 * 256 * 256 * 2);
constexpr size_t HF_LAYER = (size_t)(256 + 2048) * 1024;
constexpr size_t WS_HNORM = al256(WS_HF + 2 * HF_LAYER * 4);
constexpr size_t WS_HB = al256(WS_HNORM + 2 * 2 * 512 * 4);
constexpr size_t WS_PROJ = al256(WS_HB + (size_t)NTOK * 1024 * 2);
constexpr size_t WS_QB = al256(WS_PROJ + (size_t)NTOK * NIN * 2);
constexpr size_t WS_KB = al256(WS_QB + (size_t)4 * NTOK * 96 * 2);
constexpr size_t WS_VT = al256(WS_KB + (size_t)4 * NKT * 96 * 2);
constexpr size_t WS_ZT = al256(WS_VT + (size_t)4 * NKT * 64 * 2);
constexpr size_t WS_Y1T = al256(WS_ZT + (size_t)768 * NTOK * 2);
constexpr size_t WS_OUTT = al256(WS_Y1T + (size_t)256 * NTOK * 2);
constexpr size_t WS_RTL = al256(WS_OUTT + (size_t)256 * NTOK * 2);
constexpr size_t WS_RTC = al256(WS_RTL + (size_t)2 * 2 * 256 * 4096 * 2);
constexpr size_t WS_CTR = al256(WS_RTC + (size_t)2 * 2 * 256 * 512 * 2);
constexpr size_t WS_HPART = al256(WS_CTR + 16384);
constexpr size_t WS_YS5 = al256(WS_HPART + (size_t)2 * 288 * 1024 * 4);
constexpr size_t WS_GS5 = al256(WS_YS5 + (size_t)NTOK * 256 * 4);
constexpr size_t WS_OGLA = al256(WS_GS5 + (size_t)NTOK * 256 * 2);
constexpr size_t WS_S5LOC = al256(WS_OGLA + (size_t)2 * NTOK * 256 * 4);
constexpr size_t WS_GLALOC = al256(WS_S5LOC + (size_t)2 * 8 * 16 * 2 * 128 * 4);
constexpr size_t WS_S5T = al256(WS_GLALOC + (size_t)2 * 8 * 4 * 2 * 2080 * 4);
constexpr size_t S5T_STRIDE = 9216;
constexpr size_t WS_END = al256(WS_S5T + 64 * S5T_STRIDE);
static_assert(WS_END <= ((size_t)256 << 20), "workspace");

struct P { const float* in[42]; float* out; unsigned char* ws; };

enum { I_XP = 0, I_XS, I_C, I_CCKV, I_CKR, I_SS5, I_SGLA, I_CCTX, I_NORMW, I_ADAW, I_ADAB, I_WIN, I_WOUT, I_QAN, I_KVAN, I_WUQ, I_WUKV,
       I_QN, I_KN, I_HCW, I_HCB, I_HW1, I_HB1, I_HF1, I_HW2, I_HB2, I_HF2, I_HW3, I_HBIAS, I_AR, I_AI, I_LDT, I_BR, I_BI, I_CR, I_CI,
       I_S5D, I_GLUW, I_GLUB, I_GGW, I_GGB, I_GLAN };

DI bf16_t f2bf(float x) { __bf16 b = (__bf16)x; return __builtin_bit_cast(bf16_t, b); }
DI float bf2f(bf16_t h) { return __uint_as_float(((unsigned)h) << 16); }
DI float sigmoidf_(float x) { return 1.f / (1.f + __expf(-x)); }
DI float siluf_(float x) { return x / (1.f + __expf(-x)); }
DI float gelu_tanh(float x) { float u = 0.7978845608028654f * (x + 0.044715f * x * x * x); return 0.5f * x * (1.f + tanhf(u)); }
DI int cond_of(int tok) { return tok < NCTX ? 0 : 1 + ((tok - NCTX) >> 11); }
DI const float* xrow(const P& p, int l, int tok) {
    if (l == 0) return tok < NCTX ? p.in[I_XP] + (size_t)tok * DM : p.in[I_XS] + (size_t)(tok - NCTX) * DM;
    return p.out + (size_t)tok * DM;
}
DI int get_tid() { int t = threadIdx.x; asm volatile("" : "+v"(t)); return t; }
DI bf16x8 pack8_hw(float a0, float a1, float a2, float a3, float a4, float a5, float a6, float a7) {
    typedef __bf16 bfv8 __attribute__((ext_vector_type(8)));
    typedef float fv8 __attribute__((ext_vector_type(8)));
    fv8 v = {a0, a1, a2, a3, a4, a5, a6, a7};
    return __builtin_bit_cast(bf16x8, __builtin_convertvector(v, bfv8));
}
#define MFMA16(a, b, c) __builtin_amdgcn_mfma_f32_16x16x32_bf16((a), (b), (c), 0, 0, 0)

DI void tr_item(const float* __restrict__ src, int K, int N, bf16_t* __restrict__ dst, int kt, int nt, unsigned char* smem) {
    float* tile = (float*)smem;
    const int tid = get_tid(), k0 = kt * 64, n0 = nt * 64;
#pragma unroll
    for (int i = 0; i < 16; ++i) { int e = tid + 256 * i; int kk = e >> 6, nn = e & 63; tile[kk * 65 + nn] = src[(size_t)(k0 + kk) * N + n0 + nn]; }
    __syncthreads();
#pragma unroll
    for (int i = 0; i < 16; ++i) { int e = tid + 256 * i; int nn = e >> 6, kk = e & 63; dst[(size_t)(n0 + nn) * K + k0 + kk] = f2bf(tile[kk * 65 + nn]); }
    __syncthreads();
}

DI void ada_item(const P& p, int l, int cc, unsigned char* smem) {
    float* sc = (float*)smem;
    float* red = sc + 3 * 1024;
    const int tid = get_tid();
    for (int e = tid; e < 3 * 1024; e += 256) { int cnd = e >> 10, k = e & 1023; float v = cnd == 0 ? p.in[I_CCTX][k] : p.in[I_C][(cnd - 1) * 1024 + k]; sc[e] = siluf_(v); }
    __syncthreads();
    const int cq = tid & 15, kg = tid >> 4, n0 = cc * 64;
    const float* W = p.in[I_ADAW] + (size_t)l * 1024 * 3072 + n0 + 4 * cq;
    float acc[3][4];
#pragma unroll
    for (int a = 0; a < 3; ++a)
#pragma unroll
        for (int j = 0; j < 4; ++j) acc[a][j] = 0.f;
#pragma unroll 8
    for (int kk = 0; kk < 64; ++kk) {
        int k = kg * 64 + kk;
        float4 w = *(const float4*)(W + (size_t)k * 3072);
#pragma unroll
        for (int a = 0; a < 3; ++a) { float s = sc[a * 1024 + k]; acc[a][0] += s * w.x; acc[a][1] += s * w.y; acc[a][2] += s * w.z; acc[a][3] += s * w.w; }
    }
#pragma unroll
    for (int a = 0; a < 3; ++a)
#pragma unroll
        for (int j = 0; j < 4; ++j) red[(kg * 3 + a) * 64 + 4 * cq + j] = acc[a][j];
    __syncthreads();
    if (tid < 192) {
        int a = tid >> 6, n = tid & 63; float s = 0.f;
#pragma unroll
        for (int g = 0; g < 16; ++g) s += red[(g * 3 + a) * 64 + n];
        float* MOD = (float*)(p.ws + WS_MOD);
        MOD[(l * 3 + a) * 3072 + n0 + n] = s + p.in[I_ADAB][l * 3072 + n0 + n];
    }
    __syncthreads();
}

DI void hyfilt_item(const P& p, int l, int lsel, int tile, unsigned char* smem) {
    float* feat = (float*)smem;
    float* h1 = feat + 8 * 33;
    float* h2 = h1 + 8 * 64;
    const int tid = get_tid();
    const int L = lsel ? 2048 : 256;
    const int lag0 = tile * 8;
    const float Lf = (float)L;
    for (int e = tid; e < 8 * 33; e += 256) {
        int lg = e / 33, f = e % 33; float pos = (float)(lag0 + lg);
        float v;
        if (f == 0) v = pos / Lf;
        else {
            float w = 6.283185307179586f * pos / Lf;
            int bi = (f - 1) & 15; float band = 1e-4f + (float)bi * ((15.0f - 1e-4f) / 15.0f);
            v = (f <= 16) ? cosf(w * band) : sinf(w * band);
        }
        feat[e] = v;
    }
    __syncthreads();
    for (int e = tid; e < 8 * 64; e += 256) {
        int lg = e >> 6, j = e & 63; float s = p.in[I_HB1][l * 64 + j];
        for (int f = 0; f < 33; ++f) s += feat[lg * 33 + f] * p.in[I_HW1][(l * 33 + f) * 64 + j];
        h1[e] = sinf(p.in[I_HF1][l * 64 + j] * s);
    }
    __syncthreads();
    for (int e = tid; e < 8 * 64; e += 256) {
        int lg = e >> 6, j = e & 63; float s = p.in[I_HB2][l * 64 + j];
        for (int k = 0; k < 64; ++k) s += h1[lg * 64 + k] * p.in[I_HW2][(l * 64 + k) * 64 + j];
        h2[e] = sinf(p.in[I_HF2][l * 64 + j] * s);
    }
    __syncthreads();
    float acc[8][4];
#pragma unroll
    for (int a = 0; a < 8; ++a)
#pragma unroll
        for (int j = 0; j < 4; ++j) acc[a][j] = 0.f;
    const float* W3 = p.in[I_HW3] + (size_t)l * 64 * 1024 + 4 * tid;
#pragma unroll 4
    for (int k = 0; k < 64; ++k) {
        float4 w = *(const float4*)(W3 + k * 1024);
#pragma unroll
        for (int a = 0; a < 8; ++a) { float hv = h2[a * 64 + k]; acc[a][0] += hv * w.x; acc[a][1] += hv * w.y; acc[a][2] += hv * w.z; acc[a][3] += hv * w.w; }
    }
    float* HF = (float*)(p.ws + WS_HF) + (size_t)l * HF_LAYER + (lsel ? (size_t)256 * 1024 : 0);
    const float d0 = 15.350567286626973f, d1 = 3.0701134573253946f;
    float4 ps = make_float4(0.f, 0.f, 0.f, 0.f);
#pragma unroll
    for (int a = 0; a < 8; ++a) {
        float t = (float)(lag0 + a) / Lf;
        float4 o;
        float* op = (float*)&o;
#pragma unroll
        for (int j = 0; j < 4; ++j) {
            int ch = (4 * tid + j) & 255;
            float delta = d0 + (float)ch * ((d1 - d0) / 255.0f);
            op[j] = acc[a][j] * (expf(-t * delta) + 0.05f);
        }
        *(float4*)(HF + (size_t)(lag0 + a) * 1024 + 4 * tid) = o;
        const bool cnt = !(lag0 + a == 0 && 4 * tid >= 512);
        if (cnt) { ps.x += fabsf(o.x); ps.y += fabsf(o.y); ps.z += fabsf(o.z); ps.w += fabsf(o.w); }
    }
    *(float4*)((float*)(p.ws + WS_HPART) + ((size_t)l * 288 + (lsel ? 32 : 0) + tile) * 1024 + 4 * tid) = ps;
    __syncthreads();
}

DI void hynorm_item(const P& p, int l, int lsel, int cc, unsigned char* smem) {
    float* red = (float*)smem;
    const int tid = get_tid(), c = tid & 63, lg = tid >> 6;
    const int ntile = lsel ? 256 : 32;
    const float* PT = (const float*)(p.ws + WS_HPART) + ((size_t)l * 288 + (lsel ? 32 : 0)) * 1024;
    const int col = cc * 64 + c;
    float s = 0.f;
#pragma unroll 8
    for (int t = lg; t < ntile; t += 4) s += PT[(size_t)t * 1024 + col] + PT[(size_t)t * 1024 + 512 + col];
    red[lg * 64 + c] = s;
    __syncthreads();
    if (tid < 64) {
        float t = red[tid] + red[64 + tid] + red[128 + tid] + red[192 + tid];
        ((float*)(p.ws + WS_HNORM))[(l * 2 + lsel) * 512 + col] = 1.f / t;
    }
    __syncthreads();
}

DI void normmod_item(const P& p, int l, int item) {
    const int tid_ = get_tid(); const int lane = tid_ & 63, w = tid_ >> 6;
    float4 v[6][4]; float ss[6];
#pragma unroll
    for (int j = 0; j < 6; ++j) {
        const float* x = xrow(p, l, (item * 6 + j) * 4 + w);
        ss[j] = 0.f;
#pragma unroll
        for (int i = 0; i < 4; ++i) v[j][i] = *(const float4*)(x + lane * 4 + 256 * i);
    }
#pragma unroll
    for (int j = 0; j < 6; ++j) {
#pragma unroll
        for (int i = 0; i < 4; ++i) ss[j] += v[j][i].x * v[j][i].x + v[j][i].y * v[j][i].y + v[j][i].z * v[j][i].z + v[j][i].w * v[j][i].w;
#pragma unroll
        for (int o = 1; o < 64; o <<= 1) ss[j] += __shfl_xor(ss[j], o);
    }
#pragma unroll
    for (int j = 0; j < 6; ++j) {
        const int tok = (item * 6 + j) * 4 + w;
        const float r = rsqrtf(ss[j] * (1.f / 1024.f) + 1e-6f);
        const float* MOD = (const float*)(p.ws + WS_MOD) + (l * 3 + cond_of(tok)) * 3072;
        bf16_t* HB = (bf16_t*)(p.ws + WS_HB) + (size_t)tok * 1024;
#pragma unroll
        for (int i = 0; i < 4; ++i) {
            int c = lane * 4 + 256 * i;
            float4 nw = *(const float4*)(p.in[I_NORMW] + l * 1024 + c);
            float4 sh = *(const float4*)(MOD + c), sc = *(const float4*)(MOD + 1024 + c);
            bf16x4 o;
            o[0] = (short)f2bf(v[j][i].x * r * nw.x * (1.f + sc.x) + sh.x);
            o[1] = (short)f2bf(v[j][i].y * r * nw.y * (1.f + sc.y) + sh.y);
            o[2] = (short)f2bf(v[j][i].z * r * nw.z * (1.f + sc.z) + sh.z);
            o[3] = (short)f2bf(v[j][i].w * r * nw.w * (1.f + sc.w) + sh.w);
            *(bf16x4*)(HB + c) = o;
        }
    }
}

template <class Epi>
DI void gemm_tile(const bf16_t* __restrict__ A, int lda, const bf16_t* __restrict__ Bt, int ldb, int K, int m0, int n0,
                          unsigned char* smem, Epi epi) {
    bf16_t* As = (bf16_t*)smem;
    bf16_t* Bs = As + 128 * 72;
    const int tid = get_tid(), lane = tid & 63, w = tid >> 6;
    const int wm = w & 1, wn = w >> 1, lr = lane & 15, quad = lane >> 4;
    f32x4 acc[4][4];
#pragma unroll
    for (int a = 0; a < 4; ++a)
#pragma unroll
        for (int b = 0; b < 4; ++b) acc[a][b] = (f32x4){0.f, 0.f, 0.f, 0.f};
    u32x4 ra[4], rb[4], ra2[4], rb2[4];
    const bf16_t* Ag = A + (size_t)(m0 + (tid >> 3)) * lda + (tid & 7) * 8;
    const bf16_t* Bg = Bt + (size_t)(n0 + (tid >> 3)) * ldb + (tid & 7) * 8;
#pragma unroll
    for (int i = 0; i < 4; ++i) { ra[i] = *(const u32x4*)(Ag + (size_t)(32 * i) * lda); rb[i] = *(const u32x4*)(Bg + (size_t)(32 * i) * ldb); }
#pragma unroll
    for (int i = 0; i < 4; ++i) { ra2[i] = *(const u32x4*)(Ag + (size_t)(32 * i) * lda + 64); rb2[i] = *(const u32x4*)(Bg + (size_t)(32 * i) * ldb + 64); }
#define GEMM_STEP(RA, RB, KNEXT)                                                                                   \
    {                                                                                                                \
        _Pragma("unroll") for (int i = 0; i < 4; ++i) {                                                              \
            *(u32x4*)(As + ((tid >> 3) + 32 * i) * 72 + (tid & 7) * 8) = RA[i];                                      \
            *(u32x4*)(Bs + ((tid >> 3) + 32 * i) * 72 + (tid & 7) * 8) = RB[i];                                      \
        }                                                                                                            \
        __syncthreads();                                                                                             \
        if ((KNEXT) < K) {                                                                                           \
            _Pragma("unroll") for (int i = 0; i < 4; ++i) {                                                          \
                RA[i] = *(const u32x4*)(Ag + (size_t)(32 * i) * lda + (KNEXT));                                      \
                RB[i] = *(const u32x4*)(Bg + (size_t)(32 * i) * ldb + (KNEXT));                                      \
            }                                                                                                        \
        }                                                                                                            \
        _Pragma("unroll") for (int ks = 0; ks < 2; ++ks) {                                                           \
            bf16x8 af[4], bfr[4];                                                                                    \
            _Pragma("unroll") for (int t = 0; t < 4; ++t) {                                                          \
                af[t] = *(const bf16x8*)(As + (wm * 64 + t * 16 + lr) * 72 + ks * 32 + quad * 8);                    \
                bfr[t] = *(const bf16x8*)(Bs + (wn * 64 + t * 16 + lr) * 72 + ks * 32 + quad * 8);                   \
            }                                                                                                        \
            _Pragma("unroll") for (int nt = 0; nt < 4; ++nt)                                                         \
                _Pragma("unroll") for (int mt = 0; mt < 4; ++mt) acc[nt][mt] = MFMA16(bfr[nt], af[mt], acc[nt][mt]); \
        }                                                                                                            \
        __syncthreads();                                                                                             \
    }
    for (int k0 = 0; k0 < K; k0 += 128) {
        GEMM_STEP(ra, rb, k0 + 128)
        GEMM_STEP(ra2, rb2, k0 + 192)
    }
#undef GEMM_STEP
    if constexpr (Epi::kPre) {
        f32x4 xs[4][4], gs[4];
#pragma unroll
        for (int nt = 0; nt < 4; ++nt) {
            gs[nt] = epi.gate(m0, n0 + wn * 64 + nt * 16 + quad * 4);
#pragma unroll
            for (int mt = 0; mt < 4; ++mt) xs[nt][mt] = epi.load(m0 + wm * 64 + mt * 16 + lr, n0 + wn * 64 + nt * 16 + quad * 4);
        }
#pragma unroll
        for (int nt = 0; nt < 4; ++nt)
#pragma unroll
            for (int mt = 0; mt < 4; ++mt) epi.store(m0 + wm * 64 + mt * 16 + lr, n0 + wn * 64 + nt * 16 + quad * 4, acc[nt][mt], xs[nt][mt], gs[nt]);
    } else {
#pragma unroll
        for (int nt = 0; nt < 4; ++nt)
#pragma unroll
            for (int mt = 0; mt < 4; ++mt) epi(m0 + wm * 64 + mt * 16 + lr, n0 + wn * 64 + nt * 16 + quad * 4, acc[nt][mt]);
    }
}

struct EpiProj {
    static constexpr bool kPre = false;
    bf16_t* out; bf16_t* zt;
    DI void operator()(int row, int col, f32x4 v) const {
        bf16x4 o; o[0] = (short)f2bf(v[0]); o[1] = (short)f2bf(v[1]); o[2] = (short)f2bf(v[2]); o[3] = (short)f2bf(v[3]);
        if (col >= C_HY && col < C_HY + 768) {
#pragma unroll
            for (int j = 0; j < 4; ++j) zt[(size_t)(col - C_HY + j) * NTOK + row] = (bf16_t)o[j];
        } else *(bf16x4*)(out + (size_t)row * NIN + col) = o;
    }
};
struct EpiOut {
    static constexpr bool kPre = true;
    const P* p; int l;
    DI f32x4 gate(int m0, int col) const { return *(const f32x4*)((const float*)(p->ws + WS_MOD) + (l * 3 + cond_of(m0)) * 3072 + 2048 + col); }
    DI f32x4 load(int row, int col) const { return *(const f32x4*)(xrow(*p, l, row) + col); }
    DI void store(int row, int col, f32x4 v, f32x4 x, f32x4 g) const { *(f32x4*)(p->out + (size_t)row * DM + col) = x + g * v; }
    DI void operator()(int row, int col, f32x4 v) const { store(row, col, v, load(row, col), gate(row, col)); }
};
struct EpiGlu {
    static constexpr bool kPre = true;
    const P* p; int l;
    DI f32x4 gate(int m0, int col) const { return *(const f32x4*)(p->in[I_GLUB] + l * 256 + col); }
    DI f32x4 load(int row, int col) const {
        const bf16x4 gg = *(const bf16x4*)((const bf16_t*)(p->ws + WS_GS5) + (size_t)row * 256 + col);
        const bf16x4 gs = *(const bf16x4*)((const bf16_t*)(p->ws + WS_PROJ) + (size_t)row * NIN + C_GS5 + col);
        return __builtin_bit_cast(f32x4, __builtin_shufflevector(gg, gs, 0, 1, 2, 3, 4, 5, 6, 7));
    }
    DI void store(int row, int col, f32x4 v, f32x4 x, f32x4 b) const {
        const bf16x8 pk = __builtin_bit_cast(bf16x8, x);
        bf16x4 o;
#pragma unroll
        for (int j = 0; j < 4; ++j) { float g = bf2f((bf16_t)pk[j]); o[j] = (short)f2bf(g * sigmoidf_(v[j] + b[j]) * siluf_(bf2f((bf16_t)pk[4 + j]))); }
        *(bf16x4*)((bf16_t*)(p->ws + WS_HB) + (size_t)row * 1024 + 512 + col) = o;
    }
    DI void operator()(int row, int col, f32x4 v) const { store(row, col, v, load(row, col), gate(row, col)); }
};

DI void mlaprep_item(const P& p, int l, int item, unsigned char* smem) {
    bf16_t* Aq = (bf16_t*)smem;
    bf16_t* Akv = Aq + 32 * 200;
    float* R = (float*)(Akv + 32 * 136);
    float* kr = R + 32 * 132;
    float* kn = kr + 32 * 32;
    float* cst = kn + 32 * 32;
    float* snt = cst + 32 * 16;
    const int tid = get_tid(), lane = tid & 63, w = tid >> 6, lr = lane & 15, quad = lane >> 4;
    const bool is_cache = item >= 384;
    int tok0 = 0, cb = 0, r0 = 0;
    if (!is_cache) tok0 = item * 32; else { cb = (item - 384) >> 4; r0 = ((item - 384) & 15) * 32; }
    const bool is_lat = !is_cache && tok0 >= NCTX;
    const bool do_rope = is_lat;
    int kbase, nkeys, kin0;
    if (is_cache) { kbase = 8192 + 2560 * cb; nkeys = 2560; kin0 = r0; }
    else if (is_lat) { int b = (tok0 - NCTX) >> 11; kbase = 8192 + 2560 * b; nkeys = 2560; kin0 = 512 + ((tok0 - NCTX) & 2047); }
    else { kbase = tok0 & ~255; nkeys = 256; kin0 = tok0 & 255; }
    const bf16_t* PR = (const bf16_t*)(p.ws + WS_PROJ);
    {
        const int t = tid >> 3, part = tid & 7;
        if (!is_cache) {
            const bf16_t* row = PR + (size_t)(tok0 + t) * NIN;
            const int tok = tok0 + t;
            {
                bf16x8 q[3];
#pragma unroll
                for (int c = 0; c < 3; ++c) q[c] = *(const bf16x8*)(row + C_CQ + part * 24 + 8 * c);
                float ss = 0.f;
#pragma unroll
                for (int c = 0; c < 3; ++c)
#pragma unroll
                    for (int j = 0; j < 8; ++j) { float x = bf2f((bf16_t)q[c][j]); ss += x * x; }
                ss += __shfl_xor(ss, 1); ss += __shfl_xor(ss, 2); ss += __shfl_xor(ss, 4);
                const float rq = rsqrtf(ss * (1.f / 192.f) + 1e-6f);
                const float4* wq4 = (const float4*)(p.in[I_QAN] + l * 192 + part * 24);
#pragma unroll
                for (int c = 0; c < 3; ++c) {
                    float4 w0 = wq4[2 * c], w1 = wq4[2 * c + 1];
                    bf16x8 o;
                    o[0] = (short)f2bf(bf2f((bf16_t)q[c][0]) * rq * w0.x); o[1] = (short)f2bf(bf2f((bf16_t)q[c][1]) * rq * w0.y);
                    o[2] = (short)f2bf(bf2f((bf16_t)q[c][2]) * rq * w0.z); o[3] = (short)f2bf(bf2f((bf16_t)q[c][3]) * rq * w0.w);
                    o[4] = (short)f2bf(bf2f((bf16_t)q[c][4]) * rq * w1.x); o[5] = (short)f2bf(bf2f((bf16_t)q[c][5]) * rq * w1.y);
                    o[6] = (short)f2bf(bf2f((bf16_t)q[c][6]) * rq * w1.z); o[7] = (short)f2bf(bf2f((bf16_t)q[c][7]) * rq * w1.w);
                    *(bf16x8*)(Aq + t * 200 + part * 24 + 8 * c) = o;
                }
            }
            {
                bf16x8 k[2];
#pragma unroll
                for (int c = 0; c < 2; ++c) k[c] = *(const bf16x8*)(row + C_CKV + part * 16 + 8 * c);
                float ss = 0.f;
#pragma unroll
                for (int c = 0; c < 2; ++c)
#pragma unroll
                    for (int j = 0; j < 8; ++j) { float x = bf2f((bf16_t)k[c][j]); ss += x * x; }
                ss += __shfl_xor(ss, 1); ss += __shfl_xor(ss, 2); ss += __shfl_xor(ss, 4);
                const float rk = rsqrtf(ss * (1.f / 128.f) + 1e-6f);
                const float4* wk4 = (const float4*)(p.in[I_KVAN] + l * 128 + part * 16);
                float* oc = p.out + OFF_CKV + ((size_t)((tok >> 8) * 2 + l) * 256 + (tok & 255)) * 128 + part * 16;
#pragma unroll
                for (int c = 0; c < 2; ++c) {
                    float4 w0 = wk4[2 * c], w1 = wk4[2 * c + 1];
                    float4 v0, v1;
                    v0.x = bf2f((bf16_t)k[c][0]) * rk * w0.x; v0.y = bf2f((bf16_t)k[c][1]) * rk * w0.y;
                    v0.z = bf2f((bf16_t)k[c][2]) * rk * w0.z; v0.w = bf2f((bf16_t)k[c][3]) * rk * w0.w;
                    v1.x = bf2f((bf16_t)k[c][4]) * rk * w1.x; v1.y = bf2f((bf16_t)k[c][5]) * rk * w1.y;
                    v1.z = bf2f((bf16_t)k[c][6]) * rk * w1.z; v1.w = bf2f((bf16_t)k[c][7]) * rk * w1.w;
                    bf16x8 o;
                    o[0] = (short)f2bf(v0.x); o[1] = (short)f2bf(v0.y); o[2] = (short)f2bf(v0.z); o[3] = (short)f2bf(v0.w);
                    o[4] = (short)f2bf(v1.x); o[5] = (short)f2bf(v1.y); o[6] = (short)f2bf(v1.z); o[7] = (short)f2bf(v1.w);
                    *(bf16x8*)(Akv + t * 136 + part * 16 + 8 * c) = o;
                    if (!is_lat) { *(float4*)(oc + 8 * c) = v0; *(float4*)(oc + 8 * c + 4) = v1; }
                }
            }
            {
                bf16x4 r4 = *(const bf16x4*)(row + C_KR + part * 4);
                float4 v = make_float4(bf2f((bf16_t)r4[0]), bf2f((bf16_t)r4[1]), bf2f((bf16_t)r4[2]), bf2f((bf16_t)r4[3]));
                *(float4*)(kr + t * 32 + part * 4) = v;
                if (!is_lat) *(float4*)(p.out + OFF_KR + ((size_t)((tok >> 8) * 2 + l) * 256 + (tok & 255)) * 32 + part * 4) = v;
            }
        } else {
            const float4* ck = (const float4*)(p.in[I_CCKV] + ((size_t)(cb * 2 + l) * 512 + r0 + t) * 128 + part * 16);
            const float4* ckr = (const float4*)(p.in[I_CKR] + ((size_t)(cb * 2 + l) * 512 + r0 + t) * 32 + part * 4);
#pragma unroll
            for (int c = 0; c < 2; ++c) {
                float4 v0 = ck[2 * c], v1 = ck[2 * c + 1];
                bf16x8 o;
                o[0] = (short)f2bf(v0.x); o[1] = (short)f2bf(v0.y); o[2] = (short)f2bf(v0.z); o[3] = (short)f2bf(v0.w);
                o[4] = (short)f2bf(v1.x); o[5] = (short)f2bf(v1.y); o[6] = (short)f2bf(v1.z); o[7] = (short)f2bf(v1.w);
                *(bf16x8*)(Akv + t * 136 + part * 16 + 8 * c) = o;
            }
            *(float4*)(kr + t * 32 + part * 4) = ckr[0];
        }
        if (do_rope) {
            for (int e = tid; e < 32 * 16; e += 256) {
                int tt = e >> 4, a = e & 15; int pos = (tok0 - NCTX + tt) & 2047;
                float pp = (a < 8) ? (float)(pos >> 6) : (float)(pos & 63);
                float inv = powf(10000.f, -(float)(a & 7) * 0.125f);
                float ang = pp * inv;
                cst[e] = cosf(ang); snt[e] = sinf(ang);
            }
        }
    }
    __syncthreads();
    const int mt = w & 1, nh = w >> 1;
    const float qscale = 0.10206207261596577f * 1.4426950408889634f;
    for (int h = 0; h < 4; ++h) {
        if (!is_cache) {
            f32x4 acc[3];
#pragma unroll
            for (int i = 0; i < 3; ++i) acc[i] = (f32x4){0.f, 0.f, 0.f, 0.f};
            const bf16_t* W = (const bf16_t*)(p.ws + WS_WTUQ) + (size_t)l * 384 * 192 + (size_t)(96 * h + 48 * nh + lr) * 192 + quad * 8;
#pragma unroll
            for (int ks = 0; ks < 6; ++ks) {
                bf16x8 xf = *(const bf16x8*)(Aq + (16 * mt + lr) * 200 + 32 * ks + quad * 8);
#pragma unroll
                for (int i = 0; i < 3; ++i) { bf16x8 wf = *(const bf16x8*)(W + (size_t)(16 * i) * 192 + 32 * ks); acc[i] = MFMA16(wf, xf, acc[i]); }
            }
#pragma unroll
            for (int i = 0; i < 3; ++i) *(f32x4*)(R + (16 * mt + lr) * 132 + 48 * nh + 16 * i + quad * 4) = acc[i];
            __syncthreads();
            {
                const int t = tid >> 3, part = tid & 7;
                float4* rp = (float4*)(R + t * 132 + part * 12);
                float4 x0 = rp[0], x1 = rp[1], x2 = rp[2];
                float ss = x0.x * x0.x + x0.y * x0.y + x0.z * x0.z + x0.w * x0.w + x1.x * x1.x + x1.y * x1.y + x1.z * x1.z + x1.w * x1.w
                         + x2.x * x2.x + x2.y * x2.y + x2.z * x2.z + x2.w * x2.w;
                ss += __shfl_xor(ss, 1); ss += __shfl_xor(ss, 2); ss += __shfl_xor(ss, 4);
                float r = rsqrtf(ss * (1.f / 96.f) + 1e-6f);
                const float4* wn = (const float4*)(p.in[I_QN] + l * 96 + part * 12);
                float4 w0 = wn[0], w1 = wn[1], w2 = wn[2];
                rp[0] = make_float4(x0.x * r * w0.x, x0.y * r * w0.y, x0.z * r * w0.z, x0.w * r * w0.w);
                rp[1] = make_float4(x1.x * r * w1.x, x1.y * r * w1.y, x1.z * r * w1.z, x1.w * r * w1.w);
                rp[2] = make_float4(x2.x * r * w2.x, x2.y * r * w2.y, x2.z * r * w2.z, x2.w * r * w2.w);
            }
            __syncthreads();
            {
                const int t = tid >> 3, part = tid & 7;
                bf16_t* Qo = (bf16_t*)(p.ws + WS_QB) + ((size_t)h * NTOK + tok0 + t) * 96;
                bf16_t qv[12];
#pragma unroll
                for (int j = 0; j < 12; ++j) {
                    int n = part * 12 + j; float v;
                    if (n < 64 || !do_rope) v = R[t * 132 + n];
                    else {
                        int i = (n - 64) & 7, half = ((n - 64) >> 3) & 1, ax = (n - 64) >> 4;
                        float x1 = R[t * 132 + 64 + 16 * ax + i], x2 = R[t * 132 + 64 + 16 * ax + 8 + i];
                        float c = cst[t * 16 + ax * 8 + i], s = snt[t * 16 + ax * 8 + i];
                        v = half == 0 ? x1 * c - x2 * s : x2 * c + x1 * s;
                    }
                    qv[j] = f2bf(v * qscale);
                }
#pragma unroll
                for (int c = 0; c < 3; ++c) { bf16x4 o; o[0] = (short)qv[4 * c]; o[1] = (short)qv[4 * c + 1]; o[2] = (short)qv[4 * c + 2]; o[3] = (short)qv[4 * c + 3]; *(bf16x4*)(Qo + part * 12 + 4 * c) = o; }
            }
            __syncthreads();
        }
        {
            f32x4 acc[4];
#pragma unroll
            for (int i = 0; i < 4; ++i) acc[i] = (f32x4){0.f, 0.f, 0.f, 0.f};
            const bf16_t* W = (const bf16_t*)(p.ws + WS_WTUKV) + (size_t)l * 512 * 128 + (size_t)(128 * h + 64 * nh + lr) * 128 + quad * 8;
#pragma unroll
            for (int ks = 0; ks < 4; ++ks) {
                bf16x8 xf = *(const bf16x8*)(Akv + (16 * mt + lr) * 136 + 32 * ks + quad * 8);
#pragma unroll
                for (int i = 0; i < 4; ++i) { bf16x8 wf = *(const bf16x8*)(W + (size_t)(16 * i) * 128 + 32 * ks); acc[i] = MFMA16(wf, xf, acc[i]); }
            }
#pragma unroll
            for (int i = 0; i < 4; ++i) *(f32x4*)(R + (16 * mt + lr) * 132 + 64 * nh + 16 * i + quad * 4) = acc[i];
        }
        __syncthreads();
        {
            const int t = tid >> 3, part = tid & 7;
            float4* rp = (float4*)(R + t * 132 + part * 8);
            float4 x0 = rp[0], x1 = rp[1], x2 = *(const float4*)(kr + t * 32 + part * 4);
            float ss = x0.x * x0.x + x0.y * x0.y + x0.z * x0.z + x0.w * x0.w + x1.x * x1.x + x1.y * x1.y + x1.z * x1.z + x1.w * x1.w
                     + x2.x * x2.x + x2.y * x2.y + x2.z * x2.z + x2.w * x2.w;
            ss += __shfl_xor(ss, 1); ss += __shfl_xor(ss, 2); ss += __shfl_xor(ss, 4);
            float r = rsqrtf(ss * (1.f / 96.f) + 1e-6f);
            const float4* wn = (const float4*)(p.in[I_KN] + l * 96 + part * 8);
            float4 w0 = wn[0], w1 = wn[1], w2 = *(const float4*)(p.in[I_KN] + l * 96 + 64 + part * 4);
            rp[0] = make_float4(x0.x * r * w0.x, x0.y * r * w0.y, x0.z * r * w0.z, x0.w * r * w0.w);
            rp[1] = make_float4(x1.x * r * w1.x, x1.y * r * w1.y, x1.z * r * w1.z, x1.w * r * w1.w);
            *(float4*)(kn + t * 32 + part * 4) = make_float4(x2.x * r * w2.x, x2.y * r * w2.y, x2.z * r * w2.z, x2.w * r * w2.w);
        }
        __syncthreads();
        {
            const int t = tid >> 3, part = tid & 7;
            bf16_t* Ko = (bf16_t*)(p.ws + WS_KB) + ((size_t)h * NKT + kbase + kin0 + t) * 96;
            bf16_t kv[12];
#pragma unroll
            for (int j = 0; j < 12; ++j) {
                int n = part * 12 + j; float v;
                if (n < 64) v = R[t * 132 + n];
                else if (!do_rope) v = kn[t * 32 + n - 64];
                else {
                    int i = (n - 64) & 7, half = ((n - 64) >> 3) & 1, ax = (n - 64) >> 4;
                    float x1 = kn[t * 32 + 16 * ax + i], x2 = kn[t * 32 + 16 * ax + 8 + i];
                    float c = cst[t * 16 + ax * 8 + i], s = snt[t * 16 + ax * 8 + i];
                    v = half == 0 ? x1 * c - x2 * s : x2 * c + x1 * s;
                }
                kv[j] = f2bf(v);
            }
#pragma unroll
            for (int c = 0; c < 3; ++c) { bf16x4 o; o[0] = (short)kv[4 * c]; o[1] = (short)kv[4 * c + 1]; o[2] = (short)kv[4 * c + 2]; o[3] = (short)kv[4 * c + 3]; *(bf16x4*)(Ko + part * 12 + 4 * c) = o; }
            const int dv = tid & 63, tg = tid >> 6;
            bf16x8 o;
#pragma unroll
            for (int j = 0; j < 8; ++j) o[j] = (short)f2bf(R[(tg * 8 + j) * 132 + 64 + dv]);
            bf16_t* Vo = (bf16_t*)(p.ws + WS_VT) + ((size_t)h * NKT + kbase) * 64 + (size_t)dv * nkeys + kin0 + tg * 8;
            *(bf16x8*)Vo = o;
        }
        __syncthreads();
    }
}

DI void attn_item(const P& p, int l, int item, unsigned char* smem) {
    bf16_t* Ks = (bf16_t*)smem;
    bf16_t* Vs = Ks + 64 * 104;
    const int tid = get_tid(), lane = tid & 63, w = tid >> 6, lr = lane & 15, quad = lane >> 4;
    int seq, h, qb;
    if (item < 128) { seq = 32 + (item >> 6); h = (item >> 4) & 3; qb = item & 15; }
    else { int j = item - 128; seq = j >> 3; h = (j >> 1) & 3; qb = j & 1; }
    int tokbase, nkeys, kbase;
    if (seq < 32) { tokbase = 256 * seq; nkeys = 256; kbase = 256 * seq; }
    else { tokbase = NCTX + 2048 * (seq - 32); nkeys = 2560; kbase = 8192 + 2560 * (seq - 32); }
    const bf16_t* Qp = (const bf16_t*)(p.ws + WS_QB) + ((size_t)h * NTOK + tokbase + qb * 128 + 32 * w) * 96;
    const bf16_t* Kp = (const bf16_t*)(p.ws + WS_KB) + ((size_t)h * NKT + kbase) * 96;
    const bf16_t* Vp = (const bf16_t*)(p.ws + WS_VT) + ((size_t)h * NKT + kbase) * 64;
    bf16x8 qf[2][3];
#pragma unroll
    for (int nt = 0; nt < 2; ++nt)
#pragma unroll
        for (int ks = 0; ks < 3; ++ks) qf[nt][ks] = *(const bf16x8*)(Qp + (16 * nt + lr) * 96 + 32 * ks + 8 * quad);
    f32x4 o[4][2];
#pragma unroll
    for (int a = 0; a < 4; ++a)
#pragma unroll
        for (int b = 0; b < 2; ++b) o[a][b] = (f32x4){0.f, 0.f, 0.f, 0.f};
    float mrow[2] = {-1e30f, -1e30f}, lsum[2] = {0.f, 0.f};
    u32x4 rk[3], rv[2];
    const int ntile = nkeys >> 6;
#pragma unroll
    for (int i = 0; i < 3; ++i) { int c = tid + 256 * i; rk[i] = *(const u32x4*)(Kp + (size_t)(c / 12) * 96 + (c % 12) * 8); }
#pragma unroll
    for (int i = 0; i < 2; ++i) { int c = tid + 256 * i; rv[i] = *(const u32x4*)(Vp + (size_t)(c >> 3) * nkeys + (c & 7) * 8); }
    for (int kt = 0; kt < ntile; ++kt) {
#pragma unroll
        for (int i = 0; i < 3; ++i) { int c = tid + 256 * i; *(u32x4*)(Ks + (c / 12) * 104 + (c % 12) * 8) = rk[i]; }
#pragma unroll
        for (int i = 0; i < 2; ++i) { int c = tid + 256 * i; *(u32x4*)(Vs + (c >> 3) * 72 + (c & 7) * 8) = rv[i]; }
        __syncthreads();
        if (kt + 1 < ntile) {
#pragma unroll
            for (int i = 0; i < 3; ++i) { int c = tid + 256 * i; rk[i] = *(const u32x4*)(Kp + (size_t)((kt + 1) * 64 + c / 12) * 96 + (c % 12) * 8); }
#pragma unroll
            for (int i = 0; i < 2; ++i) { int c = tid + 256 * i; rv[i] = *(const u32x4*)(Vp + (size_t)(c >> 3) * nkeys + (kt + 1) * 64 + (c & 7) * 8); }
        }
        f32x4 s[4][2];
#pragma unroll
        for (int a = 0; a < 4; ++a)
#pragma unroll
            for (int b = 0; b < 2; ++b) s[a][b] = (f32x4){0.f, 0.f, 0.f, 0.f};
#pragma unroll
        for (int ks = 0; ks < 3; ++ks)
#pragma unroll
            for (int mt = 0; mt < 4; ++mt) {
                bf16x8 kf = *(const bf16x8*)(Ks + (16 * mt + lr) * 104 + 32 * ks + 8 * quad);
#pragma unroll
                for (int nt = 0; nt < 2; ++nt) s[mt][nt] = MFMA16(kf, qf[nt][ks], s[mt][nt]);
            }
        bf16x8 pf[2][2];
#pragma unroll
        for (int nt = 0; nt < 2; ++nt) {
            float mx = -1e30f;
#pragma unroll
            for (int mt = 0; mt < 4; ++mt)
#pragma unroll
                for (int j = 0; j < 4; ++j) mx = fmaxf(mx, s[mt][nt][j]);
            mx = fmaxf(mx, __shfl_xor(mx, 16)); mx = fmaxf(mx, __shfl_xor(mx, 32));
            float mnew = fmaxf(mrow[nt], mx);
            float alpha = __builtin_amdgcn_exp2f(mrow[nt] - mnew);
            mrow[nt] = mnew;
            float rs = 0.f;
#pragma unroll
            for (int mt = 0; mt < 4; ++mt)
#pragma unroll
                for (int j = 0; j < 4; ++j) { float pv = __builtin_amdgcn_exp2f(s[mt][nt][j] - mnew); s[mt][nt][j] = pv; rs += pv; }
            lsum[nt] = lsum[nt] * alpha + rs;
#pragma unroll
            for (int dt = 0; dt < 4; ++dt) { o[dt][nt][0] *= alpha; o[dt][nt][1] *= alpha; o[dt][nt][2] *= alpha; o[dt][nt][3] *= alpha; }
#pragma unroll
            for (int kk = 0; kk < 2; ++kk)
                pf[kk][nt] = pack8_hw(s[2 * kk][nt][0], s[2 * kk][nt][1], s[2 * kk][nt][2], s[2 * kk][nt][3],
                                      s[2 * kk + 1][nt][0], s[2 * kk + 1][nt][1], s[2 * kk + 1][nt][2], s[2 * kk + 1][nt][3]);
        }
#pragma unroll
        for (int kk = 0; kk < 2; ++kk)
#pragma unroll
            for (int dt = 0; dt < 4; ++dt) {
                bf16x4 lo = *(const bf16x4*)(Vs + (16 * dt + lr) * 72 + 32 * kk + 4 * quad);
                bf16x4 hi = *(const bf16x4*)(Vs + (16 * dt + lr) * 72 + 32 * kk + 16 + 4 * quad);
                bf16x8 vf = __builtin_shufflevector(lo, hi, 0, 1, 2, 3, 4, 5, 6, 7);
#pragma unroll
                for (int nt = 0; nt < 2; ++nt) o[dt][nt] = MFMA16(vf, pf[kk][nt], o[dt][nt]);
            }
        __syncthreads();
    }
    const bf16_t* PR = (const bf16_t*)(p.ws + WS_PROJ);
    bf16_t* HB = (bf16_t*)(p.ws + WS_HB);
    bf16x4 gpre[2][4];
#pragma unroll
    for (int nt = 0; nt < 2; ++nt)
#pragma unroll
        for (int dt = 0; dt < 4; ++dt)
            gpre[nt][dt] = *(const bf16x4*)(PR + (size_t)(tokbase + qb * 128 + 32 * w + 16 * nt + lr) * NIN + C_GMLA + h * 64 + 16 * dt + 4 * quad);
#pragma unroll
    for (int nt = 0; nt < 2; ++nt) {
        float lt = lsum[nt]; lt += __shfl_xor(lt, 16); lt += __shfl_xor(lt, 32);
        float inv = 1.f / lt;
        int tok = tokbase + qb * 128 + 32 * w + 16 * nt + lr;
#pragma unroll
        for (int dt = 0; dt < 4; ++dt) {
            int col = h * 64 + 16 * dt + 4 * quad;
            bf16x4 g = gpre[nt][dt];
            bf16x4 ov;
#pragma unroll
            for (int j = 0; j < 4; ++j) ov[j] = (short)f2bf(o[dt][nt][j] * inv * siluf_(bf2f((bf16_t)g[j])));
            *(bf16x4*)(HB + (size_t)tok * 1024 + col) = ov;
        }
    }
}

DI void rt_item(const P& p, int item, unsigned char* smem) {
    float* tile = (float*)smem;
    const int tid = get_tid();
    int l = item / 576, r = item % 576;
    int order = r / 288; r %= 288;
    int cht = r / 72, xt = r % 72;
    const int lsel = xt >= 8 ? 1 : 0; if (lsel) xt -= 8;
    const int L = lsel ? 2048 : 256, x0 = xt * 64, ch0 = cht * 64;
    const float* HF = (const float*)(p.ws + WS_HF) + (size_t)l * HF_LAYER + (lsel ? (size_t)256 * 1024 : 0) + order * 256 + ch0;
    const float* HN = (const float*)(p.ws + WS_HNORM) + (l * 2 + lsel) * 512 + order * 256 + ch0;
#pragma unroll
    for (int i = 0; i < 16; ++i) {
        int e = tid + 256 * i; int xx = e >> 6, cc = e & 63;
        int d = L - 1 - (x0 + xx);
        float v = 0.f;
        if (d >= 0) v = HF[(size_t)d * 1024 + cc]; else if (d > -L) v = HF[(size_t)(-d) * 1024 + 512 + cc];
        tile[xx * 65 + cc] = v * HN[cc];
    }
    __syncthreads();
    bf16_t* RT = lsel ? (bf16_t*)(p.ws + WS_RTL) + ((size_t)(l * 2 + order) * 256 + ch0) * 4096 : (bf16_t*)(p.ws + WS_RTC) + ((size_t)(l * 2 + order) * 256 + ch0) * 512;
    const int XL = 2 * L;
#pragma unroll
    for (int i = 0; i < 16; ++i) { int e = tid + 256 * i; int cc = e >> 6, xx = e & 63; RT[(size_t)cc * XL + x0 + xx] = f2bf(tile[xx * 65 + cc]); }
    __syncthreads();
}

DI void hy_short4(const P& p, int l, int ch768, int tokseq0, int L, int t, float* o) {
    const bf16_t* Z = (const bf16_t*)(p.ws + WS_ZT) + (size_t)ch768 * NTOK + tokseq0 + t;
    const float* cw = p.in[I_HCW] + l * 3 * 768 + ch768;
    const float w0 = cw[0], w1 = cw[768], w2 = cw[1536], bb = p.in[I_HCB][l * 768 + ch768];
    bf16x4 m = *(const bf16x4*)Z;
    const float zm = t > 0 ? bf2f(Z[-1]) : 0.f;
    const float z0 = bf2f((bf16_t)m[0]), z1 = bf2f((bf16_t)m[1]), z2 = bf2f((bf16_t)m[2]), z3 = bf2f((bf16_t)m[3]);
    const float zp = t + 4 < L ? bf2f(Z[4]) : 0.f;
    o[0] = bb + w0 * zm + w1 * z0 + w2 * z1;
    o[1] = bb + w0 * z0 + w1 * z1 + w2 * z2;
    o[2] = bb + w0 * z1 + w1 * z2 + w2 * z3;
    o[3] = bb + w0 * z2 + w1 * z3 + w2 * zp;
}
DI bf16x8 hy_short8(const P& p, int l, int ch768, int tokseq0, int L, int t) {
    const bf16_t* Z = (const bf16_t*)(p.ws + WS_ZT) + (size_t)ch768 * NTOK + tokseq0 + t;
    const float* cw = p.in[I_HCW] + l * 3 * 768 + ch768;
    const float w0 = cw[0], w1 = cw[768], w2 = cw[1536], bb = p.in[I_HCB][l * 768 + ch768];
    bf16x8 m = *(const bf16x8*)Z;
    const float zm = t > 0 ? bf2f(Z[-1]) : 0.f;
    const float z0 = bf2f((bf16_t)m[0]), z1 = bf2f((bf16_t)m[1]), z2 = bf2f((bf16_t)m[2]), z3 = bf2f((bf16_t)m[3]);
    const float z4 = bf2f((bf16_t)m[4]), z5 = bf2f((bf16_t)m[5]), z6 = bf2f((bf16_t)m[6]), z7 = bf2f((bf16_t)m[7]);
    const float zp = t + 8 < L ? bf2f(Z[8]) : 0.f;
    bf16x8 o;
    o[0] = (short)f2bf(bb + w0 * zm + w1 * z0 + w2 * z1);
    o[1] = (short)f2bf(bb + w0 * z0 + w1 * z1 + w2 * z2);
    o[2] = (short)f2bf(bb + w0 * z1 + w1 * z2 + w2 * z3);
    o[3] = (short)f2bf(bb + w0 * z2 + w1 * z3 + w2 * z4);
    o[4] = (short)f2bf(bb + w0 * z3 + w1 * z4 + w2 * z5);
    o[5] = (short)f2bf(bb + w0 * z4 + w1 * z5 + w2 * z6);
    o[6] = (short)f2bf(bb + w0 * z5 + w1 * z6 + w2 * z7);
    o[7] = (short)f2bf(bb + w0 * z6 + w1 * z7 + w2 * zp);
    return o;
}

DI void hy2_item(const P& p, int l, int which, int item, unsigned char* smem) {
    const int tid = get_tid(), lane = tid & 63, w = tid >> 6, lr = lane & 15, quad = lane >> 4;
    const bool lat = item < 256;
    const int c = lat ? item : item - 256;
    const int XL = lat ? 4096 : 512;
    unsigned* c0 = (unsigned*)smem;
    unsigned* c1 = c0 + 2048 + 16;
    bf16_t* U = (bf16_t*)(c1 + 2048 + 16);
    const bf16_t* RT = lat ? (const bf16_t*)(p.ws + WS_RTL) + ((size_t)(l * 2 + which) * 256 + c) * 4096
                           : (const bf16_t*)(p.ws + WS_RTC) + ((size_t)(l * 2 + which) * 256 + c) * 512;
    const bf16_t* Y1T = (const bf16_t*)(p.ws + WS_Y1T) + (size_t)c * NTOK;
    for (int i = tid; i < XL / 8; i += 256) *(u32x4*)(c0 + 4 * i) = *(const u32x4*)(RT + 8 * i);
    if (lat) {
        for (int i = tid; i < 2 * 64 * 72 / 8; i += 256) *(u32x4*)(U + 8 * i) = (u32x4){0u, 0u, 0u, 0u};
    }
    __syncthreads();
    for (int i = tid; i < XL / 2; i += 256) { unsigned lo = c0[i], hi = (i + 1 < XL / 2) ? c0[i + 1] : 0u; c1[i] = (lo >> 16) | (hi << 16); }
    if (lat) {
        for (int i = tid; i < 512; i += 256) {
            int b = i >> 8, t = (i & 255) * 8;
            bf16x8 v = which == 0 ? hy_short8(p, l, c, NCTX + 2048 * b, 2048, t) : *(const bf16x8*)(Y1T + NCTX + 2048 * b + t);
            *(bf16x8*)(U + (size_t)(b * 64 + 16 + (t >> 6)) * 72 + (t & 63)) = v;
        }
    } else {
        for (int i = tid; i < 1024; i += 256) {
            int b = i >> 5, t = (i & 31) * 8;
            bf16x8 v = which == 0 ? hy_short8(p, l, c, 256 * b, 256, t) : *(const bf16x8*)(Y1T + 256 * b + t);
            *(bf16x8*)(U + b * 264 + t) = v;
        }
    }
    __syncthreads();
    const float bias = p.in[I_HBIAS][(l * 2 + which) * 256 + c];
    bf16_t* OT = (which == 0 ? (bf16_t*)(p.ws + WS_Y1T) : (bf16_t*)(p.ws + WS_OUTT)) + (size_t)c * NTOK;
    const int xch = (which == 0 ? 256 : 512) + c;
    const int par = (lr + 1) & 1;
    const unsigned* cp = par ? c1 : c0;
    if (lat) {
        const int b = w >> 1, ih = w & 1;
        const int lane_dw = (2047 - lr - par) / 2 + 4 * quad;
        f32x4 acc[4];
#pragma unroll
        for (int i = 0; i < 4; ++i) acc[i] = (f32x4){0.f, 0.f, 0.f, 0.f};
        const int dlo = ih ? -15 : -31, dhi = ih ? 31 : 15;
        for (int dl = dlo; dl <= dhi; ++dl) {
#pragma unroll
            for (int ks = 0; ks < 2; ++ks) {
                bf16x8 bfr = *(const bf16x8*)(U + (size_t)(b * 64 + 16 + 16 * ih + lr - dl) * 72 + 32 * ks + 8 * quad);
#pragma unroll
                for (int mt = 0; mt < 4; ++mt) {
                    const unsigned* ap = cp + lane_dw - 32 * dl - 8 * mt + 16 * ks;
                    u32x4 av; av[0] = ap[0]; av[1] = ap[1]; av[2] = ap[2]; av[3] = ap[3];
                    acc[mt] = MFMA16(__builtin_bit_cast(bf16x8, av), bfr, acc[mt]);
                }
            }
        }
        const int tokseq0 = NCTX + 2048 * b;
        float xs[4][4];
#pragma unroll
        for (int mt = 0; mt < 4; ++mt) hy_short4(p, l, xch, tokseq0, 2048, 64 * (16 * ih + lr) + 16 * mt + 4 * quad, xs[mt]);
#pragma unroll
        for (int mt = 0; mt < 4; ++mt) {
            const int t = 64 * (16 * ih + lr) + 16 * mt + 4 * quad;
            const float* x = xs[mt];
            bf16x4 uu = *(const bf16x4*)(U + (size_t)(b * 64 + 16 + (t >> 6)) * 72 + (t & 63));
            bf16x4 o;
#pragma unroll
            for (int j = 0; j < 4; ++j) o[j] = (short)f2bf(x[j] * (acc[mt][j] + bias * bf2f((bf16_t)uu[j])));
            *(bf16x4*)(OT + tokseq0 + t) = o;
        }
    } else {
        const int lane_dw = (255 - lr - par) / 2 + 4 * quad;
        f32x4 acc[4][2];
#pragma unroll
        for (int i = 0; i < 4; ++i) { acc[i][0] = (f32x4){0.f, 0.f, 0.f, 0.f}; acc[i][1] = (f32x4){0.f, 0.f, 0.f, 0.f}; }
#pragma unroll 2
        for (int ks = 0; ks < 8; ++ks) {
            bf16x8 b0 = *(const bf16x8*)(U + lr * 264 + 32 * ks + 8 * quad);
            bf16x8 b1 = *(const bf16x8*)(U + (16 + lr) * 264 + 32 * ks + 8 * quad);
#pragma unroll
            for (int mi = 0; mi < 4; ++mi) {
                const unsigned* ap = cp + lane_dw - 8 * (4 * w + mi) + 16 * ks;
                u32x4 av; av[0] = ap[0]; av[1] = ap[1]; av[2] = ap[2]; av[3] = ap[3];
                bf16x8 af = __builtin_bit_cast(bf16x8, av);
                acc[mi][0] = MFMA16(af, b0, acc[mi][0]);
                acc[mi][1] = MFMA16(af, b1, acc[mi][1]);
            }
        }
        float xs[4][2][4];
#pragma unroll
        for (int mi = 0; mi < 4; ++mi)
#pragma unroll
            for (int nt = 0; nt < 2; ++nt) hy_short4(p, l, xch, 256 * (16 * nt + lr), 256, 16 * (4 * w + mi) + 4 * quad, xs[mi][nt]);
#pragma unroll
        for (int mi = 0; mi < 4; ++mi)
#pragma unroll
            for (int nt = 0; nt < 2; ++nt) {
                const int b = 16 * nt + lr, t = 16 * (4 * w + mi) + 4 * quad;
                const float* x = xs[mi][nt];
                bf16x4 uu = *(const bf16x4*)(U + b * 264 + t);
                bf16x4 o;
#pragma unroll
                for (int j = 0; j < 4; ++j) o[j] = (short)f2bf(x[j] * (acc[mi][nt][j] + bias * bf2f((bf16_t)uu[j])));
                *(bf16x4*)(OT + 256 * b + t) = o;
            }
    }
    __syncthreads();
}

DI void hyfin_item(const P& p, int item, unsigned char* smem) {
    bf16_t* tile = (bf16_t*)smem;
    const int tid = get_tid();
    const int tok0 = (item >> 2) * 64, ch0 = (item & 3) * 64;
    {
        const int cc = tid >> 2, part = tid & 3;
        const bf16_t* src = (const bf16_t*)(p.ws + WS_OUTT) + (size_t)(ch0 + cc) * NTOK + tok0 + part * 16;
        *(u32x4*)(tile + cc * 72 + part * 16) = *(const u32x4*)src;
        *(u32x4*)(tile + cc * 72 + part * 16 + 8) = *(const u32x4*)(src + 8);
    }
    __syncthreads();
    {
        const int tt = tid >> 2, part = tid & 3;
        const bf16_t* g = (const bf16_t*)(p.ws + WS_PROJ) + (size_t)(tok0 + tt) * NIN + C_GHY + ch0 + part * 16;
        bf16x8 g0 = *(const bf16x8*)g, g1 = *(const bf16x8*)(g + 8);
        bf16x8 o0, o1;
#pragma unroll
        for (int j = 0; j < 8; ++j) {
            o0[j] = (short)f2bf(bf2f(tile[(part * 16 + j) * 72 + tt]) * siluf_(bf2f((bf16_t)g0[j])));
            o1[j] = (short)f2bf(bf2f(tile[(part * 16 + 8 + j) * 72 + tt]) * siluf_(bf2f((bf16_t)g1[j])));
        }
        bf16_t* dst = (bf16_t*)(p.ws + WS_HB) + (size_t)(tok0 + tt) * 1024 + 256 + ch0 + part * 16;
        *(bf16x8*)dst = o0; *(bf16x8*)(dst + 8) = o1;
    }
    __syncthreads();
}

DI bf16x8 pack8(float a0, float a1, float a2, float a3, float a4, float a5, float a6, float a7) {
    typedef __bf16 bfv8 __attribute__((ext_vector_type(8)));
    typedef float fv8 __attribute__((ext_vector_type(8)));
    fv8 v = {a0, a1, a2, a3, a4, a5, a6, a7};
    return __builtin_bit_cast(bf16x8, __builtin_convertvector(v, bfv8));
}
DI void s5prep_item(const P& p, int item) {
    const int tid = get_tid();
    if (tid < 64) {
        const int pst = tid;
        unsigned char* T = p.ws + WS_S5T + (size_t)item * S5T_STRIDE;
        const int pidx = item * 64 + pst;
        const float are = fminf(p.in[I_AR][pidx], -1e-4f), aim = p.in[I_AI][pidx];
        const float dt = expf(p.in[I_LDT][item]);
        float abr, abi, Ar, Ai;
        { float m = expf(are * dt); float sn, cn; sincosf(aim * dt, &sn, &cn); abr = m * cn; abi = m * sn; }
        { float m = expf(are * dt * 256.f); float sn, cn; sincosf(aim * dt * 256.f, &sn, &cn); Ar = m * cn; Ai = m * sn; }
        ((float2*)T)[pst] = make_float2(abr, abi);
        ((float2*)T)[64 + pst] = make_float2(Ar, Ai);
        float nr = abr - 1.f, ni = abi; float den = 1.f / (are * are + aim * aim);
        float cfr = (nr * are + ni * aim) * den, cfi = (ni * are - nr * aim) * den;
        bf16_t* Bt = (bf16_t*)(T + 1024);
        bf16_t* Ct = (bf16_t*)(T + 1024 + 4096);
        for (int i = 0; i < 16; ++i) {
            float br = p.in[I_BR][(size_t)pidx * 16 + i], bi = p.in[I_BI][(size_t)pidx * 16 + i];
            Bt[(2 * pst) * 16 + i] = f2bf(cfr * br - cfi * bi);
            Bt[(2 * pst + 1) * 16 + i] = f2bf(cfr * bi + cfi * br);
            size_t ci = (size_t)(item * 16 + i) * 64 + pst;
            Ct[i * 128 + 2 * pst] = f2bf(p.in[I_CR][ci]);
            Ct[i * 128 + 2 * pst + 1] = f2bf(-p.in[I_CI][ci]);
        }
    }
}
DI void s5_item(const P& p, int l, int sc, int g, int dir, int mode, unsigned char* smem) {
    bf16_t* Ub = (bf16_t*)smem;
    float* H = (float*)(Ub + 256 * 16);
    const int tid = get_tid(), lane = tid & 63, w = tid >> 6, lr = lane & 15, quad = lane >> 4;
    const int pst = lane;
    const bool lat = sc >= 32;
    const int tokc = lat ? NCTX + 256 * (sc - 32) : 256 * sc;
    const int lb = lat ? (sc - 32) >> 3 : 0, lj = lat ? (sc - 32) & 7 : 0;
    const bf16_t* PR = (const bf16_t*)(p.ws + WS_PROJ);
    for (int e = tid; e < 512; e += 256) *(u32x4*)(Ub + 8 * e) = *(const u32x4*)(PR + (size_t)(tokc + (e >> 1)) * NIN + C_S5 + 16 * g + 8 * (e & 1));
    const unsigned char* T = p.ws + WS_S5T + (size_t)((l * 2 + dir) * 16 + g) * S5T_STRIDE;
    const float2 ab = ((const float2*)T)[pst];
    const float abr = ab.x, abi = ab.y;
    bf16x8 afB[8];
#pragma unroll
    for (int mt = 0; mt < 8; ++mt) {
        afB[mt] = (bf16x8){0, 0, 0, 0, 0, 0, 0, 0};
        if (quad < 2) afB[mt] = *(const bf16x8*)((const bf16_t*)(T + 1024) + (16 * mt + lr) * 16 + 8 * quad);
    }
    bf16x8 afC[4];
    if (mode == 1) {
#pragma unroll
        for (int ks = 0; ks < 4; ++ks) afC[ks] = *(const bf16x8*)((const bf16_t*)(T + 1024 + 4096) + lr * 128 + 32 * ks + 8 * quad);
    }
    float hr = 0.f, hi = 0.f;
    if (mode == 1 && lat && w == 0) {
        const float* h0 = p.in[I_SS5] + ((size_t)(((lb * 2 + l) * 2 + dir) * 16 + g) * 64 + pst) * 2;
        hr = h0[0]; hi = h0[1];
        const float2 A2 = ((const float2*)T)[64 + pst];
        const float Ar = A2.x, Ai = A2.y;
        const float* LOC = (const float*)(p.ws + WS_S5LOC);
        if (dir == 0) {
            for (int j = 0; j < lj; ++j) {
                const float* lc = LOC + ((size_t)(((lb * 8 + j) * 16 + g) * 2 + dir) * 64 + pst) * 2;
                float nr = Ar * hr - Ai * hi + lc[0], ni = Ar * hi + Ai * hr + lc[1]; hr = nr; hi = ni;
            }
        } else {
            for (int j = 7; j > lj; --j) {
                const float* lc = LOC + ((size_t)(((lb * 8 + j) * 16 + g) * 2 + dir) * 64 + pst) * 2;
                float nr = Ar * hr - Ai * hi + lc[0], ni = Ar * hi + Ai * hr + lc[1]; hr = nr; hi = ni;
            }
        }
    }
    __syncthreads();
    for (int sbi = 0; sbi < 4; ++sbi) {
        const int sub = dir == 0 ? sbi : 3 - sbi;
        const int tl = sub * 64 + 16 * w + lr, tok = tokc + tl, ch = 16 * g + 4 * quad;
        float* YS = (float*)(p.ws + WS_YS5) + (size_t)tok * 256 + ch;
        float4 pv = make_float4(0.f, 0.f, 0.f, 0.f);
        if (mode == 1 && dir == 1) pv = *(const float4*)YS;
        {
            bf16x8 bfr = (bf16x8){0, 0, 0, 0, 0, 0, 0, 0};
            if (quad < 2) bfr = *(const bf16x8*)(Ub + tl * 16 + 8 * quad);
#pragma unroll
            for (int mt = 0; mt < 8; ++mt) {
                f32x4 acc = MFMA16(afB[mt], bfr, ((f32x4){0.f, 0.f, 0.f, 0.f}));
                *(f32x4*)(H + (16 * w + lr) * 132 + 16 * mt + 4 * quad) = acc;
            }
        }
        __syncthreads();
        if (w == 0) {
#pragma unroll 8
            for (int k = 0; k < 64; ++k) {
                int tt = dir == 0 ? k : 63 - k;
                float2 b = *(const float2*)(H + tt * 132 + 2 * pst);
                float nr = abr * hr - abi * hi + b.x, ni = abr * hi + abi * hr + b.y; hr = nr; hi = ni;
                *(float2*)(H + tt * 132 + 2 * pst) = make_float2(hr, hi);
            }
        }
        __syncthreads();
        if (mode == 1) {
            f32x4 acc = (f32x4){0.f, 0.f, 0.f, 0.f};
#pragma unroll
            for (int ks = 0; ks < 4; ++ks) {
                const float* hp = H + (16 * w + lr) * 132 + 32 * ks + 8 * quad;
                float4 x0 = *(const float4*)hp, x1 = *(const float4*)(hp + 4);
                bf16x8 bfr = pack8(x0.x, x0.y, x0.z, x0.w, x1.x, x1.y, x1.z, x1.w);
                acc = MFMA16(afC[ks], bfr, acc);
            }
            if (dir == 0) {
                bf16x4 uu = *(const bf16x4*)(Ub + tl * 16 + 4 * quad);
                float4 dd = *(const float4*)(p.in[I_S5D] + l * 256 + ch);
                float4 o;
                o.x = dd.x * bf2f((bf16_t)uu[0]) + acc[0]; o.y = dd.y * bf2f((bf16_t)uu[1]) + acc[1];
                o.z = dd.z * bf2f((bf16_t)uu[2]) + acc[2]; o.w = dd.w * bf2f((bf16_t)uu[3]) + acc[3];
                *(float4*)YS = o;
            } else {
                bf16x4 o;
                o[0] = (short)f2bf(gelu_tanh(pv.x + acc[0])); o[1] = (short)f2bf(gelu_tanh(pv.y + acc[1]));
                o[2] = (short)f2bf(gelu_tanh(pv.z + acc[2])); o[3] = (short)f2bf(gelu_tanh(pv.w + acc[3]));
                *(bf16x4*)((bf16_t*)(p.ws + WS_GS5) + (size_t)tok * 256 + ch) = o;
            }
            __syncthreads();
        }
    }
    if (w == 0) {
        if (mode == 0) {
            float* lc = (float*)(p.ws + WS_S5LOC) + ((size_t)(((lb * 8 + lj) * 16 + g) * 2 + dir) * 64 + pst) * 2;
            lc[0] = hr; lc[1] = hi;
        } else if (!lat) {
            float* o = p.out + OFF_S5 + ((size_t)(((sc * 2 + l) * 2 + dir) * 16 + g) * 64 + pst) * 2;
            o[0] = hr; o[1] = hi;
        }
    }
    __syncthreads();
}

DI void gla_item(const P& p, int l, int sc, int head, int dir, int mode, unsigned char* smem) {
    float* qs = (float*)smem;
    float* ks = qs + 1024;
    float* ds = ks + 1024;
    float* vs = ds + 1024;
    float* gl = vs + 2048;
    float* gwl = gl + 512;
    float* ob = gwl + 544;
    const int tid = get_tid(), lane = tid & 63, w = tid >> 6;
    const int e = 16 * w + (lane & 15), dq = lane >> 4;
    const bool lat = sc >= 32;
    const int tokc = lat ? NCTX + 256 * (sc - 32) : 256 * sc;
    const int lb = lat ? (sc - 32) >> 3 : 0, lj = lat ? (sc - 32) & 7 : 0;
    const bf16_t* PR = (const bf16_t*)(p.ws + WS_PROJ);
    float S[8];
#pragma unroll
    for (int i = 0; i < 8; ++i) S[i] = 0.f;
    float acum[8];
#pragma unroll
    for (int i = 0; i < 8; ++i) acum[i] = 1.f;
    for (int i = tid; i < 544; i += 256)
        gwl[i] = i < 512 ? p.in[I_GGW][(size_t)((l * 2 + dir) * 16 + (i >> 5)) * 128 + 32 * head + (i & 31)] : p.in[I_GGB][(l * 2 + dir) * 128 + 32 * head + (i - 512)];
    if (mode == 1 && lat) {
        const float* s0 = p.in[I_SGLA] + (size_t)(((lb * 2 + l) * 2 + dir) * 4 + head) * 2048;
#pragma unroll
        for (int i = 0; i < 8; ++i) S[i] = s0[(8 * dq + i) * 64 + e];
        const float* LOC = (const float*)(p.ws + WS_GLALOC);
        if (dir == 0) {
            for (int j = 0; j < lj; ++j) {
                const float* lc = LOC + (size_t)(((lb * 8 + j) * 4 + head) * 2 + dir) * 2080;
#pragma unroll
                for (int i = 0; i < 8; ++i) S[i] = lc[2048 + 8 * dq + i] * S[i] + lc[(8 * dq + i) * 64 + e];
            }
        } else {
            for (int j = 7; j > lj; --j) {
                const float* lc = LOC + (size_t)(((lb * 8 + j) * 4 + head) * 2 + dir) * 2080;
#pragma unroll
                for (int i = 0; i < 8; ++i) S[i] = lc[2048 + 8 * dq + i] * S[i] + lc[(8 * dq + i) * 64 + e];
            }
        }
    }
    float* OG = (float*)(p.ws + WS_OGLA) + (size_t)dir * NTOK * 256;
    bf16x8 rqk, rv8, rg8 = (bf16x8){0, 0, 0, 0, 0, 0, 0, 0};
    const int qk_t = (tid & 127) >> 2, qk_c = (tid & 3) * 8, qk_col = (tid < 128 ? C_GQ : C_GK) + 32 * head + qk_c;
    {
        const int sub = dir == 0 ? 0 : 7; const int tk0 = tokc + sub * 32;
        rqk = *(const bf16x8*)(PR + (size_t)(tk0 + qk_t) * NIN + qk_col);
        rv8 = *(const bf16x8*)(PR + (size_t)(tk0 + (tid >> 3)) * NIN + C_GV + 64 * head + (tid & 7) * 8);
        if (tid < 64) rg8 = *(const bf16x8*)(PR + (size_t)(tk0 + (tid >> 1)) * NIN + C_GG + 16 * dir + (tid & 1) * 8);
    }
    for (int sbi = 0; sbi < 8; ++sbi) {
        const int sub = dir == 0 ? sbi : 7 - sbi;
        const int tk0 = tokc + sub * 32;
        __syncthreads();
        {
            float* dq_ = (tid < 128 ? qs : ks) + qk_t * 32 + qk_c;
            const float sc_ = tid < 128 ? 0.17677669529663687f : 1.f;
            *(float4*)dq_ = make_float4(bf2f((bf16_t)rqk[0]) * sc_, bf2f((bf16_t)rqk[1]) * sc_, bf2f((bf16_t)rqk[2]) * sc_, bf2f((bf16_t)rqk[3]) * sc_);
            *(float4*)(dq_ + 4) = make_float4(bf2f((bf16_t)rqk[4]) * sc_, bf2f((bf16_t)rqk[5]) * sc_, bf2f((bf16_t)rqk[6]) * sc_, bf2f((bf16_t)rqk[7]) * sc_);
            float* dv_ = vs + (tid >> 3) * 64 + (tid & 7) * 8;
            *(float4*)dv_ = make_float4(bf2f((bf16_t)rv8[0]), bf2f((bf16_t)rv8[1]), bf2f((bf16_t)rv8[2]), bf2f((bf16_t)rv8[3]));
            *(float4*)(dv_ + 4) = make_float4(bf2f((bf16_t)rv8[4]), bf2f((bf16_t)rv8[5]), bf2f((bf16_t)rv8[6]), bf2f((bf16_t)rv8[7]));
            if (tid < 64) {
                float* dg_ = gl + (tid >> 1) * 16 + (tid & 1) * 8;
                *(float4*)dg_ = make_float4(bf2f((bf16_t)rg8[0]), bf2f((bf16_t)rg8[1]), bf2f((bf16_t)rg8[2]), bf2f((bf16_t)rg8[3]));
                *(float4*)(dg_ + 4) = make_float4(bf2f((bf16_t)rg8[4]), bf2f((bf16_t)rg8[5]), bf2f((bf16_t)rg8[6]), bf2f((bf16_t)rg8[7]));
            }
        }
        __syncthreads();
        if (sbi < 7) {
            const int nsub = dir == 0 ? sbi + 1 : 6 - sbi; const int nk0 = tokc + nsub * 32;
            rqk = *(const bf16x8*)(PR + (size_t)(nk0 + qk_t) * NIN + qk_col);
            rv8 = *(const bf16x8*)(PR + (size_t)(nk0 + (tid >> 3)) * NIN + C_GV + 64 * head + (tid & 7) * 8);
            if (tid < 64) rg8 = *(const bf16x8*)(PR + (size_t)(nk0 + (tid >> 1)) * NIN + C_GG + 16 * dir + (tid & 1) * 8);
        }
#pragma unroll
        for (int j = 0; j < 4; ++j) {
            int i = tid + 256 * j; int t = i >> 5, d = i & 31;
            float z = gwl[512 + d];
#pragma unroll
            for (int r = 0; r < 16; ++r) z += gl[t * 16 + r] * gwl[r * 32 + d];
            float ls = fminf(z, 0.f) - __logf(1.f + __expf(-fabsf(z)));
            ds[i] = __expf(ls * (1.f / 16.f));
        }
        __syncthreads();
        {
            f32x2 S2[4], A2[4];
#pragma unroll
            for (int i = 0; i < 4; ++i) { S2[i] = (f32x2){S[2 * i], S[2 * i + 1]}; A2[i] = (f32x2){acum[2 * i], acum[2 * i + 1]}; }
#pragma unroll 4
            for (int k = 0; k < 32; ++k) {
                const int t = dir == 0 ? k : 31 - k;
                const float4* ap = (const float4*)(ds + t * 32 + 8 * dq);
                const float4* kp = (const float4*)(ks + t * 32 + 8 * dq);
                const float4 a0 = ap[0], a1 = ap[1], k0 = kp[0], k1 = kp[1];
                const float v = vs[t * 64 + e];
                const f32x2 vv = (f32x2){v, v};
                const f32x2 a01 = (f32x2){a0.x, a0.y}, a23 = (f32x2){a0.z, a0.w}, a45 = (f32x2){a1.x, a1.y}, a67 = (f32x2){a1.z, a1.w};
                S2[0] = a01 * S2[0] + (f32x2){k0.x, k0.y} * vv;
                S2[1] = a23 * S2[1] + (f32x2){k0.z, k0.w} * vv;
                S2[2] = a45 * S2[2] + (f32x2){k1.x, k1.y} * vv;
                S2[3] = a67 * S2[3] + (f32x2){k1.z, k1.w} * vv;
                if (mode == 1) {
                    const float4* qp = (const float4*)(qs + t * 32 + 8 * dq);
                    const float4 q0 = qp[0], q1 = qp[1];
                    f32x2 oo = (f32x2){q0.x, q0.y} * S2[0];
                    oo = (f32x2){q0.z, q0.w} * S2[1] + oo;
                    oo = (f32x2){q1.x, q1.y} * S2[2] + oo;
                    oo = (f32x2){q1.z, q1.w} * S2[3] + oo;
                    ob[(t * 64 + e) * 4 + dq] = oo[0] + oo[1];
                } else {
                    A2[0] *= a01; A2[1] *= a23; A2[2] *= a45; A2[3] *= a67;
                }
            }
#pragma unroll
            for (int i = 0; i < 4; ++i) { S[2 * i] = S2[i][0]; S[2 * i + 1] = S2[i][1]; acum[2 * i] = A2[i][0]; acum[2 * i + 1] = A2[i][1]; }
        }
        if (mode == 1) {
            __syncthreads();
            const int t = tid >> 3, e0 = (tid & 7) * 8;
            float r[8];
#pragma unroll
            for (int j = 0; j < 8; ++j) { float4 x = *(const float4*)(ob + (t * 64 + e0 + j) * 4); r[j] = (x.x + x.y) + (x.z + x.w); }
            float* dst = OG + (size_t)(tk0 + t) * 256 + 64 * head + e0;
            *(float4*)dst = make_float4(r[0], r[1], r[2], r[3]);
            *(float4*)(dst + 4) = make_float4(r[4], r[5], r[6], r[7]);
        }
    }
    if (mode == 0) {
        float* lc = (float*)(p.ws + WS_GLALOC) + (size_t)(((lb * 8 + lj) * 4 + head) * 2 + dir) * 2080;
#pragma unroll
        for (int i = 0; i < 8; ++i) lc[(8 * dq + i) * 64 + e] = S[i];
        if (w == 0 && (lane & 15) == 0) {
#pragma unroll
            for (int i = 0; i < 8; ++i) lc[2048 + 8 * dq + i] = acum[i];
        }
    } else if (!lat) {
        float* o = p.out + OFF_GLA + (size_t)(((sc * 2 + l) * 2 + dir) * 4 + head) * 2048;
#pragma unroll
        for (int i = 0; i < 8; ++i) o[(8 * dq + i) * 64 + e] = S[i];
    }
    __syncthreads();
}

DI void glafin_item(const P& p, int l, int item) {
    const int tid_ = get_tid(); const int lane = tid_ & 63, w = tid_ >> 6;
    float4 a[2], b[2]; bf16x4 g[2];
#pragma unroll
    for (int j = 0; j < 2; ++j) {
        const int tok = (item * 2 + j) * 4 + w;
        const float* O0 = (const float*)(p.ws + WS_OGLA) + (size_t)tok * 256 + lane * 4;
        a[j] = *(const float4*)O0; b[j] = *(const float4*)(O0 + (size_t)NTOK * 256);
        g[j] = *(const bf16x4*)((const bf16_t*)(p.ws + WS_PROJ) + (size_t)tok * NIN + C_GGLA + lane * 4);
    }
    const float4 nw = *(const float4*)(p.in[I_GLAN] + l * 64 + (lane & 15) * 4);
#pragma unroll
    for (int j = 0; j < 2; ++j) {
        const int tok = (item * 2 + j) * 4 + w;
        float v[4] = {a[j].x + b[j].x, a[j].y + b[j].y, a[j].z + b[j].z, a[j].w + b[j].w};
        float ss = v[0] * v[0] + v[1] * v[1] + v[2] * v[2] + v[3] * v[3];
        ss += __shfl_xor(ss, 1); ss += __shfl_xor(ss, 2); ss += __shfl_xor(ss, 4); ss += __shfl_xor(ss, 8);
        float r = rsqrtf(ss * (1.f / 64.f) + 1e-6f);
        bf16x4 o;
        o[0] = (short)f2bf(v[0] * r * nw.x * siluf_(bf2f((bf16_t)g[j][0])));
        o[1] = (short)f2bf(v[1] * r * nw.y * siluf_(bf2f((bf16_t)g[j][1])));
        o[2] = (short)f2bf(v[2] * r * nw.z * siluf_(bf2f((bf16_t)g[j][2])));
        o[3] = (short)f2bf(v[3] * r * nw.w * siluf_(bf2f((bf16_t)g[j][3])));
        *(bf16x4*)((bf16_t*)(p.ws + WS_HB) + (size_t)tok * 1024 + 768 + lane * 4) = o;
    }
}

#define XB_TMO      128
#define XB_XCNT(j)  (256  + 64 * (j))
#define XB_XSUB(j)  (1280 + 64 * (j))
#define XB_XGEN(j)  (2304 + 64 * (j))
#define XB_TOP      3328
#define XB_TOPGEN   3392
#define XCD_BAR_WORDS 3456
#define XB_SPIN_CAP (1u << 18)
#define LAS __attribute__((address_space(3)))
DI unsigned xb_ld(unsigned* p)              { return __hip_atomic_load(p, __ATOMIC_RELAXED, __HIP_MEMORY_SCOPE_AGENT); }
DI unsigned xb_add(unsigned* p, unsigned v) { return __hip_atomic_fetch_add(p, v, __ATOMIC_RELAXED, __HIP_MEMORY_SCOPE_AGENT); }
DI unsigned xb_xcc_id() { return (unsigned)__builtin_amdgcn_s_getreg((3 << 11) | 20) & 0xFu; }
#define XB_SPIN(cond, bar) do { unsigned _sp = 0; while (cond) { __builtin_amdgcn_s_sleep(1); \
    if ((++_sp & 255u) == 0u) { if (xb_ld(&(bar)[XB_TMO])) break; if (_sp > XB_SPIN_CAP) { atomicAdd(&(bar)[XB_TMO], 1u); break; } } } } while (0)
struct XcdBarrier { unsigned* bar; unsigned x; volatile LAS unsigned* st; };
DI XcdBarrier xcd_barrier_post(unsigned* bar, volatile LAS unsigned* st) {
    XcdBarrier b; b.bar = bar; b.x = xb_xcc_id(); b.st = st;
    if (threadIdx.x == 0) (void)xb_add(&bar[XB_XCNT(b.x)], 1u);
    return b;
}
DI void xcd_barrier_complete(unsigned* bar, unsigned x, unsigned& nloc, unsigned& nx) {
    const unsigned G = gridDim.x * gridDim.y * gridDim.z;
    unsigned sum, cnt, mine, sp = 0u;
    for (;;) {
        sum = 0u; cnt = 0u; mine = 0u;
#pragma unroll
        for (unsigned j = 0; j < 16; ++j) { const unsigned c = xb_ld(&bar[XB_XCNT(j)]); sum += c; cnt += (c > 0u) ? 1u : 0u; mine = (j == x) ? c : mine; }
        if (sum == G) break;
        __builtin_amdgcn_s_sleep(1);
        if ((++sp & 255u) == 0u) { if (xb_ld(&bar[XB_TMO])) break; if (sp > XB_SPIN_CAP) { atomicAdd(&bar[XB_TMO], 1u); break; } }
    }
    nloc = mine > 0u ? mine : 1u; nx = cnt > 0u ? cnt : 1u;
}
DI void xcd_barrier(const XcdBarrier& b) {
    asm volatile("s_waitcnt vmcnt(0)" ::: "memory");
    __syncthreads();
    if (threadIdx.x == 0) {
        unsigned* bar = b.bar;
        __builtin_amdgcn_s_waitcnt(0);
        unsigned nloc = b.st[0], nx = b.st[1];
        if (nloc == 0u) { xcd_barrier_complete(bar, b.x, nloc, nx); b.st[0] = nloc; b.st[1] = nx; }
        const unsigned old = xb_add(&bar[XB_XSUB(b.x)], 1u);
        const unsigned gen = old / nloc;
        if (old + 1u == (gen + 1u) * nloc) {
            __builtin_amdgcn_fence(__ATOMIC_RELEASE, "agent");
            asm volatile("s_waitcnt vmcnt(0)" ::: "memory");
            const unsigned og = xb_add(&bar[XB_TOP], 1u);
            const unsigned tg = og / nx;
            if (og + 1u == (tg + 1u) * nx) xb_add(&bar[XB_TOPGEN], 1u);
            else XB_SPIN(xb_ld(&bar[XB_TOPGEN]) == tg, bar);
            __builtin_amdgcn_fence(__ATOMIC_ACQUIRE, "agent");
            xb_add(&bar[XB_XGEN(b.x)], 1u);
            asm volatile("s_waitcnt vmcnt(0)" ::: "memory");
        } else {
            XB_SPIN(xb_ld(&bar[XB_XGEN(b.x)]) == gen, bar);
            __builtin_amdgcn_fence(__ATOMIC_ACQUIRE, "agent");
            asm volatile("s_waitcnt vmcnt(0)" ::: "memory");
        }
    }
    __syncthreads();
}

constexpr int SMEM_BYTES = 59392;
#ifndef NPHASE_LAUNCH
#define NPHASE_LAUNCH 0
#endif

DI int next_item(unsigned* ctr, int* slot) {
    __syncthreads();
    if (threadIdx.x == 0) *slot = (int)atomicAdd(ctr, 1u);
    __syncthreads();
    return __builtin_amdgcn_readfirstlane(*slot);
}

__global__ void __launch_bounds__(256, 2) mega(P pk, int ph_lo, int ph_hi) {
    __shared__ __attribute__((aligned(16))) unsigned char smem[SMEM_BYTES];
    __shared__ P p;
    __shared__ int s_next;
    if (threadIdx.x < 42) p.in[threadIdx.x] = pk.in[threadIdx.x];
    if (threadIdx.x == 42) p.out = pk.out;
    if (threadIdx.x == 43) p.ws = pk.ws;
    __syncthreads();
    cg::grid_group grid = cg::this_grid();
    __shared__ uint4 xb_words;
    if (threadIdx.x == 0) xb_words = make_uint4(0u, 0u, 0u, 0u);
    __syncthreads();
    XcdBarrier xbar = xcd_barrier_post((unsigned*)(pk.ws + WS_CTR), (volatile LAS unsigned*)&xb_words);
    if (ph_lo < 0) grid.sync();
    int ph = 0;
#define PHASE_BEGIN if (ph >= ph_lo && ph < ph_hi) {
#define PHASE_END   if (ph + 1 < ph_hi) xcd_barrier(xbar); } ++ph;
#define FOR_ITEMS(N) for (int it = blockIdx.x; it < (N); it += gridDim.x)

    PHASE_BEGIN
    FOR_ITEMS(2756 + 64) {
        if (it >= 2756) s5prep_item(p, it - 2756);
        else if (it < 96) ada_item(p, it / 48, it % 48, smem);
        else if (it < 96 + 576) { int j = it - 96; int l = j / 288, r = j % 288; int ls = r < 256 ? 1 : 0; hyfilt_item(p, l, ls, ls ? r : r - 256, smem); }
        else {
            int j = it - 672; int l = j / 1042, r = j % 1042;
            if (r < 736) tr_item(p.in[I_WIN] + (size_t)l * 1024 * 2944, 1024, 2944, (bf16_t*)(p.ws + WS_WTIN) + (size_t)l * 2944 * 1024, r / 46, r % 46, smem);
            else if (r < 992) { r -= 736; tr_item(p.in[I_WOUT] + (size_t)l * 1024 * 1024, 1024, 1024, (bf16_t*)(p.ws + WS_WTOUT) + (size_t)l * 1024 * 1024, r / 16, r % 16, smem); }
            else if (r < 1010) { r -= 992; tr_item(p.in[I_WUQ] + (size_t)l * 192 * 384, 192, 384, (bf16_t*)(p.ws + WS_WTUQ) + (size_t)l * 384 * 192, r / 6, r % 6, smem); }
            else if (r < 1026) { r -= 1010; tr_item(p.in[I_WUKV] + (size_t)l * 128 * 512, 128, 512, (bf16_t*)(p.ws + WS_WTUKV) + (size_t)l * 512 * 128, r / 8, r % 8, smem); }
            else { r -= 1026; tr_item(p.in[I_GLUW] + (size_t)l * 256 * 256, 256, 256, (bf16_t*)(p.ws + WS_WTGLU) + (size_t)l * 256 * 256, r / 4, r % 4, smem); }
        }
    }
    PHASE_END

    for (int l = 0; l < 2; ++l) {
        PHASE_BEGIN
        FOR_ITEMS(512 + (l == 0 ? 32 : 0)) {
            if (it < 512) normmod_item(p, l, it);
            else { int j = it - 512; hynorm_item(p, j >> 4, (j >> 3) & 1, j & 7, smem); }
        }
        PHASE_END
        PHASE_BEGIN
        {
            EpiProj ep{(bf16_t*)(p.ws + WS_PROJ), (bf16_t*)(p.ws + WS_ZT)};
            const bf16_t* A = (const bf16_t*)(p.ws + WS_HB);
            const bf16_t* Bt = (const bf16_t*)(p.ws + WS_WTIN) + (size_t)l * 2944 * 1024;
            FOR_ITEMS(96 * 23 + (l == 0 ? 1152 : 0)) {
                if (it < 96 * 23) { const int xq = it >> 3, xx = it & 7; gemm_tile(A, 1024, Bt, 1024, 1024, (8 * (xq / 23) + xx) * 128, (xq % 23) * 128, smem, ep); }
                else rt_item(p, it - 96 * 23, smem);
            }
        }
        PHASE_END
        PHASE_BEGIN
        FOR_ITEMS(128 + 256 + 512 + 416 + 256) {
            if (it < 128) { int j = it; gla_item(p, l, 32 + (j >> 3), (j >> 1) & 3, j & 1, 0, smem); }
            else if (it < 384 || it >= 1312) hy2_item(p, l, 0, it < 384 ? it - 128 : 256 + it - 1312, smem);
            else if (it < 896) { int j = it - 384; s5_item(p, l, 32 + (j >> 5), (j >> 1) & 15, j & 1, 0, smem); }
            else mlaprep_item(p, l, it - 896, smem);
        }
        PHASE_END
        PHASE_BEGIN
        FOR_ITEMS(384 + 128 + 768 + 256 + 256 + 256) {
            if (it < 384) { int j = it; gla_item(p, l, 47 - (j >> 3), (j >> 1) & 3, j & 1, 1, smem); }
            else if (it < 512 || (it >= 1536 && it < 1792)) attn_item(p, l, it < 512 ? it - 384 : 128 + it - 1536, smem);
            else if (it < 1280) { int j = it - 512; int sc = 47 - (j >> 4), g = j & 15; for (int dir = 0; dir < 2; ++dir) s5_item(p, l, sc, g, dir, 1, smem); }
            else hy2_item(p, l, 1, it < 1536 ? it - 1280 : 256 + it - 1792, smem);
        }
        PHASE_END
        PHASE_BEGIN
        {
            EpiGlu eg{&p, l};
            const bf16_t* A = (const bf16_t*)(p.ws + WS_GS5);
            const bf16_t* Bt = (const bf16_t*)(p.ws + WS_WTGLU) + (size_t)l * 256 * 256;
            FOR_ITEMS(192 + 512 + 768) {
                if (it < 192) gemm_tile(A, 256, Bt, 256, 256, (it >> 1) * 128, (it & 1) * 128, smem, eg);
                else if (it < 704) { for (int k = 0; k < 3; ++k) glafin_item(p, l, (it - 192) * 3 + k); }
                else hyfin_item(p, it - 704, smem);
            }
        }
        PHASE_END
        PHASE_BEGIN
        {
            EpiOut eo{&p, l};
            const bf16_t* A = (const bf16_t*)(p.ws + WS_HB);
            const bf16_t* Bt = (const bf16_t*)(p.ws + WS_WTOUT) + (size_t)l * 1024 * 1024;
            FOR_ITEMS(96 * 8) { const int xq = it >> 3, xx = it & 7; gemm_tile(A, 1024, Bt, 1024, 1024, (8 * (xq >> 3) + xx) * 128, (xq & 7) * 128, smem, eo); }
        }
        PHASE_END
    }
}

extern "C" void kernel_launch(void* const* d_in, const int* in_sizes, int n_in, void* d_out, int out_size, void* d_ws, size_t ws_size,
                              hipStream_t stream) {
    static int grid_blocks = 0;
    if (!grid_blocks) {
        int dev = 0, cus = 0, per_cu = 0;
        hipGetDevice(&dev);
        hipDeviceGetAttribute(&cus, hipDeviceAttributeMultiprocessorCount, dev);
        hipOccupancyMaxActiveBlocksPerMultiprocessor(&per_cu, mega, 256, 0);
        if (per_cu > 2) per_cu = 2;
        if (per_cu < 1) per_cu = 1;
        grid_blocks = cus * per_cu;
        if (ws_size < WS_END) fprintf(stderr, "workspace too small: %zu < %zu\n", ws_size, (size_t)WS_END);
    }
    hipMemsetAsync((unsigned char*)d_ws + WS_CTR, 0, XCD_BAR_WORDS * 4, stream);
    P p{};
    for (int i = 0; i < 42; ++i) p.in[i] = (const float*)d_in[i];
    p.out = (float*)d_out; p.ws = (unsigned char*)d_ws;
#if NPHASE_LAUNCH
    for (int ph = 0; ph < 13; ++ph) {
        int lo = ph, hi = ph + 1;
        hipLaunchKernelGGL(mega, dim3(grid_blocks), dim3(256), 0, stream, p, lo, hi);
    }
#else
    int lo = 0, hi = 13;
    void* args[] = {&p, &lo, &hi};
    hipError_t e = hipLaunchCooperativeKernel((void*)mega, dim3(grid_blocks), dim3(256), args, 0, stream);
    if (e != hipSuccess) fprintf(stderr, "cooperative launch failed: %s (grid %d)\n", hipGetErrorString(e), grid_blocks);
#endif
}
```

```cpp
#include <hip/hip_runtime.h>
#include <hip/hip_bf16.h>
#include <hip/hip_cooperative_groups.h>
#include <cstdio>
namespace cg = cooperative_groups;

typedef unsigned short bf16_t;
using bf16x8 = __attribute__((ext_vector_type(8))) short;
using bf16x4 = __attribute__((ext_vector_type(4))) short;
using f32x4 = __attribute__((ext_vector_type(4))) float;
using u32x4 = __attribute__((ext_vector_type(4))) unsigned;
using f32x2 = __attribute__((ext_vector_type(2))) float;
#define DI __device__ __forceinline__

constexpr int NTOK = 12288, NCTX = 8192, DM = 1024, NIN = 2944, NKT = 13312;
constexpr int C_CQ = 0, C_CKV = 192, C_KR = 320, C_GMLA = 352, C_HY = 608, C_GHY = 1376, C_S5 = 1632, C_GS5 = 1888,
              C_GQ = 2144, C_GK = 2272, C_GV = 2400, C_GG = 2656, C_GGLA = 2688;
constexpr size_t OFF_CKV = 12582912, OFF_KR = 14680064, OFF_S5 = 15204352, OFF_GLA = 15466496;

constexpr size_t al256(size_t x) { return (x + 255) & ~(size_t)255; }
constexpr size_t WS_MOD = 0;
constexpr size_t WS_WTIN = al256(WS_MOD + 2 * 3 * 3072 * 4);
constexpr size_t WS_WTOUT = al256(WS_WTIN + (size_t)2 * 2944 * 1024 * 2);
constexpr size_t WS_WTUQ = al256(WS_WTOUT + (size_t)2 * 1024 * 1024 * 2);
constexpr size_t WS_WTUKV = al256(WS_WTUQ + (size_t)2 * 384 * 192 * 2);
constexpr size_t WS_WTGLU = al256(WS_WTUKV + (size_t)2 * 512 * 128 * 2);
constexpr size_t WS_HF = al256(WS_WTGLU + (size_t)2 * 256 * 256 * 2);
constexpr size_t HF_LAYER = (size_t)(256 + 2048) * 1024;
constexpr size_t WS_HNORM = al256(WS_HF + 2 * HF_LAYER * 4);
constexpr size_t WS_HB = al256(WS_HNORM + 2 * 2 * 512 * 4);
constexpr size_t WS_PROJ = al256(WS_HB + (size_t)NTOK * 1024 * 2);
constexpr size_t WS_QB = al256(WS_PROJ + (size_t)NTOK * NIN * 2);
constexpr size_t WS_KB = al256(WS_QB + (size_t)4 * NTOK * 96 * 2);
constexpr size_t WS_VT = al256(WS_KB + (size_t)4 * NKT * 96 * 2);
constexpr size_t WS_ZT = al256(WS_VT + (size_t)4 * NKT * 64 * 2);
constexpr size_t WS_Y1T = al256(WS_ZT + (size_t)768 * NTOK * 2);
constexpr size_t WS_OUTT = al256(WS_Y1T + (size_t)256 * NTOK * 2);
constexpr size_t WS_RTL = al256(WS_OUTT + (size_t)256 * NTOK * 2);
constexpr size_t WS_RTC = al256(WS_RTL + (size_t)2 * 2 * 256 * 4096 * 2);
constexpr size_t WS_CTR = al256(WS_RTC + (size_t)2 * 2 * 256 * 512 * 2);
constexpr size_t WS_HPART = al256(WS_CTR + 16384);
constexpr size_t WS_YS5 = al256(WS_HPART + (size_t)2 * 288 * 1024 * 4);
constexpr size_t WS_GS5 = al256(WS_YS5 + (size_t)NTOK * 256 * 4);
constexpr size_t WS_OGLA = al256(WS_GS5 + (size_t)NTOK * 256 * 2);
constexpr size_t WS_S5LOC = al256(WS_OGLA + (size_t)2 * NTOK * 256 * 4);
constexpr size_t WS_GLALOC = al256(WS_S5LOC + (size_t)2 * 8 * 16 * 2 * 128 * 4);
constexpr size_t WS_S5T = al256(WS_GLALOC + (size_t)2 * 8 * 4 * 2 * 2080 * 4);
constexpr size_t S5T_STRIDE = 9216;
constexpr size_t WS_END = al256(WS_S5T + 64 * S5T_STRIDE);
static_assert(WS_END <= ((size_t)256 << 20), "workspace");

struct P { const float* in[42]; float* out; unsigned char* ws; };

enum { I_XP = 0, I_XS, I_C, I_CCKV, I_CKR, I_SS5, I_SGLA, I_CCTX, I_NORMW, I_ADAW, I_ADAB, I_WIN, I_WOUT, I_QAN, I_KVAN, I_WUQ, I_WUKV,
       I_QN, I_KN, I_HCW, I_HCB, I_HW1, I_HB1, I_HF1, I_HW2, I_HB2, I_HF2, I_HW3, I_HBIAS, I_AR, I_AI, I_LDT, I_BR, I_BI, I_CR, I_CI,
       I_S5D, I_GLUW, I_GLUB, I_GGW, I_GGB, I_GLAN };

DI bf16_t f2bf(float x) { __bf16 b = (__bf16)x; return __builtin_bit_cast(bf16_t, b); }
DI float bf2f(bf16_t h) { return __uint_as_float(((unsigned)h) << 16); }
DI float sigmoidf_(float x) { return 1.f / (1.f + __expf(-x)); }
DI float siluf_(float x) { return x / (1.f + __expf(-x)); }
DI float gelu_tanh(float x) { float u = 0.7978845608028654f * (x + 0.044715f * x * x * x); return 0.5f * x * (1.f + tanhf(u)); }
DI int cond_of(int tok) { return tok < NCTX ? 0 : 1 + ((tok - NCTX) >> 11); }
DI const float* xrow(const P& p, int l, int tok) {
    if (l == 0) return tok < NCTX ? p.in[I_XP] + (size_t)tok * DM : p.in[I_XS] + (size_t)(tok - NCTX) * DM;
    return p.out + (size_t)tok * DM;
}
DI int get_tid() { int t = threadIdx.x; asm volatile("" : "+v"(t)); return t; }
DI bf16x8 pack8_hw(float a0, float a1, float a2, float a3, float a4, float a5, float a6, float a7) {
    typedef __bf16 bfv8 __attribute__((ext_vector_type(8)));
    typedef float fv8 __attribute__((ext_vector_type(8)));
    fv8 v = {a0, a1, a2, a3, a4, a5, a6, a7};
    return __builtin_bit_cast(bf16x8, __builtin_convertvector(v, bfv8));
}
#define MFMA16(a, b, c) __builtin_amdgcn_mfma_f32_16x16x32_bf16((a), (b), (c), 0, 0, 0)

DI void tr_item(const float* __restrict__ src, int K, int N, bf16_t* __restrict__ dst, int kt, int nt, unsigned char* smem) {
    float* tile = (float*)smem;
    const int tid = get_tid(), k0 = kt * 64, n0 = nt * 64;
#pragma unroll
    for (int i = 0; i < 16; ++i) { int e = tid + 256 * i; int kk = e >> 6, nn = e & 63; tile[kk * 65 + nn] = src[(size_t)(k0 + kk) * N + n0 + nn]; }
    __syncthreads();
#pragma unroll
    for (int i = 0; i < 16; ++i) { int e = tid + 256 * i; int nn = e >> 6, kk = e & 63; dst[(size_t)(n0 + nn) * K + k0 + kk] = f2bf(tile[kk * 65 + nn]); }
    __syncthreads();
}

DI void ada_item(const P& p, int l, int cc, unsigned char* smem) {
    float* sc = (float*)smem;
    float* red = sc + 3 * 1024;
    const int tid = get_tid();
    for (int e = tid; e < 3 * 1024; e += 256) { int cnd = e >> 10, k = e & 1023; float v = cnd == 0 ? p.in[I_CCTX][k] : p.in[I_C][(cnd - 1) * 1024 + k]; sc[e] = siluf_(v); }
    __syncthreads();
    const int cq = tid & 15, kg = tid >> 4, n0 = cc * 64;
    const float* W = p.in[I_ADAW] + (size_t)l * 1024 * 3072 + n0 + 4 * cq;
    float acc[3][4];
#pragma unroll
    for (int a = 0; a < 3; ++a)
#pragma unroll
        for (int j = 0; j < 4; ++j) acc[a][j] = 0.f;
#pragma unroll 8
    for (int kk = 0; kk < 64; ++kk) {
        int k = kg * 64 + kk;
        float4 w = *(const float4*)(W + (size_t)k * 3072);
#pragma unroll
        for (int a = 0; a < 3; ++a) { float s = sc[a * 1024 + k]; acc[a][0] += s * w.x; acc[a][1] += s * w.y; acc[a][2] += s * w.z; acc[a][3] += s * w.w; }
    }
#pragma unroll
    for (int a = 0; a < 3; ++a)
#pragma unroll
        for (int j = 0; j < 4; ++j) red[(kg * 3 + a) * 64 + 4 * cq + j] = acc[a][j];
    __syncthreads();
    if (tid < 192) {
        int a = tid >> 6, n = tid & 63; float s = 0.f;
#pragma unroll
        for (int g = 0; g < 16; ++g) s += red[(g * 3 + a) * 64 + n];
        float* MOD = (float*)(p.ws + WS_MOD);
        MOD[(l * 3 + a) * 3072 + n0 + n] = s + p.in[I_ADAB][l * 3072 + n0 + n];
    }
    __syncthreads();
}

DI void hyfilt_item(const P& p, int l, int lsel, int tile, unsigned char* smem) {
    float* feat = (float*)smem;
    float* h1 = feat + 8 * 33;
    float* h2 = h1 + 8 * 64;
    const int tid = get_tid();
    const int L = lsel ? 2048 : 256;
    const int lag0 = tile * 8;
    const float Lf = (float)L;
    for (int e = tid; e < 8 * 33; e += 256) {
        int lg = e / 33, f = e % 33; float pos = (float)(lag0 + lg);
        float v;
        if (f == 0) v = pos / Lf;
        else {
            float w = 6.283185307179586f * pos / Lf;
            int bi = (f - 1) & 15; float band = 1e-4f + (float)bi * ((15.0f - 1e-4f) / 15.0f);
            v = (f <= 16) ? cosf(w * band) : sinf(w * band);
        }
        feat[e] = v;
    }
    __syncthreads();
    for (int e = tid; e < 8 * 64; e += 256) {
        int lg = e >> 6, j = e & 63; float s = p.in[I_HB1][l * 64 + j];
        for (int f = 0; f < 33; ++f) s += feat[lg * 33 + f] * p.in[I_HW1][(l * 33 + f) * 64 + j];
        h1[e] = sinf(p.in[I_HF1][l * 64 + j] * s);
    }
    __syncthreads();
    for (int e = tid; e < 8 * 64; e += 256) {
        int lg = e >> 6, j = e & 63; float s = p.in[I_HB2][l * 64 + j];
        for (int k = 0; k < 64; ++k) s += h1[lg * 64 + k] * p.in[I_HW2][(l * 64 + k) * 64 + j];
        h2[e] = sinf(p.in[I_HF2][l * 64 + j] * s);
    }
    __syncthreads();
    float acc[8][4];
#pragma unroll
    for (int a = 0; a < 8; ++a)
#pragma unroll
        for (int j = 0; j < 4; ++j) acc[a][j] = 0.f;
    const float* W3 = p.in[I_HW3] + (size_t)l * 64 * 1024 + 4 * tid;
#pragma unroll 4
    for (int k = 0; k < 64; ++k) {
        float4 w = *(const float4*)(W3 + k * 1024);
#pragma unroll
        for (int a = 0; a < 8; ++a) { float hv = h2[a * 64 + k]; acc[a][0] += hv * w.x; acc[a][1] += hv * w.y; acc[a][2] += hv * w.z; acc[a][3] += hv * w.w; }
    }
    float* HF = (float*)(p.ws + WS_HF) + (size_t)l * HF_LAYER + (lsel ? (size_t)256 * 1024 : 0);
    const float d0 = 15.350567286626973f, d1 = 3.0701134573253946f;
    float4 ps = make_float4(0.f, 0.f, 0.f, 0.f);
#pragma unroll
    for (int a = 0; a < 8; ++a) {
        float t = (float)(lag0 + a) / Lf;
        float4 o;
        float* op = (float*)&o;
#pragma unroll
        for (int j = 0; j < 4; ++j) {
            int ch = (4 * tid + j) & 255;
            float delta = d0 + (float)ch * ((d1 - d0) / 255.0f);
            op[j] = acc[a][j] * (expf(-t * delta) + 0.05f);
        }
        *(float4*)(HF + (size_t)(lag0 + a) * 1024 + 4 * tid) = o;
        const bool cnt = !(lag0 + a == 0 && 4 * tid >= 512);
        if (cnt) { ps.x += fabsf(o.x); ps.y += fabsf(o.y); ps.z += fabsf(o.z); ps.w += fabsf(o.w); }
    }
    *(float4*)((float*)(p.ws + WS_HPART) + ((size_t)l * 288 + (lsel ? 32 : 0) + tile) * 1024 + 4 * tid) = ps;
    __syncthreads();
}

DI void hynorm_item(const P& p, int l, int lsel, int cc, unsigned char* smem) {
    float* red = (float*)smem;
    const int tid = get_tid(), c = tid & 63, lg = tid >> 6;
    const int ntile = lsel ? 256 : 32;
    const float* PT = (const float*)(p.ws + WS_HPART) + ((size_t)l * 288 + (lsel ? 32 : 0)) * 1024;
    const int col = cc * 64 + c;
    float s = 0.f;
#pragma unroll 8
    for (int t = lg; t < ntile; t += 4) s += PT[(size_t)t * 1024 + col] + PT[(size_t)t * 1024 + 512 + col];
    red[lg * 64 + c] = s;
    __syncthreads();
    if (tid < 64) {
        float t = red[tid] + red[64 + tid] + red[128 + tid] + red[192 + tid];
        ((float*)(p.ws + WS_HNORM))[(l * 2 + lsel) * 512 + col] = 1.f / t;
    }
    __syncthreads();
}

DI void normmod_item(const P& p, int l, int item) {
    const int tid_ = get_tid(); const int lane = tid_ & 63, w = tid_ >> 6;
    float4 v[6][4]; float ss[6];
#pragma unroll
    for (int j = 0; j < 6; ++j) {
        const float* x = xrow(p, l, (item * 6 + j) * 4 + w);
        ss[j] = 0.f;
#pragma unroll
        for (int i = 0; i < 4; ++i) v[j][i] = *(const float4*)(x + lane * 4 + 256 * i);
    }
#pragma unroll
    for (int j = 0; j < 6; ++j) {
#pragma unroll
        for (int i = 0; i < 4; ++i) ss[j] += v[j][i].x * v[j][i].x + v[j][i].y * v[j][i].y + v[j][i].z * v[j][i].z + v[j][i].w * v[j][i].w;
#pragma unroll
        for (int o = 1; o < 64; o <<= 1) ss[j] += __shfl_xor(ss[j], o);
    }
    float4 nw[4];
#pragma unroll
    for (int i = 0; i < 4; ++i) nw[i] = *(const float4*)(p.in[I_NORMW] + l * 1024 + lane * 4 + 256 * i);
    const int cnd0 = cond_of((item * 6) * 4 + w), cnd5 = cond_of((item * 6 + 5) * 4 + w);
    float4 sh[4], sc[4];
    if (cnd0 == cnd5) {
        const float* MOD = (const float*)(p.ws + WS_MOD) + (l * 3 + cnd0) * 3072;
#pragma unroll
        for (int i = 0; i < 4; ++i) { sh[i] = *(const float4*)(MOD + lane * 4 + 256 * i); sc[i] = *(const float4*)(MOD + 1024 + lane * 4 + 256 * i); }
    }
#pragma unroll
    for (int j = 0; j < 6; ++j) {
        const int tok = (item * 6 + j) * 4 + w;
        const float r = rsqrtf(ss[j] * (1.f / 1024.f) + 1e-6f);
        if (cnd0 != cnd5) {
            const float* MOD = (const float*)(p.ws + WS_MOD) + (l * 3 + cond_of(tok)) * 3072;
#pragma unroll
            for (int i = 0; i < 4; ++i) { sh[i] = *(const float4*)(MOD + lane * 4 + 256 * i); sc[i] = *(const float4*)(MOD + 1024 + lane * 4 + 256 * i); }
        }
        bf16_t* HB = (bf16_t*)(p.ws + WS_HB) + (size_t)tok * 1024;
#pragma unroll
        for (int i = 0; i < 4; ++i) {
            int c = lane * 4 + 256 * i;
            bf16x4 o;
            o[0] = (short)f2bf(v[j][i].x * r * nw[i].x * (1.f + sc[i].x) + sh[i].x);
            o[1] = (short)f2bf(v[j][i].y * r * nw[i].y * (1.f + sc[i].y) + sh[i].y);
            o[2] = (short)f2bf(v[j][i].z * r * nw[i].z * (1.f + sc[i].z) + sh[i].z);
            o[3] = (short)f2bf(v[j][i].w * r * nw[i].w * (1.f + sc[i].w) + sh[i].w);
            *(bf16x4*)(HB + c) = o;
        }
    }
}

template <class Epi>
DI void gemm_tile(const bf16_t* __restrict__ A, int lda, const bf16_t* __restrict__ Bt, int ldb, int K, int m0, int n0,
                          unsigned char* smem, Epi epi) {
    bf16_t* As = (bf16_t*)smem;
    bf16_t* Bs = As + 128 * 72;
    const int tid = get_tid(), lane = tid & 63, w = tid >> 6;
    const int wm = w & 1, wn = w >> 1, lr = lane & 15, quad = lane >> 4;
    f32x4 acc[4][4];
#pragma unroll
    for (int a = 0; a < 4; ++a)
#pragma unroll
        for (int b = 0; b < 4; ++b) acc[a][b] = (f32x4){0.f, 0.f, 0.f, 0.f};
    u32x4 ra[4], rb[4], ra2[4], rb2[4];
    const bf16_t* Ag = A + (size_t)(m0 + (tid >> 3)) * lda + (tid & 7) * 8;
    const bf16_t* Bg = Bt + (size_t)(n0 + (tid >> 3)) * ldb + (tid & 7) * 8;
#pragma unroll
    for (int i = 0; i < 4; ++i) { ra[i] = *(const u32x4*)(Ag + (size_t)(32 * i) * lda); rb[i] = *(const u32x4*)(Bg + (size_t)(32 * i) * ldb); }
#pragma unroll
    for (int i = 0; i < 4; ++i) { ra2[i] = *(const u32x4*)(Ag + (size_t)(32 * i) * lda + 64); rb2[i] = *(const u32x4*)(Bg + (size_t)(32 * i) * ldb + 64); }
#define GEMM_STEP(RA, RB, KNEXT)                                                                                   \
    {                                                                                                                \
        _Pragma("unroll") for (int i = 0; i < 4; ++i) {                                                              \
            *(u32x4*)(As + ((tid >> 3) + 32 * i) * 72 + (tid & 7) * 8) = RA[i];                                      \
            *(u32x4*)(Bs + ((tid >> 3) + 32 * i) * 72 + (tid & 7) * 8) = RB[i];                                      \
        }                                                                                                            \
        __syncthreads();                                                                                             \
        if ((KNEXT) < K) {                                                                                           \
            _Pragma("unroll") for (int i = 0; i < 4; ++i) {                                                          \
                RA[i] = *(const u32x4*)(Ag + (size_t)(32 * i) * lda + (KNEXT));                                      \
                RB[i] = *(const u32x4*)(Bg + (size_t)(32 * i) * ldb + (KNEXT));                                      \
            }                                                                                                        \
        }                                                                                                            \
        _Pragma("unroll") for (int ks = 0; ks < 2; ++ks) {                                                           \
            bf16x8 af[4], bfr[4];                                                                                    \
            _Pragma("unroll") for (int t = 0; t < 4; ++t) {                                                          \
                af[t] = *(const bf16x8*)(As + (wm * 64 + t * 16 + lr) * 72 + ks * 32 + quad * 8);                    \
                bfr[t] = *(const bf16x8*)(Bs + (wn * 64 + t * 16 + lr) * 72 + ks * 32 + quad * 8);                   \
            }                                                                                                        \
            _Pragma("unroll") for (int nt = 0; nt < 4; ++nt)                                                         \
                _Pragma("unroll") for (int mt = 0; mt < 4; ++mt) acc[nt][mt] = MFMA16(bfr[nt], af[mt], acc[nt][mt]); \
        }                                                                                                            \
        __syncthreads();                                                                                             \
    }
    for (int k0 = 0; k0 < K; k0 += 128) {
        GEMM_STEP(ra, rb, k0 + 128)
        GEMM_STEP(ra2, rb2, k0 + 192)
    }
#undef GEMM_STEP
    if constexpr (Epi::kPre) {
        f32x4 xs[4][4], gs[4];
#pragma unroll
        for (int nt = 0; nt < 4; ++nt) {
            gs[nt] = epi.gate(m0, n0 + wn * 64 + nt * 16 + quad * 4);
#pragma unroll
            for (int mt = 0; mt < 4; ++mt) xs[nt][mt] = epi.load(m0 + wm * 64 + mt * 16 + lr, n0 + wn * 64 + nt * 16 + quad * 4);
        }
#pragma unroll
        for (int nt = 0; nt < 4; ++nt)
#pragma unroll
            for (int mt = 0; mt < 4; ++mt) epi.store(m0 + wm * 64 + mt * 16 + lr, n0 + wn * 64 + nt * 16 + quad * 4, acc[nt][mt], xs[nt][mt], gs[nt]);
    } else {
#pragma unroll
        for (int nt = 0; nt < 4; ++nt)
#pragma unroll
            for (int mt = 0; mt < 4; ++mt) epi(m0 + wm * 64 + mt * 16 + lr, n0 + wn * 64 + nt * 16 + quad * 4, acc[nt][mt]);
    }
}

struct EpiProj {
    static constexpr bool kPre = false;
    bf16_t* out; bf16_t* zt;
    DI void operator()(int row, int col, f32x4 v) const {
        bf16x4 o; o[0] = (short)f2bf(v[0]); o[1] = (short)f2bf(v[1]); o[2] = (short)f2bf(v[2]); o[3] = (short)f2bf(v[3]);
        if (col >= C_HY && col < C_HY + 768) {
#pragma unroll
            for (int j = 0; j < 4; ++j) zt[(size_t)(col - C_HY + j) * NTOK + row] = (bf16_t)o[j];
        } else *(bf16x4*)(out + (size_t)row * NIN + col) = o;
    }
};
struct EpiOut {
    static constexpr bool kPre = true;
    const P* p; int l;
    DI f32x4 gate(int m0, int col) const { return *(const f32x4*)((const float*)(p->ws + WS_MOD) + (l * 3 + cond_of(m0)) * 3072 + 2048 + col); }
    DI f32x4 load(int row, int col) const { return *(const f32x4*)(xrow(*p, l, row) + col); }
    DI void store(int row, int col, f32x4 v, f32x4 x, f32x4 g) const { *(f32x4*)(p->out + (size_t)row * DM + col) = x + g * v; }
    DI void operator()(int row, int col, f32x4 v) const { store(row, col, v, load(row, col), gate(row, col)); }
};
struct EpiGlu {
    static constexpr bool kPre = true;
    const P* p; int l;
    DI f32x4 gate(int m0, int col) const { return *(const f32x4*)(p->in[I_GLUB] + l * 256 + col); }
    DI f32x4 load(int row, int col) const {
        const bf16x4 gg = *(const bf16x4*)((const bf16_t*)(p->ws + WS_GS5) + (size_t)row * 256 + col);
        const bf16x4 gs = *(const bf16x4*)((const bf16_t*)(p->ws + WS_PROJ) + (size_t)row * NIN + C_GS5 + col);
        return __builtin_bit_cast(f32x4, __builtin_shufflevector(gg, gs, 0, 1, 2, 3, 4, 5, 6, 7));
    }
    DI void store(int row, int col, f32x4 v, f32x4 x, f32x4 b) const {
        const bf16x8 pk = __builtin_bit_cast(bf16x8, x);
        bf16x4 o;
#pragma unroll
        for (int j = 0; j < 4; ++j) { float g = bf2f((bf16_t)pk[j]); o[j] = (short)f2bf(g * sigmoidf_(v[j] + b[j]) * siluf_(bf2f((bf16_t)pk[4 + j]))); }
        *(bf16x4*)((bf16_t*)(p->ws + WS_HB) + (size_t)row * 1024 + 512 + col) = o;
    }
    DI void operator()(int row, int col, f32x4 v) const { store(row, col, v, load(row, col), gate(row, col)); }
};

DI void mlaprep_item(const P& p, int l, int item, unsigned char* smem) {
    bf16_t* Aq = (bf16_t*)smem;
    bf16_t* Akv = Aq + 32 * 200;
    float* R = (float*)(Akv + 32 * 136);
    float* kr = R + 32 * 132;
    float* kn = kr + 32 * 32;
    float* cst = kn + 32 * 32;
    float* snt = cst + 32 * 16;
    const int tid = get_tid(), lane = tid & 63, w = tid >> 6, lr = lane & 15, quad = lane >> 4;
    const bool is_cache = item >= 384;
    int tok0 = 0, cb = 0, r0 = 0;
    if (!is_cache) tok0 = item * 32; else { cb = (item - 384) >> 4; r0 = ((item - 384) & 15) * 32; }
    const bool is_lat = !is_cache && tok0 >= NCTX;
    const bool do_rope = is_lat;
    int kbase, nkeys, kin0;
    if (is_cache) { kbase = 8192 + 2560 * cb; nkeys = 2560; kin0 = r0; }
    else if (is_lat) { int b = (tok0 - NCTX) >> 11; kbase = 8192 + 2560 * b; nkeys = 2560; kin0 = 512 + ((tok0 - NCTX) & 2047); }
    else { kbase = tok0 & ~255; nkeys = 256; kin0 = tok0 & 255; }
    const bf16_t* PR = (const bf16_t*)(p.ws + WS_PROJ);
    {
        const int t = tid >> 3, part = tid & 7;
        if (!is_cache) {
            const bf16_t* row = PR + (size_t)(tok0 + t) * NIN;
            const int tok = tok0 + t;
            {
                bf16x8 q[3];
#pragma unroll
                for (int c = 0; c < 3; ++c) q[c] = *(const bf16x8*)(row + C_CQ + part * 24 + 8 * c);
                float ss = 0.f;
#pragma unroll
                for (int c = 0; c < 3; ++c)
#pragma unroll
                    for (int j = 0; j < 8; ++j) { float x = bf2f((bf16_t)q[c][j]); ss += x * x; }
                ss += __shfl_xor(ss, 1); ss += __shfl_xor(ss, 2); ss += __shfl_xor(ss, 4);
                const float rq = rsqrtf(ss * (1.f / 192.f) + 1e-6f);
                const float4* wq4 = (const float4*)(p.in[I_QAN] + l * 192 + part * 24);
#pragma unroll
                for (int c = 0; c < 3; ++c) {
                    float4 w0 = wq4[2 * c], w1 = wq4[2 * c + 1];
                    bf16x8 o;
                    o[0] = (short)f2bf(bf2f((bf16_t)q[c][0]) * rq * w0.x); o[1] = (short)f2bf(bf2f((bf16_t)q[c][1]) * rq * w0.y);
                    o[2] = (short)f2bf(bf2f((bf16_t)q[c][2]) * rq * w0.z); o[3] = (short)f2bf(bf2f((bf16_t)q[c][3]) * rq * w0.w);
                    o[4] = (short)f2bf(bf2f((bf16_t)q[c][4]) * rq * w1.x); o[5] = (short)f2bf(bf2f((bf16_t)q[c][5]) * rq * w1.y);
                    o[6] = (short)f2bf(bf2f((bf16_t)q[c][6]) * rq * w1.z); o[7] = (short)f2bf(bf2f((bf16_t)q[c][7]) * rq * w1.w);
                    *(bf16x8*)(Aq + t * 200 + part * 24 + 8 * c) = o;
                }
            }
            {
                bf16x8 k[2];
#pragma unroll
                for (int c = 0; c < 2; ++c) k[c] = *(const bf16x8*)(row + C_CKV + part * 16 + 8 * c);
                float ss = 0.f;
#pragma unroll
                for (int c = 0; c < 2; ++c)
#pragma unroll
                    for (int j = 0; j < 8; ++j) { float x = bf2f((bf16_t)k[c][j]); ss += x * x; }
                ss += __shfl_xor(ss, 1); ss += __shfl_xor(ss, 2); ss += __shfl_xor(ss, 4);
                const float rk = rsqrtf(ss * (1.f / 128.f) + 1e-6f);
                const float4* wk4 = (const float4*)(p.in[I_KVAN] + l * 128 + part * 16);
                float* oc = p.out + OFF_CKV + ((size_t)((tok >> 8) * 2 + l) * 256 + (tok & 255)) * 128 + part * 16;
#pragma unroll
                for (int c = 0; c < 2; ++c) {
                    float4 w0 = wk4[2 * c], w1 = wk4[2 * c + 1];
                    float4 v0, v1;
                    v0.x = bf2f((bf16_t)k[c][0]) * rk * w0.x; v0.y = bf2f((bf16_t)k[c][1]) * rk * w0.y;
                    v0.z = bf2f((bf16_t)k[c][2]) * rk * w0.z; v0.w = bf2f((bf16_t)k[c][3]) * rk * w0.w;
                    v1.x = bf2f((bf16_t)k[c][4]) * rk * w1.x; v1.y = bf2f((bf16_t)k[c][5]) * rk * w1.y;
                    v1.z = bf2f((bf16_t)k[c][6]) * rk * w1.z; v1.w = bf2f((bf16_t)k[c][7]) * rk * w1.w;
                    bf16x8 o;
                    o[0] = (short)f2bf(v0.x); o[1] = (short)f2bf(v0.y); o[2] = (short)f2bf(v0.z); o[3] = (short)f2bf(v0.w);
                    o[4] = (short)f2bf(v1.x); o[5] = (short)f2bf(v1.y); o[6] = (short)f2bf(v1.z); o[7] = (short)f2bf(v1.w);
                    *(bf16x8*)(Akv + t * 136 + part * 16 + 8 * c) = o;
                    if (!is_lat) { *(float4*)(oc + 8 * c) = v0; *(float4*)(oc + 8 * c + 4) = v1; }
                }
            }
            {
                bf16x4 r4 = *(const bf16x4*)(row + C_KR + part * 4);
                float4 v = make_float4(bf2f((bf16_t)r4[0]), bf2f((bf16_t)r4[1]), bf2f((bf16_t)r4[2]), bf2f((bf16_t)r4[3]));
                *(float4*)(kr + t * 32 + part * 4) = v;
                if (!is_lat) *(float4*)(p.out + OFF_KR + ((size_t)((tok >> 8) * 2 + l) * 256 + (tok & 255)) * 32 + part * 4) = v;
            }
        } else {
            const float4* ck = (const float4*)(p.in[I_CCKV] + ((size_t)(cb * 2 + l) * 512 + r0 + t) * 128 + part * 16);
            const float4* ckr = (const float4*)(p.in[I_CKR] + ((size_t)(cb * 2 + l) * 512 + r0 + t) * 32 + part * 4);
#pragma unroll
            for (int c = 0; c < 2; ++c) {
                float4 v0 = ck[2 * c], v1 = ck[2 * c + 1];
                bf16x8 o;
                o[0] = (short)f2bf(v0.x); o[1] = (short)f2bf(v0.y); o[2] = (short)f2bf(v0.z); o[3] = (short)f2bf(v0.w);
                o[4] = (short)f2bf(v1.x); o[5] = (short)f2bf(v1.y); o[6] = (short)f2bf(v1.z); o[7] = (short)f2bf(v1.w);
                *(bf16x8*)(Akv + t * 136 + part * 16 + 8 * c) = o;
            }
            *(float4*)(kr + t * 32 + part * 4) = ckr[0];
        }
        if (do_rope) {
            for (int e = tid; e < 32 * 16; e += 256) {
                int tt = e >> 4, a = e & 15; int pos = (tok0 - NCTX + tt) & 2047;
                float pp = (a < 8) ? (float)(pos >> 6) : (float)(pos & 63);
                float inv = powf(10000.f, -(float)(a & 7) * 0.125f);
                float ang = pp * inv;
                cst[e] = cosf(ang); snt[e] = sinf(ang);
            }
        }
    }
    __syncthreads();
    const int mt = w & 1, nh = w >> 1;
    const float qscale = 0.10206207261596577f * 1.4426950408889634f;
    for (int h = 0; h < 4; ++h) {
        if (!is_cache) {
            f32x4 acc[3];
#pragma unroll
            for (int i = 0; i < 3; ++i) acc[i] = (f32x4){0.f, 0.f, 0.f, 0.f};
            const bf16_t* W = (const bf16_t*)(p.ws + WS_WTUQ) + (size_t)l * 384 * 192 + (size_t)(96 * h + 48 * nh + lr) * 192 + quad * 8;
#pragma unroll
            for (int ks = 0; ks < 6; ++ks) {
                bf16x8 xf = *(const bf16x8*)(Aq + (16 * mt + lr) * 200 + 32 * ks + quad * 8);
#pragma unroll
                for (int i = 0; i < 3; ++i) { bf16x8 wf = *(const bf16x8*)(W + (size_t)(16 * i) * 192 + 32 * ks); acc[i] = MFMA16(wf, xf, acc[i]); }
            }
#pragma unroll
            for (int i = 0; i < 3; ++i) *(f32x4*)(R + (16 * mt + lr) * 132 + 48 * nh + 16 * i + quad * 4) = acc[i];
            __syncthreads();
            {
                const int t = tid >> 3, part = tid & 7;
                float4* rp = (float4*)(R + t * 132 + part * 12);
                float4 x0 = rp[0], x1 = rp[1], x2 = rp[2];
                float ss = x0.x * x0.x + x0.y * x0.y + x0.z * x0.z + x0.w * x0.w + x1.x * x1.x + x1.y * x1.y + x1.z * x1.z + x1.w * x1.w
                         + x2.x * x2.x + x2.y * x2.y + x2.z * x2.z + x2.w * x2.w;
                ss += __shfl_xor(ss, 1); ss += __shfl_xor(ss, 2); ss += __shfl_xor(ss, 4);
                float r = rsqrtf(ss * (1.f / 96.f) + 1e-6f);
                const float4* wn = (const float4*)(p.in[I_QN] + l * 96 + part * 12);
                float4 w0 = wn[0], w1 = wn[1], w2 = wn[2];
                rp[0] = make_float4(x0.x * r * w0.x, x0.y * r * w0.y, x0.z * r * w0.z, x0.w * r * w0.w);
                rp[1] = make_float4(x1.x * r * w1.x, x1.y * r * w1.y, x1.z * r * w1.z, x1.w * r * w1.w);
                rp[2] = make_float4(x2.x * r * w2.x, x2.y * r * w2.y, x2.z * r * w2.z, x2.w * r * w2.w);
            }
            __syncthreads();
            {
                const int t = tid >> 3, part = tid & 7;
                bf16_t* Qo = (bf16_t*)(p.ws + WS_QB) + ((size_t)h * NTOK + tok0 + t) * 96;
                bf16_t qv[12];
#pragma unroll
                for (int j = 0; j < 12; ++j) {
                    int n = part * 12 + j; float v;
                    if (n < 64 || !do_rope) v = R[t * 132 + n];
                    else {
                        int i = (n - 64) & 7, half = ((n - 64) >> 3) & 1, ax = (n - 64) >> 4;
                        float x1 = R[t * 132 + 64 + 16 * ax + i], x2 = R[t * 132 + 64 + 16 * ax + 8 + i];
                        float c = cst[t * 16 + ax * 8 + i], s = snt[t * 16 + ax * 8 + i];
                        v = half == 0 ? x1 * c - x2 * s : x2 * c + x1 * s;
                    }
                    qv[j] = f2bf(v * qscale);
                }
#pragma unroll
                for (int c = 0; c < 3; ++c) { bf16x4 o; o[0] = (short)qv[4 * c]; o[1] = (short)qv[4 * c + 1]; o[2] = (short)qv[4 * c + 2]; o[3] = (short)qv[4 * c + 3]; *(bf16x4*)(Qo + part * 12 + 4 * c) = o; }
            }
            __syncthreads();
        }
        {
            f32x4 acc[4];
#pragma unroll
            for (int i = 0; i < 4; ++i) acc[i] = (f32x4){0.f, 0.f, 0.f, 0.f};
            const bf16_t* W = (const bf16_t*)(p.ws + WS_WTUKV) + (size_t)l * 512 * 128 + (size_t)(128 * h + 64 * nh + lr) * 128 + quad * 8;
#pragma unroll
            for (int ks = 0; ks < 4; ++ks) {
                bf16x8 xf = *(const bf16x8*)(Akv + (16 * mt + lr) * 136 + 32 * ks + quad * 8);
#pragma unroll
                for (int i = 0; i < 4; ++i) { bf16x8 wf = *(const bf16x8*)(W + (size_t)(16 * i) * 128 + 32 * ks); acc[i] = MFMA16(wf, xf, acc[i]); }
            }
#pragma unroll
            for (int i = 0; i < 4; ++i) *(f32x4*)(R + (16 * mt + lr) * 132 + 64 * nh + 16 * i + quad * 4) = acc[i];
        }
        __syncthreads();
        {
            const int t = tid >> 3, part = tid & 7;
            float4* rp = (float4*)(R + t * 132 + part * 8);
            float4 x0 = rp[0], x1 = rp[1], x2 = *(const float4*)(kr + t * 32 + part * 4);
            float ss = x0.x * x0.x + x0.y * x0.y + x0.z * x0.z + x0.w * x0.w + x1.x * x1.x + x1.y * x1.y + x1.z * x1.z + x1.w * x1.w
                     + x2.x * x2.x + x2.y * x2.y + x2.z * x2.z + x2.w * x2.w;
            ss += __shfl_xor(ss, 1); ss += __shfl_xor(ss, 2); ss += __shfl_xor(ss, 4);
            float r = rsqrtf(ss * (1.f / 96.f) + 1e-6f);
            const float4* wn = (const float4*)(p.in[I_KN] + l * 96 + part * 8);
            float4 w0 = wn[0], w1 = wn[1], w2 = *(const float4*)(p.in[I_KN] + l * 96 + 64 + part * 4);
            rp[0] = make_float4(x0.x * r * w0.x, x0.y * r * w0.y, x0.z * r * w0.z, x0.w * r * w0.w);
            rp[1] = make_float4(x1.x * r * w1.x, x1.y * r * w1.y, x1.z * r * w1.z, x1.w * r * w1.w);
            *(float4*)(kn + t * 32 + part * 4) = make_float4(x2.x * r * w2.x, x2.y * r * w2.y, x2.z * r * w2.z, x2.w * r * w2.w);
        }
        __syncthreads();
        {
            const int t = tid >> 3, part = tid & 7;
            bf16_t* Ko = (bf16_t*)(p.ws + WS_KB) + ((size_t)h * NKT + kbase + kin0 + t) * 96;
            bf16_t kv[12];
#pragma unroll
            for (int j = 0; j < 12; ++j) {
                int n = part * 12 + j; float v;
                if (n < 64) v = R[t * 132 + n];
                else if (!do_rope) v = kn[t * 32 + n - 64];
                else {
                    int i = (n - 64) & 7, half = ((n - 64) >> 3) & 1, ax = (n - 64) >> 4;
                    float x1 = kn[t * 32 + 16 * ax + i], x2 = kn[t * 32 + 16 * ax + 8 + i];
                    float c = cst[t * 16 + ax * 8 + i], s = snt[t * 16 + ax * 8 + i];
                    v = half == 0 ? x1 * c - x2 * s : x2 * c + x1 * s;
                }
                kv[j] = f2bf(v);
            }
#pragma unroll
            for (int c = 0; c < 3; ++c) { bf16x4 o; o[0] = (short)kv[4 * c]; o[1] = (short)kv[4 * c + 1]; o[2] = (short)kv[4 * c + 2]; o[3] = (short)kv[4 * c + 3]; *(bf16x4*)(Ko + part * 12 + 4 * c) = o; }
            const int dv = tid & 63, tg = tid >> 6;
            bf16x8 o;
#pragma unroll
            for (int j = 0; j < 8; ++j) o[j] = (short)f2bf(R[(tg * 8 + j) * 132 + 64 + dv]);
            bf16_t* Vo = (bf16_t*)(p.ws + WS_VT) + ((size_t)h * NKT + kbase) * 64 + (size_t)dv * nkeys + kin0 + tg * 8;
            *(bf16x8*)Vo = o;
        }
        __syncthreads();
    }
}

DI void attn_item(const P& p, int l, int item, unsigned char* smem) {
    bf16_t* Ks = (bf16_t*)smem;
    bf16_t* Vs = Ks + 64 * 104;
    const int tid = get_tid(), lane = tid & 63, w = tid >> 6, lr = lane & 15, quad = lane >> 4;
    int seq, h, qb;
    if (item < 128) { seq = 32 + (item >> 6); h = (item >> 4) & 3; qb = item & 15; }
    else { int j = item - 128; seq = j >> 3; h = (j >> 1) & 3; qb = j & 1; }
    int tokbase, nkeys, kbase;
    if (seq < 32) { tokbase = 256 * seq; nkeys = 256; kbase = 256 * seq; }
    else { tokbase = NCTX + 2048 * (seq - 32); nkeys = 2560; kbase = 8192 + 2560 * (seq - 32); }
    const bf16_t* Qp = (const bf16_t*)(p.ws + WS_QB) + ((size_t)h * NTOK + tokbase + qb * 128 + 32 * w) * 96;
    const bf16_t* Kp = (const bf16_t*)(p.ws + WS_KB) + ((size_t)h * NKT + kbase) * 96;
    const bf16_t* Vp = (const bf16_t*)(p.ws + WS_VT) + ((size_t)h * NKT + kbase) * 64;
    bf16x8 qf[2][3];
#pragma unroll
    for (int nt = 0; nt < 2; ++nt)
#pragma unroll
        for (int ks = 0; ks < 3; ++ks) qf[nt][ks] = *(const bf16x8*)(Qp + (16 * nt + lr) * 96 + 32 * ks + 8 * quad);
    f32x4 o[4][2];
#pragma unroll
    for (int a = 0; a < 4; ++a)
#pragma unroll
        for (int b = 0; b < 2; ++b) o[a][b] = (f32x4){0.f, 0.f, 0.f, 0.f};
    float mrow[2] = {-1e30f, -1e30f}, lsum[2] = {0.f, 0.f};
    u32x4 rk[3], rv[2];
    const int ntile = nkeys >> 6;
#pragma unroll
    for (int i = 0; i < 3; ++i) { int c = tid + 256 * i; rk[i] = *(const u32x4*)(Kp + (size_t)(c / 12) * 96 + (c % 12) * 8); }
#pragma unroll
    for (int i = 0; i < 2; ++i) { int c = tid + 256 * i; rv[i] = *(const u32x4*)(Vp + (size_t)(c >> 3) * nkeys + (c & 7) * 8); }
    for (int kt = 0; kt < ntile; ++kt) {
#pragma unroll
        for (int i = 0; i < 3; ++i) { int c = tid + 256 * i; *(u32x4*)(Ks + (c / 12) * 104 + (c % 12) * 8) = rk[i]; }
#pragma unroll
        for (int i = 0; i < 2; ++i) { int c = tid + 256 * i; *(u32x4*)(Vs + (c >> 3) * 72 + (c & 7) * 8) = rv[i]; }
        __syncthreads();
        if (kt + 1 < ntile) {
#pragma unroll
            for (int i = 0; i < 3; ++i) { int c = tid + 256 * i; rk[i] = *(const u32x4*)(Kp + (size_t)((kt + 1) * 64 + c / 12) * 96 + (c % 12) * 8); }
#pragma unroll
            for (int i = 0; i < 2; ++i) { int c = tid + 256 * i; rv[i] = *(const u32x4*)(Vp + (size_t)(c >> 3) * nkeys + (kt + 1) * 64 + (c & 7) * 8); }
        }
        f32x4 s[4][2];
#pragma unroll
        for (int a = 0; a < 4; ++a)
#pragma unroll
            for (int b = 0; b < 2; ++b) s[a][b] = (f32x4){0.f, 0.f, 0.f, 0.f};
#pragma unroll
        for (int ks = 0; ks < 3; ++ks)
#pragma unroll
            for (int mt = 0; mt < 4; ++mt) {
                bf16x8 kf = *(const bf16x8*)(Ks + (16 * mt + lr) * 104 + 32 * ks + 8 * quad);
#pragma unroll
                for (int nt = 0; nt < 2; ++nt) s[mt][nt] = MFMA16(kf, qf[nt][ks], s[mt][nt]);
            }
        bf16x8 pf[2][2];
#pragma unroll
        for (int nt = 0; nt < 2; ++nt) {
            float mx = -1e30f;
#pragma unroll
            for (int mt = 0; mt < 4; ++mt)
#pragma unroll
                for (int j = 0; j < 4; ++j) mx = fmaxf(mx, s[mt][nt][j]);
            mx = fmaxf(mx, __shfl_xor(mx, 16)); mx = fmaxf(mx, __shfl_xor(mx, 32));
            float mnew = fmaxf(mrow[nt], mx);
            float alpha = __builtin_amdgcn_exp2f(mrow[nt] - mnew);
            mrow[nt] = mnew;
            float rs = 0.f;
#pragma unroll
            for (int mt = 0; mt < 4; ++mt)
#pragma unroll
                for (int j = 0; j < 4; ++j) { float pv = __builtin_amdgcn_exp2f(s[mt][nt][j] - mnew); s[mt][nt][j] = pv; rs += pv; }
            lsum[nt] = lsum[nt] * alpha + rs;
#pragma unroll
            for (int dt = 0; dt < 4; ++dt) { o[dt][nt][0] *= alpha; o[dt][nt][1] *= alpha; o[dt][nt][2] *= alpha; o[dt][nt][3] *= alpha; }
#pragma unroll
            for (int kk = 0; kk < 2; ++kk)
                pf[kk][nt] = pack8_hw(s[2 * kk][nt][0], s[2 * kk][nt][1], s[2 * kk][nt][2], s[2 * kk][nt][3],
                                      s[2 * kk + 1][nt][0], s[2 * kk + 1][nt][1], s[2 * kk + 1][nt][2], s[2 * kk + 1][nt][3]);
        }
#pragma unroll
        for (int kk = 0; kk < 2; ++kk)
#pragma unroll
            for (int dt = 0; dt < 4; ++dt) {
                bf16x4 lo = *(const bf16x4*)(Vs + (16 * dt + lr) * 72 + 32 * kk + 4 * quad);
                bf16x4 hi = *(const bf16x4*)(Vs + (16 * dt + lr) * 72 + 32 * kk + 16 + 4 * quad);
                bf16x8 vf = __builtin_shufflevector(lo, hi, 0, 1, 2, 3, 4, 5, 6, 7);
#pragma unroll
                for (int nt = 0; nt < 2; ++nt) o[dt][nt] = MFMA16(vf, pf[kk][nt], o[dt][nt]);
            }
        __syncthreads();
    }
    const bf16_t* PR = (const bf16_t*)(p.ws + WS_PROJ);
    bf16_t* HB = (bf16_t*)(p.ws + WS_HB);
    bf16x4 gpre[2][4];
#pragma unroll
    for (int nt = 0; nt < 2; ++nt)
#pragma unroll
        for (int dt = 0; dt < 4; ++dt)
            gpre[nt][dt] = *(const bf16x4*)(PR + (size_t)(tokbase + qb * 128 + 32 * w + 16 * nt + lr) * NIN + C_GMLA + h * 64 + 16 * dt + 4 * quad);
#pragma unroll
    for (int nt = 0; nt < 2; ++nt) {
        float lt = lsum[nt]; lt += __shfl_xor(lt, 16); lt += __shfl_xor(lt, 32);
        float inv = 1.f / lt;
        int tok = tokbase + qb * 128 + 32 * w + 16 * nt + lr;
#pragma unroll
        for (int dt = 0; dt < 4; ++dt) {
            int col = h * 64 + 16 * dt + 4 * quad;
            bf16x4 g = gpre[nt][dt];
            bf16x4 ov;
#pragma unroll
            for (int j = 0; j < 4; ++j) ov[j] = (short)f2bf(o[dt][nt][j] * inv * siluf_(bf2f((bf16_t)g[j])));
            *(bf16x4*)(HB + (size_t)tok * 1024 + col) = ov;
        }
    }
}

DI void rt_item(const P& p, int item, unsigned char* smem) {
    float* tile = (float*)smem;
    const int tid = get_tid();
    int l = item / 576, r = item % 576;
    int order = r / 288; r %= 288;
    int cht = r / 72, xt = r % 72;
    const int lsel = xt >= 8 ? 1 : 0; if (lsel) xt -= 8;
    const int L = lsel ? 2048 : 256, x0 = xt * 64, ch0 = cht * 64;
    const float* HF = (const float*)(p.ws + WS_HF) + (size_t)l * HF_LAYER + (lsel ? (size_t)256 * 1024 : 0) + order * 256 + ch0;
    const float* HN = (const float*)(p.ws + WS_HNORM) + (l * 2 + lsel) * 512 + order * 256 + ch0;
#pragma unroll
    for (int i = 0; i < 16; ++i) {
        int e = tid + 256 * i; int xx = e >> 6, cc = e & 63;
        int d = L - 1 - (x0 + xx);
        float v = 0.f;
        if (d >= 0) v = HF[(size_t)d * 1024 + cc]; else if (d > -L) v = HF[(size_t)(-d) * 1024 + 512 + cc];
        tile[xx * 65 + cc] = v * HN[cc];
    }
    __syncthreads();
    bf16_t* RT = lsel ? (bf16_t*)(p.ws + WS_RTL) + ((size_t)(l * 2 + order) * 256 + ch0) * 4096 : (bf16_t*)(p.ws + WS_RTC) + ((size_t)(l * 2 + order) * 256 + ch0) * 512;
    const int XL = 2 * L;
#pragma unroll
    for (int i = 0; i < 16; ++i) { int e = tid + 256 * i; int cc = e >> 6, xx = e & 63; RT[(size_t)cc * XL + x0 + xx] = f2bf(tile[xx * 65 + cc]); }
    __syncthreads();
}

DI void hy_short4(const P& p, int l, int ch768, int tokseq0, int L, int t, float* o) {
    const bf16_t* Z = (const bf16_t*)(p.ws + WS_ZT) + (size_t)ch768 * NTOK + tokseq0 + t;
    const float* cw = p.in[I_HCW] + l * 3 * 768 + ch768;
    const float w0 = cw[0], w1 = cw[768], w2 = cw[1536], bb = p.in[I_HCB][l * 768 + ch768];
    bf16x4 m = *(const bf16x4*)Z;
    const float zm = t > 0 ? bf2f(Z[-1]) : 0.f;
    const float z0 = bf2f((bf16_t)m[0]), z1 = bf2f((bf16_t)m[1]), z2 = bf2f((bf16_t)m[2]), z3 = bf2f((bf16_t)m[3]);
    const float zp = t + 4 < L ? bf2f(Z[4]) : 0.f;
    o[0] = bb + w0 * zm + w1 * z0 + w2 * z1;
    o[1] = bb + w0 * z0 + w1 * z1 + w2 * z2;
    o[2] = bb + w0 * z1 + w1 * z2 + w2 * z3;
    o[3] = bb + w0 * z2 + w1 * z3 + w2 * zp;
}
DI bf16x8 hy_short8(const P& p, int l, int ch768, int tokseq0, int L, int t) {
    const bf16_t* Z = (const bf16_t*)(p.ws + WS_ZT) + (size_t)ch768 * NTOK + tokseq0 + t;
    const float* cw = p.in[I_HCW] + l * 3 * 768 + ch768;
    const float w0 = cw[0], w1 = cw[768], w2 = cw[1536], bb = p.in[I_HCB][l * 768 + ch768];
    bf16x8 m = *(const bf16x8*)Z;
    const float zm = t > 0 ? bf2f(Z[-1]) : 0.f;
    const float z0 = bf2f((bf16_t)m[0]), z1 = bf2f((bf16_t)m[1]), z2 = bf2f((bf16_t)m[2]), z3 = bf2f((bf16_t)m[3]);
    const float z4 = bf2f((bf16_t)m[4]), z5 = bf2f((bf16_t)m[5]), z6 = bf2f((bf16_t)m[6]), z7 = bf2f((bf16_t)m[7]);
    const float zp = t + 8 < L ? bf2f(Z[8]) : 0.f;
    bf16x8 o;
    o[0] = (short)f2bf(bb + w0 * zm + w1 * z0 + w2 * z1);
    o[1] = (short)f2bf(bb + w0 * z0 + w1 * z1 + w2 * z2);
    o[2] = (short)f2bf(bb + w0 * z1 + w1 * z2 + w2 * z3);
    o[3] = (short)f2bf(bb + w0 * z2 + w1 * z3 + w2 * z4);
    o[4] = (short)f2bf(bb + w0 * z3 + w1 * z4 + w2 * z5);
    o[5] = (short)f2bf(bb + w0 * z4 + w1 * z5 + w2 * z6);
    o[6] = (short)f2bf(bb + w0 * z5 + w1 * z6 + w2 * z7);
    o[7] = (short)f2bf(bb + w0 * z6 + w1 * z7 + w2 * zp);
    return o;
}

DI void hy2_item(const P& p, int l, int which, int item, unsigned char* smem) {
    const int tid = get_tid(), lane = tid & 63, w = tid >> 6, lr = lane & 15, quad = lane >> 4;
    const bool lat = item < 256;
    const int c = lat ? item : item - 256;
    const int XL = lat ? 4096 : 512;
    unsigned* c0 = (unsigned*)smem;
    unsigned* c1 = c0 + 2048 + 16;
    bf16_t* U = (bf16_t*)(c1 + 2048 + 16);
    const bf16_t* RT = lat ? (const bf16_t*)(p.ws + WS_RTL) + ((size_t)(l * 2 + which) * 256 + c) * 4096
                           : (const bf16_t*)(p.ws + WS_RTC) + ((size_t)(l * 2 + which) * 256 + c) * 512;
    const bf16_t* Y1T = (const bf16_t*)(p.ws + WS_Y1T) + (size_t)c * NTOK;
    for (int i = tid; i < XL / 8; i += 256) *(u32x4*)(c0 + 4 * i) = *(const u32x4*)(RT + 8 * i);
    if (lat) {
        for (int i = tid; i < 2 * 64 * 72 / 8; i += 256) *(u32x4*)(U + 8 * i) = (u32x4){0u, 0u, 0u, 0u};
    }
    __syncthreads();
    for (int i = tid; i < XL / 2; i += 256) { unsigned lo = c0[i], hi = (i + 1 < XL / 2) ? c0[i + 1] : 0u; c1[i] = (lo >> 16) | (hi << 16); }
    if (lat) {
        for (int i = tid; i < 512; i += 256) {
            int b = i >> 8, t = (i & 255) * 8;
            bf16x8 v = which == 0 ? hy_short8(p, l, c, NCTX + 2048 * b, 2048, t) : *(const bf16x8*)(Y1T + NCTX + 2048 * b + t);
            *(bf16x8*)(U + (size_t)(b * 64 + 16 + (t >> 6)) * 72 + (t & 63)) = v;
        }
    } else {
        for (int i = tid; i < 1024; i += 256) {
            int b = i >> 5, t = (i & 31) * 8;
            bf16x8 v = which == 0 ? hy_short8(p, l, c, 256 * b, 256, t) : *(const bf16x8*)(Y1T + 256 * b + t);
            *(bf16x8*)(U + b * 264 + t) = v;
        }
    }
    __syncthreads();
    const float bias = p.in[I_HBIAS][(l * 2 + which) * 256 + c];
    bf16_t* OT = (which == 0 ? (bf16_t*)(p.ws + WS_Y1T) : (bf16_t*)(p.ws + WS_OUTT)) + (size_t)c * NTOK;
    const int xch = (which == 0 ? 256 : 512) + c;
    const int par = (lr + 1) & 1;
    const unsigned* cp = par ? c1 : c0;
    if (lat) {
        const int b = w >> 1, ih = w & 1;
        const int lane_dw = (2047 - lr - par) / 2 + 4 * quad;
        f32x4 acc[4];
#pragma unroll
        for (int i = 0; i < 4; ++i) acc[i] = (f32x4){0.f, 0.f, 0.f, 0.f};
        const int dlo = ih ? -15 : -31, dhi = ih ? 31 : 15;
        for (int dl = dlo; dl <= dhi; ++dl) {
#pragma unroll
            for (int ks = 0; ks < 2; ++ks) {
                bf16x8 bfr = *(const bf16x8*)(U + (size_t)(b * 64 + 16 + 16 * ih + lr - dl) * 72 + 32 * ks + 8 * quad);
#pragma unroll
                for (int mt = 0; mt < 4; ++mt) {
                    const unsigned* ap = cp + lane_dw - 32 * dl - 8 * mt + 16 * ks;
                    u32x4 av; av[0] = ap[0]; av[1] = ap[1]; av[2] = ap[2]; av[3] = ap[3];
                    acc[mt] = MFMA16(__builtin_bit_cast(bf16x8, av), bfr, acc[mt]);
                }
            }
        }
        const int tokseq0 = NCTX + 2048 * b;
        float xs[4][4];
#pragma unroll
        for (int mt = 0; mt < 4; ++mt) hy_short4(p, l, xch, tokseq0, 2048, 64 * (16 * ih + lr) + 16 * mt + 4 * quad, xs[mt]);
#pragma unroll
        for (int mt = 0; mt < 4; ++mt) {
            const int t = 64 * (16 * ih + lr) + 16 * mt + 4 * quad;
            const float* x = xs[mt];
            bf16x4 uu = *(const bf16x4*)(U + (size_t)(b * 64 + 16 + (t >> 6)) * 72 + (t & 63));
            bf16x4 o;
#pragma unroll
            for (int j = 0; j < 4; ++j) o[j] = (short)f2bf(x[j] * (acc[mt][j] + bias * bf2f((bf16_t)uu[j])));
            *(bf16x4*)(OT + tokseq0 + t) = o;
        }
    } else {
        const int lane_dw = (255 - lr - par) / 2 + 4 * quad;
        f32x4 acc[4][2];
#pragma unroll
        for (int i = 0; i < 4; ++i) { acc[i][0] = (f32x4){0.f, 0.f, 0.f, 0.f}; acc[i][1] = (f32x4){0.f, 0.f, 0.f, 0.f}; }
#pragma unroll 2
        for (int ks = 0; ks < 8; ++ks) {
            bf16x8 b0 = *(const bf16x8*)(U + lr * 264 + 32 * ks + 8 * quad);
            bf16x8 b1 = *(const bf16x8*)(U + (16 + lr) * 264 + 32 * ks + 8 * quad);
#pragma unroll
            for (int mi = 0; mi < 4; ++mi) {
                const unsigned* ap = cp + lane_dw - 8 * (4 * w + mi) + 16 * ks;
                u32x4 av; av[0] = ap[0]; av[1] = ap[1]; av[2] = ap[2]; av[3] = ap[3];
                bf16x8 af = __builtin_bit_cast(bf16x8, av);
                acc[mi][0] = MFMA16(af, b0, acc[mi][0]);
                acc[mi][1] = MFMA16(af, b1, acc[mi][1]);
            }
        }
        float xs[4][2][4];
#pragma unroll
        for (int mi = 0; mi < 4; ++mi)
#pragma unroll
            for (int nt = 0; nt < 2; ++nt) hy_short4(p, l, xch, 256 * (16 * nt + lr), 256, 16 * (4 * w + mi) + 4 * quad, xs[mi][nt]);
#pragma unroll
        for (int mi = 0; mi < 4; ++mi)
#pragma unroll
            for (int nt = 0; nt < 2; ++nt) {
                const int b = 16 * nt + lr, t = 16 * (4 * w + mi) + 4 * quad;
                const float* x = xs[mi][nt];
                bf16x4 uu = *(const bf16x4*)(U + b * 264 + t);
                bf16x4 o;
#pragma unroll
                for (int j = 0; j < 4; ++j) o[j] = (short)f2bf(x[j] * (acc[mi][nt][j] + bias * bf2f((bf16_t)uu[j])));
                *(bf16x4*)(OT + 256 * b + t) = o;
            }
    }
    __syncthreads();
}

DI void hyfin_item(const P& p, int item, unsigned char* smem) {
    bf16_t* tile = (bf16_t*)smem;
    const int tid = get_tid();
    const int tok0 = (item >> 2) * 64, ch0 = (item & 3) * 64;
    {
        const int cc = tid >> 2, part = tid & 3;
        const bf16_t* src = (const bf16_t*)(p.ws + WS_OUTT) + (size_t)(ch0 + cc) * NTOK + tok0 + part * 16;
        *(u32x4*)(tile + cc * 72 + part * 16) = *(const u32x4*)src;
        *(u32x4*)(tile + cc * 72 + part * 16 + 8) = *(const u32x4*)(src + 8);
    }
    __syncthreads();
    {
        const int tt = tid >> 2, part = tid & 3;
        const bf16_t* g = (const bf16_t*)(p.ws + WS_PROJ) + (size_t)(tok0 + tt) * NIN + C_GHY + ch0 + part * 16;
        bf16x8 g0 = *(const bf16x8*)g, g1 = *(const bf16x8*)(g + 8);
        bf16x8 o0, o1;
#pragma unroll
        for (int j = 0; j < 8; ++j) {
            o0[j] = (short)f2bf(bf2f(tile[(part * 16 + j) * 72 + tt]) * siluf_(bf2f((bf16_t)g0[j])));
            o1[j] = (short)f2bf(bf2f(tile[(part * 16 + 8 + j) * 72 + tt]) * siluf_(bf2f((bf16_t)g1[j])));
        }
        bf16_t* dst = (bf16_t*)(p.ws + WS_HB) + (size_t)(tok0 + tt) * 1024 + 256 + ch0 + part * 16;
        *(bf16x8*)dst = o0; *(bf16x8*)(dst + 8) = o1;
    }
    __syncthreads();
}

DI bf16x8 pack8(float a0, float a1, float a2, float a3, float a4, float a5, float a6, float a7) {
    typedef __bf16 bfv8 __attribute__((ext_vector_type(8)));
    typedef float fv8 __attribute__((ext_vector_type(8)));
    fv8 v = {a0, a1, a2, a3, a4, a5, a6, a7};
    return __builtin_bit_cast(bf16x8, __builtin_convertvector(v, bfv8));
}
DI void s5prep_item(const P& p, int item) {
    const int tid = get_tid();
    if (tid < 64) {
        const int pst = tid;
        unsigned char* T = p.ws + WS_S5T + (size_t)item * S5T_STRIDE;
        const int pidx = item * 64 + pst;
        const float are = fminf(p.in[I_AR][pidx], -1e-4f), aim = p.in[I_AI][pidx];
        const float dt = expf(p.in[I_LDT][item]);
        float abr, abi, Ar, Ai;
        { float m = expf(are * dt); float sn, cn; sincosf(aim * dt, &sn, &cn); abr = m * cn; abi = m * sn; }
        { float m = expf(are * dt * 256.f); float sn, cn; sincosf(aim * dt * 256.f, &sn, &cn); Ar = m * cn; Ai = m * sn; }
        ((float2*)T)[pst] = make_float2(abr, abi);
        ((float2*)T)[64 + pst] = make_float2(Ar, Ai);
        float nr = abr - 1.f, ni = abi; float den = 1.f / (are * are + aim * aim);
        float cfr = (nr * are + ni * aim) * den, cfi = (ni * are - nr * aim) * den;
        bf16_t* Bt = (bf16_t*)(T + 1024);
        bf16_t* Ct = (bf16_t*)(T + 1024 + 4096);
        for (int i = 0; i < 16; ++i) {
            float br = p.in[I_BR][(size_t)pidx * 16 + i], bi = p.in[I_BI][(size_t)pidx * 16 + i];
            Bt[(2 * pst) * 16 + i] = f2bf(cfr * br - cfi * bi);
            Bt[(2 * pst + 1) * 16 + i] = f2bf(cfr * bi + cfi * br);
            size_t ci = (size_t)(item * 16 + i) * 64 + pst;
            Ct[i * 128 + 2 * pst] = f2bf(p.in[I_CR][ci]);
            Ct[i * 128 + 2 * pst + 1] = f2bf(-p.in[I_CI][ci]);
        }
    }
}
DI void s5_item(const P& p, int l, int sc, int g, int dir, int mode, unsigned char* smem) {
    bf16_t* Ub = (bf16_t*)smem;
    float* H = (float*)(Ub + 256 * 16);
    const int tid = get_tid(), lane = tid & 63, w = tid >> 6, lr = lane & 15, quad = lane >> 4;
    const int pst = lane;
    const bool lat = sc >= 32;
    const int tokc = lat ? NCTX + 256 * (sc - 32) : 256 * sc;
    const int lb = lat ? (sc - 32) >> 3 : 0, lj = lat ? (sc - 32) & 7 : 0;
    const bf16_t* PR = (const bf16_t*)(p.ws + WS_PROJ);
    for (int e = tid; e < 512; e += 256) *(u32x4*)(Ub + 8 * e) = *(const u32x4*)(PR + (size_t)(tokc + (e >> 1)) * NIN + C_S5 + 16 * g + 8 * (e & 1));
    const unsigned char* T = p.ws + WS_S5T + (size_t)((l * 2 + dir) * 16 + g) * S5T_STRIDE;
    const float2 ab = ((const float2*)T)[pst];
    const float abr = ab.x, abi = ab.y;
    bf16x8 afB[8];
#pragma unroll
    for (int mt = 0; mt < 8; ++mt) {
        afB[mt] = (bf16x8){0, 0, 0, 0, 0, 0, 0, 0};
        if (quad < 2) afB[mt] = *(const bf16x8*)((const bf16_t*)(T + 1024) + (16 * mt + lr) * 16 + 8 * quad);
    }
    bf16x8 afC[4];
    if (mode == 1) {
#pragma unroll
        for (int ks = 0; ks < 4; ++ks) afC[ks] = *(const bf16x8*)((const bf16_t*)(T + 1024 + 4096) + lr * 128 + 32 * ks + 8 * quad);
    }
    float hr = 0.f, hi = 0.f;
    if (mode == 1 && lat && w == 0) {
        const float* h0 = p.in[I_SS5] + ((size_t)(((lb * 2 + l) * 2 + dir) * 16 + g) * 64 + pst) * 2;
        hr = h0[0]; hi = h0[1];
        const float2 A2 = ((const float2*)T)[64 + pst];
        const float Ar = A2.x, Ai = A2.y;
        const float* LOC = (const float*)(p.ws + WS_S5LOC);
        if (dir == 0) {
            for (int j = 0; j < lj; ++j) {
                const float* lc = LOC + ((size_t)(((lb * 8 + j) * 16 + g) * 2 + dir) * 64 + pst) * 2;
                float nr = Ar * hr - Ai * hi + lc[0], ni = Ar * hi + Ai * hr + lc[1]; hr = nr; hi = ni;
            }
        } else {
            for (int j = 7; j > lj; --j) {
                const float* lc = LOC + ((size_t)(((lb * 8 + j) * 16 + g) * 2 + dir) * 64 + pst) * 2;
                float nr = Ar * hr - Ai * hi + lc[0], ni = Ar * hi + Ai * hr + lc[1]; hr = nr; hi = ni;
            }
        }
    }
    __syncthreads();
    for (int sbi = 0; sbi < 4; ++sbi) {
        const int sub = dir == 0 ? sbi : 3 - sbi;
        const int tl = sub * 64 + 16 * w + lr, tok = tokc + tl, ch = 16 * g + 4 * quad;
        float* YS = (float*)(p.ws + WS_YS5) + (size_t)tok * 256 + ch;
        float4 pv = make_float4(0.f, 0.f, 0.f, 0.f);
        if (mode == 1 && dir == 1) pv = *(const float4*)YS;
        {
            bf16x8 bfr = (bf16x8){0, 0, 0, 0, 0, 0, 0, 0};
            if (quad < 2) bfr = *(const bf16x8*)(Ub + tl * 16 + 8 * quad);
#pragma unroll
            for (int mt = 0; mt < 8; ++mt) {
                f32x4 acc = MFMA16(afB[mt], bfr, ((f32x4){0.f, 0.f, 0.f, 0.f}));
                *(f32x4*)(H + (16 * w + lr) * 132 + 16 * mt + 4 * quad) = acc;
            }
        }
        __syncthreads();
        if (w == 0) {
#pragma unroll 8
            for (int k = 0; k < 64; ++k) {
                int tt = dir == 0 ? k : 63 - k;
                float2 b = *(const float2*)(H + tt * 132 + 2 * pst);
                float nr = abr * hr - abi * hi + b.x, ni = abr * hi + abi * hr + b.y; hr = nr; hi = ni;
                *(float2*)(H + tt * 132 + 2 * pst) = make_float2(hr, hi);
            }
        }
        __syncthreads();
        if (mode == 1) {
            f32x4 acc = (f32x4){0.f, 0.f, 0.f, 0.f};
#pragma unroll
            for (int ks = 0; ks < 4; ++ks) {
                const float* hp = H + (16 * w + lr) * 132 + 32 * ks + 8 * quad;
                float4 x0 = *(const float4*)hp, x1 = *(const float4*)(hp + 4);
                bf16x8 bfr = pack8(x0.x, x0.y, x0.z, x0.w, x1.x, x1.y, x1.z, x1.w);
                acc = MFMA16(afC[ks], bfr, acc);
            }
            if (dir == 0) {
                bf16x4 uu = *(const bf16x4*)(Ub + tl * 16 + 4 * quad);
                float4 dd = *(const float4*)(p.in[I_S5D] + l * 256 + ch);
                float4 o;
                o.x = dd.x * bf2f((bf16_t)uu[0]) + acc[0]; o.y = dd.y * bf2f((bf16_t)uu[1]) + acc[1];
                o.z = dd.z * bf2f((bf16_t)uu[2]) + acc[2]; o.w = dd.w * bf2f((bf16_t)uu[3]) + acc[3];
                *(float4*)YS = o;
            } else {
                bf16x4 o;
                o[0] = (short)f2bf(gelu_tanh(pv.x + acc[0])); o[1] = (short)f2bf(gelu_tanh(pv.y + acc[1]));
                o[2] = (short)f2bf(gelu_tanh(pv.z + acc[2])); o[3] = (short)f2bf(gelu_tanh(pv.w + acc[3]));
                *(bf16x4*)((bf16_t*)(p.ws + WS_GS5) + (size_t)tok * 256 + ch) = o;
            }
            __syncthreads();
        }
    }
    if (w == 0) {
        if (mode == 0) {
            float* lc = (float*)(p.ws + WS_S5LOC) + ((size_t)(((lb * 8 + lj) * 16 + g) * 2 + dir) * 64 + pst) * 2;
            lc[0] = hr; lc[1] = hi;
        } else if (!lat) {
            float* o = p.out + OFF_S5 + ((size_t)(((sc * 2 + l) * 2 + dir) * 16 + g) * 64 + pst) * 2;
            o[0] = hr; o[1] = hi;
        }
    }
    __syncthreads();
}

DI void gla_item(const P& p, int l, int sc, int head, int dir, int mode, unsigned char* smem) {
    float* qs = (float*)smem;
    float* ks = qs + 1024;
    float* ds = ks + 1024;
    float* vs = ds + 1024;
    float* gl = vs + 2048;
    float* gwl = gl + 512;
    float* ob = gwl + 544;
    const int tid = get_tid(), lane = tid & 63, w = tid >> 6;
    const int e = 16 * w + (lane & 15), dq = lane >> 4;
    const bool lat = sc >= 32;
    const int tokc = lat ? NCTX + 256 * (sc - 32) : 256 * sc;
    const int lb = lat ? (sc - 32) >> 3 : 0, lj = lat ? (sc - 32) & 7 : 0;
    const bf16_t* PR = (const bf16_t*)(p.ws + WS_PROJ);
    float S[8];
#pragma unroll
    for (int i = 0; i < 8; ++i) S[i] = 0.f;
    float acum[8];
#pragma unroll
    for (int i = 0; i < 8; ++i) acum[i] = 1.f;
    for (int i = tid; i < 544; i += 256)
        gwl[i] = i < 512 ? p.in[I_GGW][(size_t)((l * 2 + dir) * 16 + (i >> 5)) * 128 + 32 * head + (i & 31)] : p.in[I_GGB][(l * 2 + dir) * 128 + 32 * head + (i - 512)];
    if (mode == 1 && lat) {
        const float* s0 = p.in[I_SGLA] + (size_t)(((lb * 2 + l) * 2 + dir) * 4 + head) * 2048;
#pragma unroll
        for (int i = 0; i < 8; ++i) S[i] = s0[(8 * dq + i) * 64 + e];
        const float* LOC = (const float*)(p.ws + WS_GLALOC);
        if (dir == 0) {
            for (int j = 0; j < lj; ++j) {
                const float* lc = LOC + (size_t)(((lb * 8 + j) * 4 + head) * 2 + dir) * 2080;
#pragma unroll
                for (int i = 0; i < 8; ++i) S[i] = lc[2048 + 8 * dq + i] * S[i] + lc[(8 * dq + i) * 64 + e];
            }
        } else {
            for (int j = 7; j > lj; --j) {
                const float* lc = LOC + (size_t)(((lb * 8 + j) * 4 + head) * 2 + dir) * 2080;
#pragma unroll
                for (int i = 0; i < 8; ++i) S[i] = lc[2048 + 8 * dq + i] * S[i] + lc[(8 * dq + i) * 64 + e];
            }
        }
    }
    float* OG = (float*)(p.ws + WS_OGLA) + (size_t)dir * NTOK * 256;
    bf16x8 rqk, rv8, rg8 = (bf16x8){0, 0, 0, 0, 0, 0, 0, 0};
    const int qk_t = (tid & 127) >> 2, qk_c = (tid & 3) * 8, qk_col = (tid < 128 ? C_GQ : C_GK) + 32 * head + qk_c;
    {
        const int sub = dir == 0 ? 0 : 7; const int tk0 = tokc + sub * 32;
        rqk = *(const bf16x8*)(PR + (size_t)(tk0 + qk_t) * NIN + qk_col);
        rv8 = *(const bf16x8*)(PR + (size_t)(tk0 + (tid >> 3)) * NIN + C_GV + 64 * head + (tid & 7) * 8);
        if (tid < 64) rg8 = *(const bf16x8*)(PR + (size_t)(tk0 + (tid >> 1)) * NIN + C_GG + 16 * dir + (tid & 1) * 8);
    }
    for (int sbi = 0; sbi < 8; ++sbi) {
        const int sub = dir == 0 ? sbi : 7 - sbi;
        const int tk0 = tokc + sub * 32;
        __syncthreads();
        {
            float* dq_ = (tid < 128 ? qs : ks) + qk_t * 32 + qk_c;
            const float sc_ = tid < 128 ? 0.17677669529663687f : 1.f;
            *(float4*)dq_ = make_float4(bf2f((bf16_t)rqk[0]) * sc_, bf2f((bf16_t)rqk[1]) * sc_, bf2f((bf16_t)rqk[2]) * sc_, bf2f((bf16_t)rqk[3]) * sc_);
            *(float4*)(dq_ + 4) = make_float4(bf2f((bf16_t)rqk[4]) * sc_, bf2f((bf16_t)rqk[5]) * sc_, bf2f((bf16_t)rqk[6]) * sc_, bf2f((bf16_t)rqk[7]) * sc_);
            float* dv_ = vs + (tid >> 3) * 64 + (tid & 7) * 8;
            *(float4*)dv_ = make_float4(bf2f((bf16_t)rv8[0]), bf2f((bf16_t)rv8[1]), bf2f((bf16_t)rv8[2]), bf2f((bf16_t)rv8[3]));
            *(float4*)(dv_ + 4) = make_float4(bf2f((bf16_t)rv8[4]), bf2f((bf16_t)rv8[5]), bf2f((bf16_t)rv8[6]), bf2f((bf16_t)rv8[7]));
            if (tid < 64) {
                float* dg_ = gl + (tid >> 1) * 16 + (tid & 1) * 8;
                *(float4*)dg_ = make_float4(bf2f((bf16_t)rg8[0]), bf2f((bf16_t)rg8[1]), bf2f((bf16_t)rg8[2]), bf2f((bf16_t)rg8[3]));
                *(float4*)(dg_ + 4) = make_float4(bf2f((bf16_t)rg8[4]), bf2f((bf16_t)rg8[5]), bf2f((bf16_t)rg8[6]), bf2f((bf16_t)rg8[7]));
            }
        }
        __syncthreads();
        if (sbi < 7) {
            const int nsub = dir == 0 ? sbi + 1 : 6 - sbi; const int nk0 = tokc + nsub * 32;
            rqk = *(const bf16x8*)(PR + (size_t)(nk0 + qk_t) * NIN + qk_col);
            rv8 = *(const bf16x8*)(PR + (size_t)(nk0 + (tid >> 3)) * NIN + C_GV + 64 * head + (tid & 7) * 8);
            if (tid < 64) rg8 = *(const bf16x8*)(PR + (size_t)(nk0 + (tid >> 1)) * NIN + C_GG + 16 * dir + (tid & 1) * 8);
        }
#pragma unroll
        for (int j = 0; j < 4; ++j) {
            int i = tid + 256 * j; int t = i >> 5, d = i & 31;
            float z = gwl[512 + d];
#pragma unroll
            for (int r = 0; r < 16; ++r) z += gl[t * 16 + r] * gwl[r * 32 + d];
            float ls = fminf(z, 0.f) - __logf(1.f + __expf(-fabsf(z)));
            ds[i] = __expf(ls * (1.f / 16.f));
        }
        __syncthreads();
        {
            f32x2 S2[4], A2[4];
#pragma unroll
            for (int i = 0; i < 4; ++i) { S2[i] = (f32x2){S[2 * i], S[2 * i + 1]}; A2[i] = (f32x2){acum[2 * i], acum[2 * i + 1]}; }
#pragma unroll 4
            for (int k = 0; k < 32; ++k) {
                const int t = dir == 0 ? k : 31 - k;
                const float4* ap = (const float4*)(ds + t * 32 + 8 * dq);
                const float4* kp = (const float4*)(ks + t * 32 + 8 * dq);
                const float4 a0 = ap[0], a1 = ap[1], k0 = kp[0], k1 = kp[1];
                const float v = vs[t * 64 + e];
                const f32x2 vv = (f32x2){v, v};
                const f32x2 a01 = (f32x2){a0.x, a0.y}, a23 = (f32x2){a0.z, a0.w}, a45 = (f32x2){a1.x, a1.y}, a67 = (f32x2){a1.z, a1.w};
                S2[0] = a01 * S2[0] + (f32x2){k0.x, k0.y} * vv;
                S2[1] = a23 * S2[1] + (f32x2){k0.z, k0.w} * vv;
                S2[2] = a45 * S2[2] + (f32x2){k1.x, k1.y} * vv;
                S2[3] = a67 * S2[3] + (f32x2){k1.z, k1.w} * vv;
                if (mode == 1) {
                    const float4* qp = (const float4*)(qs + t * 32 + 8 * dq);
                    const float4 q0 = qp[0], q1 = qp[1];
                    f32x2 oo = (f32x2){q0.x, q0.y} * S2[0];
                    oo = (f32x2){q0.z, q0.w} * S2[1] + oo;
                    oo = (f32x2){q1.x, q1.y} * S2[2] + oo;
                    oo = (f32x2){q1.z, q1.w} * S2[3] + oo;
                    ob[(t * 64 + e) * 4 + dq] = oo[0] + oo[1];
                } else {
                    A2[0] *= a01; A2[1] *= a23; A2[2] *= a45; A2[3] *= a67;
                }
            }
#pragma unroll
            for (int i = 0; i < 4; ++i) { S[2 * i] = S2[i][0]; S[2 * i + 1] = S2[i][1]; acum[2 * i] = A2[i][0]; acum[2 * i + 1] = A2[i][1]; }
        }
        if (mode == 1) {
            __syncthreads();
            const int t = tid >> 3, e0 = (tid & 7) * 8;
            float r[8];
#pragma unroll
            for (int j = 0; j < 8; ++j) { float4 x = *(const float4*)(ob + (t * 64 + e0 + j) * 4); r[j] = (x.x + x.y) + (x.z + x.w); }
            float* dst = OG + (size_t)(tk0 + t) * 256 + 64 * head + e0;
            *(float4*)dst = make_float4(r[0], r[1], r[2], r[3]);
            *(float4*)(dst + 4) = make_float4(r[4], r[5], r[6], r[7]);
        }
    }
    if (mode == 0) {
        float* lc = (float*)(p.ws + WS_GLALOC) + (size_t)(((lb * 8 + lj) * 4 + head) * 2 + dir) * 2080;
#pragma unroll
        for (int i = 0; i < 8; ++i) lc[(8 * dq + i) * 64 + e] = S[i];
        if (w == 0 && (lane & 15) == 0) {
#pragma unroll
            for (int i = 0; i < 8; ++i) lc[2048 + 8 * dq + i] = acum[i];
        }
    } else if (!lat) {
        float* o = p.out + OFF_GLA + (size_t)(((sc * 2 + l) * 2 + dir) * 4 + head) * 2048;
#pragma unroll
        for (int i = 0; i < 8; ++i) o[(8 * dq + i) * 64 + e] = S[i];
    }
    __syncthreads();
}

DI void glafin_item(const P& p, int l, int item) {
    const int tid_ = get_tid(); const int lane = tid_ & 63, w = tid_ >> 6;
    float4 a[2], b[2]; bf16x4 g[2];
#pragma unroll
    for (int j = 0; j < 2; ++j) {
        const int tok = (item * 2 + j) * 4 + w;
        const float* O0 = (const float*)(p.ws + WS_OGLA) + (size_t)tok * 256 + lane * 4;
        a[j] = *(const float4*)O0; b[j] = *(const float4*)(O0 + (size_t)NTOK * 256);
        g[j] = *(const bf16x4*)((const bf16_t*)(p.ws + WS_PROJ) + (size_t)tok * NIN + C_GGLA + lane * 4);
    }
    const float4 nw = *(const float4*)(p.in[I_GLAN] + l * 64 + (lane & 15) * 4);
#pragma unroll
    for (int j = 0; j < 2; ++j) {
        const int tok = (item * 2 + j) * 4 + w;
        float v[4] = {a[j].x + b[j].x, a[j].y + b[j].y, a[j].z + b[j].z, a[j].w + b[j].w};
        float ss = v[0] * v[0] + v[1] * v[1] + v[2] * v[2] + v[3] * v[3];
        ss += __shfl_xor(ss, 1); ss += __shfl_xor(ss, 2); ss += __shfl_xor(ss, 4); ss += __shfl_xor(ss, 8);
        float r = rsqrtf(ss * (1.f / 64.f) + 1e-6f);
        bf16x4 o;
        o[0] = (short)f2bf(v[0] * r * nw.x * siluf_(bf2f((bf16_t)g[j][0])));
        o[1] = (short)f2bf(v[1] * r * nw.y * siluf_(bf2f((bf16_t)g[j][1])));
        o[2] = (short)f2bf(v[2] * r * nw.z * siluf_(bf2f((bf16_t)g[j][2])));
        o[3] = (short)f2bf(v[3] * r * nw.w * siluf_(bf2f((bf16_t)g[j][3])));
        *(bf16x4*)((bf16_t*)(p.ws + WS_HB) + (size_t)tok * 1024 + 768 + lane * 4) = o;
    }
}

#define XB_TMO      128
#define XB_XCNT(j)  (256  + 64 * (j))
#define XB_XSUB(j)  (1280 + 64 * (j))
#define XB_XGEN(j)  (2304 + 64 * (j))
#define XB_TOP      3328
#define XB_TOPGEN   3392
#define XCD_BAR_WORDS 3456
#define XB_SPIN_CAP (1u << 18)
#define LAS __attribute__((address_space(3)))
DI unsigned xb_ld(unsigned* p)              { return __hip_atomic_load(p, __ATOMIC_RELAXED, __HIP_MEMORY_SCOPE_AGENT); }
DI unsigned xb_add(unsigned* p, unsigned v) { return __hip_atomic_fetch_add(p, v, __ATOMIC_RELAXED, __HIP_MEMORY_SCOPE_AGENT); }
DI unsigned xb_xcc_id() { return (unsigned)__builtin_amdgcn_s_getreg((3 << 11) | 20) & 0xFu; }
#define XB_SPIN(cond, bar) do { unsigned _sp = 0; while (cond) { __builtin_amdgcn_s_sleep(1); \
    if ((++_sp & 255u) == 0u) { if (xb_ld(&(bar)[XB_TMO])) break; if (_sp > XB_SPIN_CAP) { atomicAdd(&(bar)[XB_TMO], 1u); break; } } } } while (0)
struct XcdBarrier { unsigned* bar; unsigned x; volatile LAS unsigned* st; };
DI XcdBarrier xcd_barrier_post(unsigned* bar, volatile LAS unsigned* st) {
    XcdBarrier b; b.bar = bar; b.x = xb_xcc_id(); b.st = st;
    if (threadIdx.x == 0) (void)xb_add(&bar[XB_XCNT(b.x)], 1u);
    return b;
}
DI void xcd_barrier_complete(unsigned* bar, unsigned x, unsigned& nloc, unsigned& nx) {
    const unsigned G = gridDim.x * gridDim.y * gridDim.z;
    unsigned sum, cnt, mine, sp = 0u;
    for (;;) {
        sum = 0u; cnt = 0u; mine = 0u;
#pragma unroll
        for (unsigned j = 0; j < 16; ++j) { const unsigned c = xb_ld(&bar[XB_XCNT(j)]); sum += c; cnt += (c > 0u) ? 1u : 0u; mine = (j == x) ? c : mine; }
        if (sum == G) break;
        __builtin_amdgcn_s_sleep(1);
        if ((++sp & 255u) == 0u) { if (xb_ld(&bar[XB_TMO])) break; if (sp > XB_SPIN_CAP) { atomicAdd(&bar[XB_TMO], 1u); break; } }
    }
    nloc = mine > 0u ? mine : 1u; nx = cnt > 0u ? cnt : 1u;
}
DI void xcd_barrier(const XcdBarrier& b) {
    asm volatile("s_waitcnt vmcnt(0)" ::: "memory");
    __syncthreads();
    if (threadIdx.x == 0) {
        unsigned* bar = b.bar;
        __builtin_amdgcn_s_waitcnt(0);
        unsigned nloc = b.st[0], nx = b.st[1];
        if (nloc == 0u) { xcd_barrier_complete(bar, b.x, nloc, nx); b.st[0] = nloc; b.st[1] = nx; }
        const unsigned old = xb_add(&bar[XB_XSUB(b.x)], 1u);
        const unsigned gen = old / nloc;
        if (old + 1u == (gen + 1u) * nloc) {
            __builtin_amdgcn_fence(__ATOMIC_RELEASE, "agent");
            asm volatile("s_waitcnt vmcnt(0)" ::: "memory");
            const unsigned og = xb_add(&bar[XB_TOP], 1u);
            const unsigned tg = og / nx;
            if (og + 1u == (tg + 1u) * nx) xb_add(&bar[XB_TOPGEN], 1u);
            else XB_SPIN(xb_ld(&bar[XB_TOPGEN]) == tg, bar);
            __builtin_amdgcn_fence(__ATOMIC_ACQUIRE, "agent");
            xb_add(&bar[XB_XGEN(b.x)], 1u);
            asm volatile("s_waitcnt vmcnt(0)" ::: "memory");
        } else {
            XB_SPIN(xb_ld(&bar[XB_XGEN(b.x)]) == gen, bar);
            __builtin_amdgcn_fence(__ATOMIC_ACQUIRE, "agent");
            asm volatile("s_waitcnt vmcnt(0)" ::: "memory");
        }
    }
    __syncthreads();
}

constexpr int SMEM_BYTES = 59392;
#ifndef NPHASE_LAUNCH
#define NPHASE_LAUNCH 0
#endif

DI int next_item(unsigned* ctr, int* slot) {
    __syncthreads();
    if (threadIdx.x == 0) *slot = (int)atomicAdd(ctr, 1u);
    __syncthreads();
    return __builtin_amdgcn_readfirstlane(*slot);
}

__global__ void __launch_bounds__(256, 2) mega(P pk, int ph_lo, int ph_hi) {
    __shared__ __attribute__((aligned(16))) unsigned char smem[SMEM_BYTES];
    __shared__ P p;
    __shared__ int s_next;
    if (threadIdx.x < 42) p.in[threadIdx.x] = pk.in[threadIdx.x];
    if (threadIdx.x == 42) p.out = pk.out;
    if (threadIdx.x == 43) p.ws = pk.ws;
    __syncthreads();
    cg::grid_group grid = cg::this_grid();
    __shared__ uint4 xb_words;
    if (threadIdx.x == 0) xb_words = make_uint4(0u, 0u, 0u, 0u);
    __syncthreads();
    XcdBarrier xbar = xcd_barrier_post((unsigned*)(pk.ws + WS_CTR), (volatile LAS unsigned*)&xb_words);
    if (ph_lo < 0) grid.sync();
    int ph = 0;
#define PHASE_BEGIN if (ph >= ph_lo && ph < ph_hi) {
#define PHASE_END   if (ph + 1 < ph_hi) xcd_barrier(xbar); } ++ph;
#define FOR_ITEMS(N) for (int it = blockIdx.x; it < (N); it += gridDim.x)

    PHASE_BEGIN
    FOR_ITEMS(2756 + 64) {
        if (it >= 2756) s5prep_item(p, it - 2756);
        else if (it < 96) ada_item(p, it / 48, it % 48, smem);
        else if (it < 96 + 576) { int j = it - 96; int l = j / 288, r = j % 288; int ls = r < 256 ? 1 : 0; hyfilt_item(p, l, ls, ls ? r : r - 256, smem); }
        else {
            int j = it - 672; int l = j / 1042, r = j % 1042;
            if (r < 736) tr_item(p.in[I_WIN] + (size_t)l * 1024 * 2944, 1024, 2944, (bf16_t*)(p.ws + WS_WTIN) + (size_t)l * 2944 * 1024, r / 46, r % 46, smem);
            else if (r < 992) { r -= 736; tr_item(p.in[I_WOUT] + (size_t)l * 1024 * 1024, 1024, 1024, (bf16_t*)(p.ws + WS_WTOUT) + (size_t)l * 1024 * 1024, r / 16, r % 16, smem); }
            else if (r < 1010) { r -= 992; tr_item(p.in[I_WUQ] + (size_t)l * 192 * 384, 192, 384, (bf16_t*)(p.ws + WS_WTUQ) + (size_t)l * 384 * 192, r / 6, r % 6, smem); }
            else if (r < 1026) { r -= 1010; tr_item(p.in[I_WUKV] + (size_t)l * 128 * 512, 128, 512, (bf16_t*)(p.ws + WS_WTUKV) + (size_t)l * 512 * 128, r / 8, r % 8, smem); }
            else { r -= 1026; tr_item(p.in[I_GLUW] + (size_t)l * 256 * 256, 256, 256, (bf16_t*)(p.ws + WS_WTGLU) + (size_t)l * 256 * 256, r / 4, r % 4, smem); }
        }
    }
    PHASE_END

    for (int l = 0; l < 2; ++l) {
        PHASE_BEGIN
        FOR_ITEMS(512 + (l == 0 ? 32 : 0)) {
            if (it < 512) normmod_item(p, l, it);
            else { int j = it - 512; hynorm_item(p, j >> 4, (j >> 3) & 1, j & 7, smem); }
        }
        PHASE_END
        PHASE_BEGIN
        {
            EpiProj ep{(bf16_t*)(p.ws + WS_PROJ), (bf16_t*)(p.ws + WS_ZT)};
            const bf16_t* A = (const bf16_t*)(p.ws + WS_HB);
            const bf16_t* Bt = (const bf16_t*)(p.ws + WS_WTIN) + (size_t)l * 2944 * 1024;
            FOR_ITEMS(96 * 23 + (l == 0 ? 1152 : 0)) {
                if (it < 96 * 23) { const int xq = it >> 3, xx = it & 7; gemm_tile(A, 1024, Bt, 1024, 1024, (8 * (xq / 23) + xx) * 128, (xq % 23) * 128, smem, ep); }
                else rt_item(p, it - 96 * 23, smem);
            }
        }
        PHASE_END
        PHASE_BEGIN
        FOR_ITEMS(128 + 256 + 512 + 416 + 256) {
            if (it < 128) { int j = it; gla_item(p, l, 32 + (j >> 3), (j >> 1) & 3, j & 1, 0, smem); }
            else if (it < 384 || it >= 1312) hy2_item(p, l, 0, it < 384 ? it - 128 : 256 + it - 1312, smem);
            else if (it < 896) { int j = it - 384; s5_item(p, l, 32 + (j >> 5), (j >> 1) & 15, j & 1, 0, smem); }
            else mlaprep_item(p, l, it - 896, smem);
        }
        PHASE_END
        PHASE_BEGIN
        FOR_ITEMS(384 + 128 + 768 + 256 + 256 + 256) {
            if (it < 384) { int j = it; gla_item(p, l, 47 - (j >> 3), (j >> 1) & 3, j & 1, 1, smem); }
            else if (it < 512 || (it >= 1536 && it < 1792)) attn_item(p, l, it < 512 ? it - 384 : 128 + it - 1536, smem);
            else if (it < 1280) { int j = it - 512; int sc = 47 - (j >> 4), g = j & 15; for (int dir = 0; dir < 2; ++dir) s5_item(p, l, sc, g, dir, 1, smem); }
            else hy2_item(p, l, 1, it < 1536 ? it - 1280 : 256 + it - 1792, smem);
        }
        PHASE_END
        PHASE_BEGIN
        {
            EpiGlu eg{&p, l};
            const bf16_t* A = (const bf16_t*)(p.ws + WS_GS5);
            const bf16_t* Bt = (const bf16_t*)(p.ws + WS_WTGLU) + (size_t)l * 256 * 256;
            FOR_ITEMS(192 + 512 + 768) {
                if (it < 192) gemm_tile(A, 256, Bt, 256, 256, (it >> 1) * 128, (it & 1) * 128, smem, eg);
                else if (it < 704) { for (int k = 0; k < 3; ++k) glafin_item(p, l, (it - 192) * 3 + k); }
                else hyfin_item(p, it - 704, smem);
            }
        }
        PHASE_END
        PHASE_BEGIN
        {
            EpiOut eo{&p, l};
            const bf16_t* A = (const bf16_t*)(p.ws + WS_HB);
            const bf16_t* Bt = (const bf16_t*)(p.ws + WS_WTOUT) + (size_t)l * 1024 * 1024;
            FOR_ITEMS(96 * 8) { const int xq = it >> 3, xx = it & 7; gemm_tile(A, 1024, Bt, 1024, 1024, (8 * (xq >> 3) + xx) * 128, (xq & 7) * 128, smem, eo); }
        }
        PHASE_END
    }
}

extern "C" void kernel_launch(void* const* d_in, const int* in_sizes, int n_in, void* d_out, int out_size, void* d_ws, size_t ws_size,
                              hipStream_t stream) {
    static int grid_blocks = 0;
    if (!grid_blocks) {
        int dev = 0, cus = 0, per_cu = 0;
        hipGetDevice(&dev);
        hipDeviceGetAttribute(&cus, hipDeviceAttributeMultiprocessorCount, dev);
        hipOccupancyMaxActiveBlocksPerMultiprocessor(&per_cu, mega, 256, 0);
        if (per_cu > 2) per_cu = 2;
        if (per_cu < 1) per_cu = 1;
        grid_blocks = cus * per_cu;
        if (ws_size < WS_END) fprintf(stderr, "workspace too small: %zu < %zu\n", ws_size, (size_t)WS_END);
    }
    hipMemsetAsync((unsigned char*)d_ws + WS_CTR, 0, XCD_BAR_WORDS * 4, stream);
    P p{};
    for (int i = 0; i < 42; ++i) p.in[i] = (const float*)d_in[i];
    p.out = (float*)d_out; p.ws = (unsigned char*)d_ws;
#if NPHASE_LAUNCH
    for (int ph = 0; ph < 13; ++ph) {
        int lo = ph, hi = ph + 1;
        hipLaunchKernelGGL(mega, dim3(grid_blocks), dim3(256), 0, stream, p, lo, hi);
    }
#else
    int lo = 0, hi = 13;
    void* args[] = {&p, &lo, &hi};
    hipError_t e = hipLaunchCooperativeKernel((void*)mega, dim3(grid_blocks), dim3(256), args, 0, stream);
    if (e != hipSuccess) fprintf(stderr, "cooperative launch failed: %s (grid %d)\n", hipGetErrorString(e), grid_blocks);
#endif
}
```
